# Optimizing an MI355X kernel written in HIP

```python
import math
import jax, jax.numpy as jnp
from jax import lax
import numpy as np

D_MODEL = 2048
BATCH = 8
SEQ = 2048
DEPTH = 1

D_MIX = D_MODEL
A_HEADS = 8
A_HEAD_DIM = 128
A_WIDTH = A_HEADS * A_HEAD_DIM
A_KV_RANK = 256
IDX_HEADS = 16
IDX_DIM = 64
IDX_TOPK_MAX = 256
Q_BLOCK = 128
B_HEADS = 8
B_KEY_DIM = 128
B_VAL_DIM = 128
B_WIDTH = B_HEADS * B_VAL_DIM
B_CHUNK = 64
REL_BUCKETS = 32
REL_MAX_DIST = 128
N_EXPERTS = 64
TOP_K = 8
N_GROUPS = 8
TOPK_GROUPS = 4
D_EXPERT = 512
D_SHARED = 512
ROUTED_SCALE = 2.5
MOE_BLOCK = 128
EPS = 1e-6

IN_SIZES = (A_WIDTH,
            A_KV_RANK,
            IDX_HEADS * IDX_DIM,
            IDX_DIM,
            IDX_HEADS,
            B_HEADS * B_KEY_DIM,
            B_HEADS * B_KEY_DIM,
            B_WIDTH,
            B_WIDTH)
D_IN = sum(IN_SIZES)

kernel_name = 'hymba_dsa_hgrn2_moe_adaln'


def rmsnorm(x, g):
    xf = x.astype(jnp.float32)
    y = xf * lax.rsqrt(jnp.mean(xf * xf, axis=-1, keepdims=True) + EPS)
    return (y * g.astype(jnp.float32)).astype(x.dtype)


def split_cols(t, sizes):
    out, off = [], 0
    for s in sizes:
        out.append(t[..., off:off + s])
        off += s
    return out


def t5_bucket(rel):
    n = jnp.maximum(rel, 0)
    max_exact = REL_BUCKETS // 2
    n_large = jnp.maximum(n, max_exact).astype(jnp.float32)
    large = max_exact + (jnp.log(n_large / max_exact) / math.log(REL_MAX_DIST / max_exact)
                         * (REL_BUCKETS - max_exact)).astype(jnp.int32)
    large = jnp.minimum(large, REL_BUCKETS - 1)
    return jnp.where(n < max_exact, n, large)


def dsa_mixer(q, ckv, iq, ik, iw, w_uk, w_uv, rel_bias):
    bsz, L = q.shape[0], q.shape[1]
    topk = min(IDX_TOPK_MAX, L // 4)
    nqb = L // Q_BLOCK
    q_lat = jnp.einsum('blhd,hcd->blhc', q, w_uk) * (A_HEAD_DIM ** -0.5)
    kpos = jnp.arange(L, dtype=jnp.int32)

    def to_blocks(t):
        return jnp.moveaxis(t.reshape((bsz, nqb, Q_BLOCK) + t.shape[2:]), 1, 0)

    def block(args):
        qb, iqb, iwb, start = args
        qpos = start + jnp.arange(Q_BLOCK, dtype=jnp.int32)
        isc = jax.nn.relu(jnp.einsum('bqhd,bsd->bqhs', iqb, ik))
        isc = jnp.einsum('bqhs,bqh->bqs', isc, iwb).astype(jnp.float32)
        causal = kpos[None, :] <= qpos[:, None]
        isc = jnp.where(causal[None], isc, -jnp.inf)
        _, sel = lax.top_k(isc, topk)
        kv = jax.vmap(lambda cb, ib: cb[ib])(ckv, sel)
        logits = jnp.einsum('bqhc,bqkc->bqhk', qb, kv).astype(jnp.float32)
        rel = qpos[None, :, None] - sel
        bias = rel_bias[t5_bucket(rel)].astype(jnp.float32)
        logits = logits + jnp.moveaxis(bias, -1, 2)
        logits = jnp.where((rel >= 0)[:, :, None, :], logits, -jnp.inf)
        p = jax.nn.softmax(logits, axis=-1).astype(kv.dtype)
        return jnp.einsum('bqhk,bqkc->bqhc', p, kv)

    starts = jnp.arange(nqb, dtype=jnp.int32) * Q_BLOCK
    o_lat = lax.map(block, (to_blocks(q_lat), to_blocks(iq), to_blocks(iw), starts))
    o_lat = jnp.moveaxis(o_lat, 0, 1).reshape(bsz, L, A_HEADS, A_KV_RANK)
    return jnp.einsum('blhc,hcd->blhd', o_lat, w_uv)


def hgrn2_mixer(q, f_raw, i_in, lb):
    bsz, L = q.shape[0], q.shape[1]
    nc = L // B_CHUNK
    f = lb + (1.0 - lb) * jax.nn.sigmoid(f_raw.astype(jnp.float32))
    log_f = jnp.log(f)
    k = 1.0 - f

    def to_chunks(t):
        return t.astype(jnp.float32).reshape(bsz, nc, B_CHUNK, B_HEADS, -1).transpose(1, 0, 3, 2, 4)

    causal = jnp.tril(jnp.ones((B_CHUNK, B_CHUNK), dtype=bool))

    def step(S, inp):
        qc, kc, vc, lfc = inp
        bc = jnp.cumsum(lfc, axis=2)
        o_inter = jnp.einsum('bhtk,bhkv->bhtv', qc * jnp.exp(bc), S)
        diff = bc[:, :, :, None, :] - bc[:, :, None, :, :]
        decay = jnp.exp(jnp.where(causal[:, :, None], diff, -jnp.inf))
        scores = jnp.einsum('bhtk,bhsk,bhtsk->bhts', qc, kc, decay)
        o_intra = jnp.einsum('bhts,bhsv->bhtv', scores, vc)
        b_last = bc[:, :, -1:, :]
        S = (jnp.exp(b_last[:, :, 0, :])[..., None] * S
             + jnp.einsum('bhsk,bhsv->bhkv', kc * jnp.exp(b_last - bc), vc))
        return S, o_inter + o_intra

    S0 = jnp.zeros((bsz, B_HEADS, B_KEY_DIM, B_VAL_DIM), jnp.float32)
    _, o = lax.scan(step, S0, (to_chunks(q), to_chunks(k), to_chunks(i_in), to_chunks(log_f)))
    return o.transpose(1, 0, 3, 2, 4).reshape(bsz, L, B_HEADS, B_VAL_DIM)


def moe_ffn(h, w_router, router_bias, w_e_gate, w_e_up, w_e_down, w_s_gate, w_s_up, w_s_down):
    bsz, L, D = h.shape
    T = bsz * L
    ht = h.reshape(T, D)
    scores = jax.nn.sigmoid((ht @ w_router).astype(jnp.float32))
    choice = scores + router_bias.astype(jnp.float32)
    per_group = N_EXPERTS // N_GROUPS
    grp = lax.top_k(choice.reshape(T, N_GROUPS, per_group), 2)[0].sum(-1)
    _, gsel = lax.top_k(grp, TOPK_GROUPS)
    gmask = jax.nn.one_hot(gsel, N_GROUPS, dtype=jnp.float32).sum(1) > 0
    emask = jnp.repeat(gmask, per_group, axis=1)
    _, eidx = lax.top_k(jnp.where(emask, choice, -jnp.inf), TOP_K)
    ew = jnp.take_along_axis(scores, eidx, axis=1)
    ew = ew / jnp.sum(ew, axis=-1, keepdims=True) * ROUTED_SCALE

    A = T * TOP_K
    flat_e = eidx.reshape(A)
    flat_tok = jnp.arange(A, dtype=jnp.int32) // TOP_K
    order = jnp.argsort(flat_e)
    e_sorted = flat_e[order]
    counts = jnp.bincount(flat_e, length=N_EXPERTS)
    padded = (counts + MOE_BLOCK - 1) // MOE_BLOCK * MOE_BLOCK
    pad_end = jnp.cumsum(padded)
    pad_start = pad_end - padded
    start = jnp.cumsum(counts) - counts
    dest = pad_start[e_sorted] + jnp.arange(A, dtype=jnp.int32) - start[e_sorted]
    n_rows = (A + N_EXPERTS * (MOE_BLOCK - 1) + MOE_BLOCK - 1) // MOE_BLOCK * MOE_BLOCK
    nb = n_rows // MOE_BLOCK
    row_tok = jnp.full((n_rows,), T, jnp.int32).at[dest].set(flat_tok[order])
    row_w = jnp.zeros((n_rows,), jnp.float32).at[dest].set(ew.reshape(A)[order])
    block_e = jnp.minimum(jnp.searchsorted(pad_end, jnp.arange(nb, dtype=jnp.int32) * MOE_BLOCK,
                                           side='right'), N_EXPERTS - 1)
    h_pad = jnp.concatenate([ht, jnp.zeros((1, D), ht.dtype)], axis=0)

    def expert_block(args):
        toks, e = args
        xb = h_pad[toks]
        return (jax.nn.silu(xb @ w_e_gate[e]) * (xb @ w_e_up[e])) @ w_e_down[e]

    y_rows = lax.map(expert_block, (row_tok.reshape(nb, MOE_BLOCK), block_e)).reshape(n_rows, D)
    routed = jax.ops.segment_sum(y_rows * row_w[:, None].astype(y_rows.dtype), row_tok,
                                 num_segments=T + 1)[:T]
    shared = (jax.nn.silu(ht @ w_s_gate) * (ht @ w_s_up)) @ w_s_down
    return (routed + shared).reshape(bsz, L, D)


def setup_inputs(seed: int = 0) -> dict:
    key = jax.random.key(seed)
    ks = jax.random.split(key, 26)
    D = D_MODEL

    def nrm(k, shape, scale):
        return jax.random.normal(k, shape, jnp.float32) * scale

    return {
        'x': nrm(ks[0], (BATCH, SEQ, D), 1.0),
        'c': nrm(ks[1], (BATCH, D), 1.0),
        'w_ada': nrm(ks[2], (DEPTH, D, 6 * D), 0.5 * D ** -0.5),
        'b_ada': nrm(ks[3], (DEPTH, 6 * D), 0.02),
        'norm1_g': 1.0 + nrm(ks[4], (DEPTH, D), 0.02),
        'w_in': nrm(ks[5], (DEPTH, D, D_IN), D ** -0.5),
        'ckv_norm_g': 1.0 + nrm(ks[6], (DEPTH, A_KV_RANK), 0.02),
        'idx_k_norm_g': 1.0 + nrm(ks[7], (DEPTH, IDX_DIM), 0.02),
        'w_uk': nrm(ks[8], (DEPTH, A_HEADS, A_KV_RANK, A_HEAD_DIM), A_KV_RANK ** -0.5),
        'w_uv': nrm(ks[9], (DEPTH, A_HEADS, A_KV_RANK, A_HEAD_DIM), A_KV_RANK ** -0.5),
        'rel_bias': nrm(ks[10], (REL_BUCKETS, A_HEADS), 0.5),
        'lb_logits': nrm(ks[11], (DEPTH + 1, B_HEADS * B_KEY_DIM), 0.5),
        'attn_out_norm_g': 1.0 + nrm(ks[12], (DEPTH, A_WIDTH), 0.02),
        'hgrn_out_norm_g': 1.0 + nrm(ks[13], (DEPTH, B_WIDTH), 0.02),
        'w_out': nrm(ks[14], (DEPTH, D_MIX, D), D_MIX ** -0.5),
        'norm2_g': 1.0 + nrm(ks[15], (DEPTH, D), 0.02),
        'w_router': nrm(ks[16], (DEPTH, D, N_EXPERTS), D ** -0.5),
        'router_bias': nrm(ks[17], (DEPTH, N_EXPERTS), 0.01),
        'w_e_gate': nrm(ks[18], (DEPTH, N_EXPERTS, D, D_EXPERT), D ** -0.5),
        'w_e_up': nrm(ks[19], (DEPTH, N_EXPERTS, D, D_EXPERT), D ** -0.5),
        'w_e_down': nrm(ks[20], (DEPTH, N_EXPERTS, D_EXPERT, D), D_EXPERT ** -0.5),
        'w_s_gate': nrm(ks[21], (DEPTH, D, D_SHARED), D ** -0.5),
        'w_s_up': nrm(ks[22], (DEPTH, D, D_SHARED), D ** -0.5),
        'w_s_down': nrm(ks[23], (DEPTH, D_SHARED, D), D_SHARED ** -0.5),
        'final_norm_g': 1.0 + nrm(ks[24], (D,), 0.02),
    }


def reference(x, c, w_ada, b_ada, norm1_g, w_in, ckv_norm_g, idx_k_norm_g, w_uk, w_uv, rel_bias,
              lb_logits, attn_out_norm_g, hgrn_out_norm_g, w_out, norm2_g, w_router, router_bias,
              w_e_gate, w_e_up, w_e_down, w_s_gate, w_s_up, w_s_down, final_norm_g):
    bsz, L, D = x.shape
    lb_all = jnp.cumsum(jax.nn.softmax(lb_logits.astype(jnp.float32), axis=0), axis=0)
    c_act = jax.nn.silu(c)
    for layer in range(DEPTH):
        mod = c_act @ w_ada[layer] + b_ada[layer]
        sh1, sc1, g1, sh2, sc2, g2 = jnp.split(mod, 6, axis=-1)

        h = rmsnorm(x, norm1_g[layer]) * (1.0 + sc1[:, None]) + sh1[:, None]
        proj = h @ w_in[layer]
        q_a, ckv, iq, ik, iw, q_b, f_b, i_b, g_b = split_cols(proj, IN_SIZES)
        ckv = rmsnorm(ckv, ckv_norm_g[layer])
        ik = rmsnorm(ik, idx_k_norm_g[layer])
        iw = iw * (IDX_HEADS ** -0.5 * IDX_DIM ** -0.5)
        o_a = dsa_mixer(q_a.reshape(bsz, L, A_HEADS, A_HEAD_DIM), ckv,
                        iq.reshape(bsz, L, IDX_HEADS, IDX_DIM), ik, iw,
                        w_uk[layer], w_uv[layer], rel_bias)
        o_a = rmsnorm(o_a.reshape(bsz, L, A_WIDTH), attn_out_norm_g[layer])
        lb = lb_all[layer].reshape(B_HEADS, B_KEY_DIM)
        o_b = hgrn2_mixer(q_b.reshape(bsz, L, B_HEADS, B_KEY_DIM),
                          f_b.reshape(bsz, L, B_HEADS, B_KEY_DIM),
                          i_b.reshape(bsz, L, B_HEADS, B_VAL_DIM), lb)
        o_b = rmsnorm(o_b, hgrn_out_norm_g[layer].reshape(B_HEADS, B_VAL_DIM)).astype(x.dtype)
        o_b = o_b.reshape(bsz, L, B_WIDTH) * jax.nn.silu(g_b)
        mix = jnp.concatenate([o_a, o_b], axis=-1) @ w_out[layer]
        x = x + g1[:, None] * mix

        h = rmsnorm(x, norm2_g[layer]) * (1.0 + sc2[:, None]) + sh2[:, None]
        y = moe_ffn(h, w_router[layer], router_bias[layer], w_e_gate[layer], w_e_up[layer],
                    w_e_down[layer], w_s_gate[layer], w_s_up[layer], w_s_down[layer])
        x = x + g2[:, None] * y
    return rmsnorm(x, final_norm_g)
```

```cpp
#include <hip/hip_runtime.h>
#include <cstdio>
#include <cstdint>

#ifndef MK_N_LAUNCHES
#define MK_N_LAUNCHES 1
#endif

#define GAS __attribute__((address_space(1)))
#define LAS __attribute__((address_space(3)))
typedef unsigned short bf16_t;
typedef short bf16x8 __attribute__((ext_vector_type(8)));
typedef short s16x4 __attribute__((ext_vector_type(4)));
typedef float f32x4 __attribute__((ext_vector_type(4)));
typedef float f32x2 __attribute__((ext_vector_type(2)));
typedef float f32x16 __attribute__((ext_vector_type(16)));
typedef unsigned u32x4 __attribute__((ext_vector_type(4)));
typedef unsigned u32x2 __attribute__((ext_vector_type(2)));

constexpr int NB = 8, SEQ = 2048, T = NB * SEQ, D = 2048;
constexpr int NH = 8, HD = 128, CKV = 256, IH = 16, IDIM = 64, TOPK = 256;
constexpr int NPROJ = 6656;
constexpr int NE = 64, DE = 512, KSEL = 8, NSLOT = 9;
constexpr float EPS = 1e-6f;
constexpr float ATT_SCALE = 0.08838834764831845f;

constexpr size_t MiB = 1u << 20;
constexpr size_t WS_CTL = 0, CTL_ZERO_BYTES = 1 * MiB;
constexpr size_t WS_MOD = 1 * MiB;
constexpr size_t WS_CKVSS = 2 * MiB;
constexpr size_t WS_WR = 3 * MiB;
constexpr size_t WS_LTOK = 4 * MiB, WS_LDST = 8 * MiB, WS_LW = 12 * MiB;
constexpr size_t WS_MODP = 16 * MiB;
constexpr size_t WS_W2 = 32 * MiB;
constexpr size_t WS_X1 = 162 * MiB;
constexpr size_t WS_WIN = 162 * MiB;
constexpr size_t WS_WKV = 188 * MiB;
constexpr size_t WS_H1 = 190 * MiB;
constexpr size_t WS_ACT = 290 * MiB;
constexpr size_t WS_K = 290 * MiB, WS_V = 322 * MiB;
constexpr size_t WS_AO = 354 * MiB;
constexpr size_t WS_HO = 386 * MiB;
constexpr size_t WS_A2 = 290 * MiB;
constexpr size_t WS_Y = 450 * MiB;
constexpr size_t WS_W1 = 450 * MiB;
constexpr size_t WS_QA = 710 * MiB;
constexpr size_t WS_CKV = 742 * MiB;
constexpr size_t WS_IQ = 750 * MiB;
constexpr size_t WS_QB = 782 * MiB;
constexpr size_t WS_LOGF = 814 * MiB;
constexpr size_t WS_KB = 878 * MiB;
constexpr size_t WS_IB = 910 * MiB;
constexpr size_t WS_GB = 942 * MiB;
constexpr size_t WS_IK = 974 * MiB;
constexpr size_t WS_IW = 976 * MiB;
constexpr size_t WS_MASK = 977 * MiB;
constexpr size_t WS_WOUT = 981 * MiB;
constexpr size_t WS_H2 = 710 * MiB;
constexpr size_t WS_END = 1026 * MiB;
constexpr int CW_TMO = 0, CW_BAR = 4096, CW_CNT = 8192  , CW_IDXQ = 8448  ;

constexpr int RING_BYTES = 131072, MISC_OFF = RING_BYTES + 320, LDS_BYTES = 147456;
constexpr int SCHED_OFF = RING_BYTES + 1024;

#define RLX_AGENT __ATOMIC_RELAXED, __HIP_MEMORY_SCOPE_AGENT
#define LDS_WAIT() asm volatile("s_waitcnt lgkmcnt(0)" ::: "memory")
#define VM_WAIT() asm volatile("s_waitcnt vmcnt(0)" ::: "memory")

__device__ __forceinline__ unsigned f2bf(float f) { unsigned u = __builtin_bit_cast(unsigned, f); return (u + 0x7fffu + ((u >> 16) & 1u)) >> 16; }
__device__ __forceinline__ unsigned pk2(float lo, float hi) { unsigned r; asm volatile("v_cvt_pk_bf16_f32 %0, %1, %2" : "=v"(r) : "v"(lo), "v"(hi)); return r; }
__device__ __forceinline__ float bflo(unsigned w) { return __builtin_bit_cast(float, w << 16); }
__device__ __forceinline__ float bfhi(unsigned w) { return __builtin_bit_cast(float, w & 0xffff0000u); }
__device__ __forceinline__ float bf1(bf16_t h) { return __builtin_bit_cast(float, ((unsigned)h) << 16); }
__device__ __forceinline__ float sigmoidf_(float x) { return 1.f / (1.f + __expf(-x)); }
template <int LN> __device__ __forceinline__ void wlane(int& vd, int sval) { asm volatile("s_nop 4\n\tv_writelane_b32 %0, %1, %2" : "+v"(vd) : "s"(sval), "n"(LN));   }
template <int XM> __device__ __forceinline__ float swz_xor(float v) { return __builtin_bit_cast(float, __builtin_amdgcn_ds_swizzle(__builtin_bit_cast(int, v), (XM << 10) | 0x1f)); }
__device__ __forceinline__ float wave_sum(float v) {
    v += swz_xor<1>(v); v += swz_xor<2>(v); v += swz_xor<4>(v); v += swz_xor<8>(v); v += swz_xor<16>(v);
    return __builtin_bit_cast(float, __builtin_amdgcn_readlane(__builtin_bit_cast(int, v), 0)) + __builtin_bit_cast(float, __builtin_amdgcn_readlane(__builtin_bit_cast(int, v), 32));
}
__device__ __forceinline__ int opaque(int x) { asm volatile("" : "+v"(x)); return x; }

#define XB_TMO      128
#define XB_XCNT(j)  (256  + 64 * (j))
#define XB_XSUB(j)  (1280 + 64 * (j))
#define XB_XGEN(j)  (2304 + 64 * (j))
#define XB_TOP      3328
#define XB_TOPGEN   3392
#define XCD_BAR_WORDS 3456
#define XB_SPIN_CAP (1u << 20)
__device__ __forceinline__ unsigned xb_ld(unsigned* p)              { return __hip_atomic_load(p, __ATOMIC_RELAXED, __HIP_MEMORY_SCOPE_AGENT); }
__device__ __forceinline__ unsigned xb_add(unsigned* p, unsigned v) { return __hip_atomic_fetch_add(p, v, __ATOMIC_RELAXED, __HIP_MEMORY_SCOPE_AGENT); }
__device__ __forceinline__ unsigned xb_xcc_id() { return (unsigned)__builtin_amdgcn_s_getreg((3 << 11) | 20) & 0xFu; }
#define XB_SPIN(cond, bar) do { unsigned _sp = 0; while (cond) { __builtin_amdgcn_s_sleep(1); \
    if ((++_sp & 255u) == 0u) { if (xb_ld(&(bar)[XB_TMO])) break; if (_sp > XB_SPIN_CAP) { atomicAdd(&(bar)[XB_TMO], 1u); break; } } } } while (0)
struct XcdBarrier { unsigned* bar; unsigned x; volatile LAS unsigned* st; };
__device__ __forceinline__ XcdBarrier xcd_barrier_post(unsigned* bar, volatile LAS unsigned* st) {
    XcdBarrier b; b.bar = bar; b.x = xb_xcc_id(); b.st = st;
    if (threadIdx.x == 0) (void)xb_add(&bar[XB_XCNT(b.x)], 1u);
    return b;
}
__device__ __forceinline__ void xcd_barrier_complete(unsigned* bar, unsigned x, unsigned& nloc, unsigned& nx) {
    const unsigned G = gridDim.x * gridDim.y * gridDim.z;
    unsigned sum, cnt, mine, sp = 0u;
    for (;;) {
        sum = 0u; cnt = 0u; mine = 0u;
#pragma unroll
        for (unsigned j = 0; j < 16; ++j) { const unsigned c = xb_ld(&bar[XB_XCNT(j)]); sum += c; cnt += (c > 0u) ? 1u : 0u; mine = (j == x) ? c : mine; }
        if (sum == G) break;
        __builtin_amdgcn_s_sleep(1);
        if ((++sp & 255u) == 0u) { if (xb_ld(&bar[XB_TMO])) break; if (sp > XB_SPIN_CAP) { atomicAdd(&bar[XB_TMO], 1u); break; } }
    }
    nloc = mine > 0u ? mine : 1u; nx = cnt > 0u ? cnt : 1u;
}
__device__ __forceinline__ void xcd_barrier(const XcdBarrier& b) {
    asm volatile("s_waitcnt vmcnt(0)" ::: "memory");
    __syncthreads();
    if (threadIdx.x == 0) {
        unsigned* bar = b.bar;
        __builtin_amdgcn_s_waitcnt(0);
        unsigned nloc = b.st[0], nx = b.st[1];
        if (nloc == 0u) { xcd_barrier_complete(bar, b.x, nloc, nx); b.st[0] = nloc; b.st[1] = nx; }
        const unsigned old = xb_add(&bar[XB_XSUB(b.x)], 1u);
        const unsigned gen = old / nloc;
        if (old + 1u == (gen + 1u) * nloc) {
            __builtin_amdgcn_fence(__ATOMIC_RELEASE, "agent");
            asm volatile("s_waitcnt vmcnt(0)" ::: "memory");
            const unsigned og = xb_add(&bar[XB_TOP], 1u);
            const unsigned tg = og / nx;
            if (og + 1u == (tg + 1u) * nx) xb_add(&bar[XB_TOPGEN], 1u);
            else XB_SPIN(xb_ld(&bar[XB_TOPGEN]) == tg, bar);
            __builtin_amdgcn_fence(__ATOMIC_ACQUIRE, "agent");
            xb_add(&bar[XB_XGEN(b.x)], 1u);
            asm volatile("s_waitcnt vmcnt(0)" ::: "memory");
        } else {
            XB_SPIN(xb_ld(&bar[XB_XGEN(b.x)]) == gen, bar);
            __builtin_amdgcn_fence(__ATOMIC_ACQUIRE, "agent");
            asm volatile("s_waitcnt vmcnt(0)" ::: "memory");
        }
    }
    __syncthreads();
}

namespace pg8 {
constexpr int BM = 256, BK = 64, HALF = 128, HTB = HALF * BK * 2, STAGE_BYTES = 8 * HTB, NXCD = 8, WGM = 8;
__host__ __device__ __forceinline__ int lds_byte(int r, int c) { const int st = (r >> 4) * 2 + (c >> 5), rr = r & 15, cc = c & 31, ob = rr * 64 + cc * 2; return st * 1024 + (ob ^ (((ob >> 9) & 1) << 5)); }
__host__ __device__ __forceinline__ void stage_rc(int b, int& R, int& C) { const int st = b / 1024, sb = b % 1024, swz = sb ^ (((sb >> 9) & 1) << 5); R = (st >> 1) * 16 + swz / 64; C = (st & 1) * 32 + (swz % 64) / 2; }
__host__ __device__ __forceinline__ int perm32(int rho) { const int n = rho >> 4, i = rho & 15; return 8 * (i >> 2) + 4 * n + (i & 3); }

struct Unit { int pm, pn, e, cnt; };

struct DenseSched {
    const char* A; const char* Bt; int nM, nN, nwg, G, c, K;
    __device__ __forceinline__ void init(const void* A_, const void* Bt_, int M, int N, int K_, int G_, int c_) { A = (const char*)A_; Bt = (const char*)Bt_; nM = M / BM; nN = N / BM; nwg = nM * nN; G = G_; c = c_; K = K_; }
    __device__ __forceinline__ bool next(int i, Unit& u) const {
        const long L = (long)i * G + c; if (L >= nwg) return false;
        int wgid = (int)L; { const int q = nwg / NXCD, r = nwg % NXCD, xcd = wgid % NXCD, off = wgid / NXCD; wgid = (xcd < r ? xcd * (q + 1) : r * (q + 1) + (xcd - r) * q) + off; }
        const int nig = WGM * nN, gid = wgid / nig, fm = gid * WGM, gsz = (nM - fm) < WGM ? (nM - fm) : WGM;
        u.pm = fm + ((wgid % nig) % gsz); u.pn = (wgid % nig) / gsz; u.e = 0; u.cnt = 0; return true;
    }
    __device__ __forceinline__ const char* a_base() const { return A; }
    __device__ __forceinline__ unsigned a_off(const Unit& u, int h, int R) const { return (unsigned)(u.pm * BM + h * HALF + R) * (unsigned)(K * 2); }
    __device__ __forceinline__ const char* b_tile(const Unit& u) const { return Bt + (size_t)u.pn * BM * K * 2; }
};

template <class Epi, class Sched, bool ALIGN_EPI, bool SP2>
__device__ __forceinline__ void gemm_phase(LAS unsigned char* lds, const int K, const Sched& S, const Epi& E) {
    const int tid = threadIdx.x, wid = __builtin_amdgcn_readfirstlane(tid >> 6), lane = tid & 63, wr = wid >> 2, wc = wid & 3, fr = lane & 15, fq = lane >> 4;
    const int nt = K / BK;
    int Rr[2], Cc[2]; unsigned voffB[2];
#pragma unroll
    for (int i = 0; i < 2; ++i) { int R, C; stage_rc(tid * 16 + i * 8192, R, C); const int Rb = Epi::PERM ? ((R & ~31) + perm32(R & 31)) : R;
        Rr[i] = R; Cc[i] = C * 2; voffB[i] = (unsigned)(Rb * K + C) * 2u; }
    const size_t kstep = (size_t)(BK * 2);
    const size_t hstep = (size_t)HALF * K * 2;
    const unsigned ldsw = (unsigned)wid * 1024u;
    const int aoff = lds_byte(wr * 64 + fr, fq * 8), boff = lds_byte(wc * 32 + fr, fq * 8);
#define PG8_SA(b, h) (((b) * 2 + (h)) * HTB)
#define PG8_SB(b, h) ((4 + (b) * 2 + (h)) * HTB)
#define PG8_STAGE2(bufoff, gbase, v0, v1) do { \
        __builtin_amdgcn_global_load_lds((const unsigned*)((const char*)(gbase) + (v0)), (LAS unsigned*)(lds + (bufoff) + ldsw), 16, 0, 0); \
        __builtin_amdgcn_global_load_lds((const unsigned*)((const char*)(gbase) + (v1)), (LAS unsigned*)(lds + (bufoff) + ldsw + 8192), 16, 0, 0); } while (0)
#define PG8_STAGEB(bufoff, gbase) PG8_STAGE2(bufoff, gbase, voffB[0], voffB[1])
#define PG8_LDA(dst, b, h) do { _Pragma("unroll") for (int m = 0; m < 4; ++m) _Pragma("unroll") for (int k = 0; k < 2; ++k) dst[m][k] = *(const LAS bf16x8*)(lds + PG8_SA(b, h) + aoff + m * 2048 + k * 1024); } while (0)
#define PG8_LDB(dst, b, h) do { _Pragma("unroll") for (int n = 0; n < 2; ++n) _Pragma("unroll") for (int k = 0; k < 2; ++k) dst[n][k] = *(const LAS bf16x8*)(lds + PG8_SB(b, h) + boff + n * 2048 + k * 1024); } while (0)
#define PG8_MMA(ai, bj, At, Bt) do { __builtin_amdgcn_s_setprio(1); _Pragma("unroll") for (int m = 0; m < 4; ++m) _Pragma("unroll") for (int n = 0; n < 2; ++n) _Pragma("unroll") for (int k = 0; k < 2; ++k) \
        acc[ai][bj][m][n] = __builtin_amdgcn_mfma_f32_16x16x32_bf16(Bt[n][k], At[m][k], acc[ai][bj][m][n], 0, 0, 0); __builtin_amdgcn_s_setprio(0); } while (0)
#define PG8_WAIT_V(n) asm volatile("s_waitcnt vmcnt(" #n ")" ::: "memory")
#define PG8_WAIT_L(n) asm volatile("s_waitcnt lgkmcnt(" #n ")" ::: "memory")
#define PG8_BAR __builtin_amdgcn_s_barrier()
#define PG8_SCHED __builtin_amdgcn_sched_barrier(0)
    Unit cur, nxt; int ui = 0;
    if (!S.next(0, cur)) return;
    f32x4 acc[2][2][4][2];
#pragma unroll
    for (int a = 0; a < 2; ++a)
#pragma unroll
        for (int b = 0; b < 2; ++b)
#pragma unroll
            for (int m = 0; m < 4; ++m)
#pragma unroll
                for (int n = 0; n < 2; ++n) acc[a][b][m][n] = (f32x4){0.f, 0.f, 0.f, 0.f};
    bf16x8 At[4][2], B0[2][2], B1[2][2];
    const char* const A0 = S.a_base();
    const char* cB = S.b_tile(cur);
    unsigned c00 = S.a_off(cur, 0, Rr[0]) + Cc[0], c01 = S.a_off(cur, 0, Rr[1]) + Cc[1], c10 = S.a_off(cur, 1, Rr[0]) + Cc[0], c11 = S.a_off(cur, 1, Rr[1]) + Cc[1];
    PG8_STAGEB(PG8_SB(0, 0), cB); PG8_STAGEB(PG8_SB(0, 1), cB + hstep); PG8_STAGE2(PG8_SA(0, 0), A0, c00, c01); PG8_STAGE2(PG8_SA(0, 1), A0, c10, c11);
    if (wr == 1) PG8_BAR;
    PG8_WAIT_V(2); PG8_BAR;
    PG8_STAGEB(PG8_SB(1, 0), cB + kstep); PG8_STAGE2(PG8_SA(1, 0), A0 + kstep, c00, c01); PG8_STAGEB(PG8_SB(1, 1), cB + hstep + kstep);
    PG8_WAIT_V(6); PG8_BAR;
    for (;;) {
        const bool has_next = S.next(ui + 1, nxt);
        if (!has_next) nxt = cur;
        const char* nB = has_next ? S.b_tile(nxt) : cB;
        unsigned n00 = c00, n01 = c01, n10 = c10, n11 = c11;
        if (has_next) { n00 = S.a_off(nxt, 0, Rr[0]) + Cc[0]; n01 = S.a_off(nxt, 0, Rr[1]) + Cc[1]; n10 = S.a_off(nxt, 1, Rr[0]) + Cc[0]; n11 = S.a_off(nxt, 1, Rr[1]) + Cc[1]; }
#pragma nounroll
        for (int t = 0; t < nt; t += 2) {
            const bool last = (t == nt - 2);
            const char* a1 = A0 + (size_t)(t + 1) * kstep;
            const char* a2 = last ? A0 : A0 + (size_t)(t + 2) * kstep; const char* b2 = last ? nB : cB + (size_t)(t + 2) * kstep;
            const char* a3 = a2 + kstep; const char* b3 = b2 + kstep;
            unsigned x00 = c00, x01 = c01, x10 = c10, x11 = c11;
            if (last) { x00 = n00; x01 = n01; x10 = n10; x11 = n11; }
            PG8_LDB(B0, 0, 0); PG8_LDB(B1, 0, 1); PG8_SCHED; PG8_LDA(At, 0, 0); PG8_STAGE2(PG8_SA(1, 1), a1, c10, c11);
            PG8_WAIT_V(8); PG8_WAIT_L(0); PG8_BAR; PG8_MMA(0, 0, At, B0); PG8_MMA(0, 1, At, B1); PG8_BAR; PG8_SCHED;
            PG8_LDA(At, 0, 1); PG8_STAGEB(PG8_SB(0, 0), b2); PG8_STAGEB(PG8_SB(0, 1), b2 + hstep); PG8_STAGE2(PG8_SA(0, 0), a2, x00, x01);
            PG8_WAIT_V(8); PG8_WAIT_L(0); PG8_BAR; PG8_MMA(1, 0, At, B0); PG8_MMA(1, 1, At, B1); PG8_BAR; PG8_SCHED;
            PG8_LDB(B0, 1, 0); PG8_LDB(B1, 1, 1); PG8_SCHED; PG8_LDA(At, 1, 0); PG8_STAGE2(PG8_SA(0, 1), a2, x10, x11);
            PG8_WAIT_V(8); PG8_WAIT_L(0); PG8_BAR; PG8_MMA(0, 0, At, B0); PG8_MMA(0, 1, At, B1); PG8_BAR; PG8_SCHED;
            PG8_LDA(At, 1, 1); PG8_STAGEB(PG8_SB(1, 0), b3); PG8_STAGEB(PG8_SB(1, 1), b3 + hstep); PG8_STAGE2(PG8_SA(1, 0), a3, x00, x01);
            PG8_WAIT_V(8); PG8_WAIT_L(0); PG8_BAR; PG8_MMA(1, 0, At, B0); PG8_MMA(1, 1, At, B1); PG8_BAR; PG8_SCHED;
        }
        if constexpr (ALIGN_EPI) { if (wr == 0) PG8_BAR; }
        E(acc, cur, wr, wc, fr, fq);
        if (!has_next) break;
#pragma unroll
        for (int a = 0; a < 2; ++a)
#pragma unroll
            for (int b = 0; b < 2; ++b)
#pragma unroll
                for (int m = 0; m < 4; ++m)
#pragma unroll
                    for (int n = 0; n < 2; ++n) acc[a][b][m][n] = (f32x4){0.f, 0.f, 0.f, 0.f};
        cur = nxt; cB = nB; c00 = n00; c01 = n01; c10 = n10; c11 = n11; ++ui;
        if constexpr (ALIGN_EPI) { if (wr == 1) PG8_BAR; }
    }
    PG8_WAIT_V(0);
    if constexpr (!ALIGN_EPI) { if (wr == 0) PG8_BAR; }
    PG8_BAR;
#undef PG8_SA
#undef PG8_SB
#undef PG8_STAGE2
#undef PG8_STAGEB
#undef PG8_LDA
#undef PG8_LDB
#undef PG8_MMA
#undef PG8_WAIT_V
#undef PG8_WAIT_L
#undef PG8_BAR
#undef PG8_SCHED
}
}

struct Args { const float* in[25]; float* out; unsigned char* ws; int ph_lo, ph_hi; };
constexpr int NWAVES = 8, NTHR = 512;
struct Frame {
    LAS unsigned char* lds;
    volatile LAS unsigned* MISC;
    unsigned* ctl;
    unsigned char* ws;
    const float* const* in;
    float* out;
    int tid, lane, wave, G, bx;
};
enum { I_X = 0, I_C, I_WADA, I_BADA, I_N1G, I_WIN, I_CKVG, I_IKG, I_WUK, I_WUV, I_RELB, I_LBL, I_AOG, I_HOG, I_WOUT, I_N2G, I_WROUT, I_RBIAS, I_EG, I_EU, I_ED, I_SG, I_SU, I_SD, I_FNG };
#define WSP(T_, off) ((T_*)(F.ws + (off)))

struct SrcWin { const float* W; __device__ __forceinline__ float operator()(int k, int p) const {
    int o; if (p < 2304) o = p; else if (p < 6400) o = p + 80; else if (p < 6480) o = p - 4096; else return 0.f;
    return W[(size_t)k * 6480 + o]; } };
struct SrcPlain { const float* W; int N; __device__ __forceinline__ float operator()(int k, int n) const { return W[(size_t)k * N + n]; } };
struct SrcWkv { const float* W; const float* g; __device__ __forceinline__ float operator()(int k, int n) const { return W[(size_t)k * 128 + n] * g[k]; } };
struct SrcW1 { const float* Wg; const float* Wu; __device__ __forceinline__ float operator()(int k, int n) const {
    const int j = (n >> 3) * 4 + (n & 3); const unsigned long long a = (unsigned long long)Wg, bb = (unsigned long long)Wu, msk = 0ull - (unsigned long long)((n >> 2) & 1);
    const float* p = (const float*)(a ^ ((a ^ bb) & msk)); return p[(size_t)k * 512 + j]; } };
template <class Src> __device__ __forceinline__ void p0_tr_item(const Src& src, int K, int nblk, bf16_t* WT, int row_off, LAS float* scr, int item, int lane) {
    const int kb = item / nblk, nb = item % nblk, k0 = 64 * kb, n0 = 32 * nb;
#pragma unroll 8
    for (int i = 0; i < 32; ++i) { const int kk = 2 * i + (lane >> 5); scr[kk * 33 + (lane & 31)] = src(k0 + kk, n0 + (lane & 31)); }
    LDS_WAIT(); asm volatile("" ::: "memory");
    const int c = lane & 7;
#pragma unroll
    for (int j = 0; j < 4; ++j) { const int n = (lane >> 3) + 8 * j; const LAS float* s = scr + (8 * c) * 33 + n;
        u32x4 o; o.x = pk2(s[0 * 33], s[1 * 33]); o.y = pk2(s[2 * 33], s[3 * 33]); o.z = pk2(s[4 * 33], s[5 * 33]); o.w = pk2(s[6 * 33], s[7 * 33]);
        *(u32x4*)(WT + (size_t)(row_off + n0 + n) * K + k0 + 8 * c) = o; }
    LDS_WAIT(); asm volatile("" ::: "memory");
}
__device__ __forceinline__ void p0_prologue(Frame& F) {
    LAS float* scr = (LAS float*)(F.lds + F.wave * 16384);
    const int gw = F.bx * NWAVES + F.wave, NGW = F.G * NWAVES, lane = F.lane;
    constexpr int I_W1 = 65 * 1024, I_W2 = 65 * 512, I_WINI = 32 * 208, I_WO = 32 * 64, I_KV = 256, I_ADA = 768, I_RT = 256;
    constexpr int NITEMS = I_W1 + I_W2 + I_WINI + I_WO + I_KV + I_ADA + I_RT;
    for (int it = gw; it < NITEMS; it += NGW) {
        int r = it;
        if (r < I_W1) { const int e = r >> 10, rr = r & 1023;
            SrcW1 s; if (e < 64) { s.Wg = F.in[I_EG] + (size_t)e * 2048 * 512; s.Wu = F.in[I_EU] + (size_t)e * 2048 * 512; } else { s.Wg = F.in[I_SG]; s.Wu = F.in[I_SU]; }
            p0_tr_item(s, 2048, 32, WSP(bf16_t, WS_W1) + (size_t)e * 1024 * 2048, 0, scr, rr, lane); continue; } r -= I_W1;
        if (r < I_W2) { const int e = r >> 9, rr = r & 511;
            SrcPlain s; s.W = (e < 64) ? F.in[I_ED] + (size_t)e * 512 * 2048 : F.in[I_SD]; s.N = 2048;
            p0_tr_item(s, 512, 64, WSP(bf16_t, WS_W2) + (size_t)e * 2048 * 512, 0, scr, rr, lane); continue; } r -= I_W2;
        if (r < I_WINI) { SrcWin s; s.W = F.in[I_WIN]; p0_tr_item(s, 2048, 208, WSP(bf16_t, WS_WIN), 0, scr, r, lane); continue; } r -= I_WINI;
        if (r < I_WO) { SrcPlain s; s.W = F.in[I_WOUT]; s.N = 2048; p0_tr_item(s, 2048, 64, WSP(bf16_t, WS_WOUT), 0, scr, r, lane); continue; } r -= I_WO;
        if (r < I_KV) { const int kv = r >> 7, h = (r >> 4) & 7, rr = r & 15;
            SrcWkv s; s.W = F.in[kv ? I_WUV : I_WUK] + (size_t)h * 256 * 128; s.g = F.in[I_CKVG];
            p0_tr_item(s, 256, 4, WSP(bf16_t, WS_WKV), kv * 1024 + h * 128, scr, rr, lane); continue; } r -= I_KV;
        if (r < I_ADA) { const int ks = r / 48, cb = r % 48;
            const float* cc = F.in[I_C];
#pragma unroll
            for (int j = 0; j < 16; ++j) { const int b = lane >> 3, kk = (lane & 7) + 8 * j; const float v = cc[b * 2048 + ks * 128 + kk]; scr[b * 128 + kk] = v * sigmoidf_(v); }
            LDS_WAIT(); asm volatile("" ::: "memory");
            f32x4 acc[8];
#pragma unroll
            for (int b = 0; b < 8; ++b) acc[b] = (f32x4){0.f, 0.f, 0.f, 0.f};
            const float* wp = F.in[I_WADA] + (size_t)(ks * 128) * 12288 + cb * 256 + lane * 4;
#pragma unroll 4
            for (int k = 0; k < 128; ++k) { const f32x4 w = *(const f32x4*)(wp + (size_t)k * 12288);
#pragma unroll
                for (int b = 0; b < 8; ++b) acc[b] += w * scr[b * 128 + k]; }
            float* mp = WSP(float, WS_MODP) + (size_t)ks * 8 * 12288 + cb * 256 + lane * 4;
#pragma unroll
            for (int b = 0; b < 8; ++b) *(f32x4*)(mp + (size_t)b * 12288) = acc[b];
            LDS_WAIT(); asm volatile("" ::: "memory"); continue; } r -= I_ADA;
        if (r < I_RT) { const int s = r >> 2, nt = r & 3, n = lane & 15, g = lane >> 4; const float* wr_ = F.in[I_WROUT];
            float v[8]; unsigned hi[4], lo[4];
#pragma unroll
            for (int j = 0; j < 8; ++j) v[j] = wr_[(size_t)(32 * s + 8 * g + j) * 64 + 16 * nt + n];
#pragma unroll
            for (int j = 0; j < 4; ++j) { const unsigned h0 = f2bf(v[2 * j]), h1 = f2bf(v[2 * j + 1]); hi[j] = h0 | (h1 << 16);
                lo[j] = f2bf(v[2 * j] - bf1((bf16_t)h0)) | (f2bf(v[2 * j + 1] - bf1((bf16_t)h1)) << 16); }
            u32x4* o = WSP(u32x4, WS_WR) + (size_t)((s * 4 + nt) * 2) * 64 + lane;
            o[0] = (u32x4){hi[0], hi[1], hi[2], hi[3]}; o[64] = (u32x4){lo[0], lo[1], lo[2], lo[3]}; continue; }
    }
}
__device__ __forceinline__ void p0b_mod(Frame& F) {
    const float* mp = WSP(float, WS_MODP); float* mod = WSP(float, WS_MOD); const float* ba = F.in[I_BADA];
    for (int i = F.bx * NTHR + F.tid; i < 8 * 12288; i += F.G * NTHR) { float s = ba[i % 12288];
#pragma unroll
        for (int ks = 0; ks < 16; ++ks) s += mp[(size_t)ks * 8 * 12288 + i];
        mod[i] = s; }
}
__device__ __forceinline__ void p1_h1(Frame& F) {
    const int gw = F.bx * NWAVES + F.wave, NGW = F.G * NWAVES, lane = F.lane;
    const float* mod = WSP(float, WS_MOD); const float* g = F.in[I_N1G]; bf16_t* H1 = WSP(bf16_t, WS_H1);
#pragma nounroll
    for (int m = gw; m < T; m += NGW) { const int b = m >> 11;
        const f32x4* xr = (const f32x4*)(F.in[I_X] + (size_t)m * D) + lane;
        f32x4 v[8]; float s = 0.f;
#pragma unroll
        for (int j = 0; j < 8; ++j) { v[j] = xr[64 * j]; s += (v[j].x * v[j].x + v[j].y * v[j].y) + (v[j].z * v[j].z + v[j].w * v[j].w); }
        const float rstd = 1.f / sqrtf(wave_sum(s) * (1.f / D) + EPS);
        u32x2* o = (u32x2*)(H1 + (size_t)m * D) + lane;
#pragma unroll
        for (int j = 0; j < 8; ++j) { const int c = 4 * lane + 256 * j;
            const f32x4 gg = *(const f32x4*)(g + c), sc = *(const f32x4*)(mod + b * 12288 + 2048 + c), sh = *(const f32x4*)(mod + b * 12288 + c);
            const f32x4 h = v[j] * rstd * gg * (sc + 1.f) + sh;
            o[64 * j] = (u32x2){pk2(h.x, h.y), pk2(h.z, h.w)}; }
    }
}

struct EpiProj {
    static constexpr bool PERM = true;
    unsigned char* ws; const float* lbl;
    __device__ __forceinline__ void operator()(const f32x4 (&acc)[2][2][4][2], const pg8::Unit& u, int wr, int wc, int fr, int fq) const {
        const int pn = u.pn, row0 = u.pm * 256 + wr * 64 + fr, ct = 32 * wc + 8 * fq;
        if (pn < 4) {
            bf16_t* QA = (bf16_t*)(ws + WS_QA);
#pragma unroll
            for (int ai = 0; ai < 2; ++ai)
#pragma unroll
                for (int m = 0; m < 4; ++m) { const int row = row0 + ai * 128 + m * 16, b = row >> 11, s = row & 2047;
#pragma unroll
                    for (int bj = 0; bj < 2; ++bj) { const f32x4 v0 = acc[ai][bj][m][0], v1 = acc[ai][bj][m][1];
                        *(u32x4*)(QA + ((size_t)(b * 8 + 2 * pn + bj) * 2048 + s) * 128 + ct) = (u32x4){pk2(v0[0], v0[1]), pk2(v0[2], v0[3]), pk2(v1[0], v1[1]), pk2(v1[2], v1[3])}; } }
        } else if (pn == 4) {
            bf16_t* O = (bf16_t*)(ws + WS_CKV); float* SS = (float*)(ws + WS_CKVSS);
#pragma unroll
            for (int ai = 0; ai < 2; ++ai)
#pragma unroll
                for (int m = 0; m < 4; ++m) { const int row = row0 + ai * 128 + m * 16; float ss = 0.f;
#pragma unroll
                    for (int bj = 0; bj < 2; ++bj) { const f32x4 v0 = acc[ai][bj][m][0], v1 = acc[ai][bj][m][1];
                        ss += (v0[0] * v0[0] + v0[1] * v0[1]) + (v0[2] * v0[2] + v0[3] * v0[3]) + (v1[0] * v1[0] + v1[1] * v1[1]) + (v1[2] * v1[2] + v1[3] * v1[3]);
                        *(u32x4*)(O + (size_t)row * 256 + bj * 128 + ct) = (u32x4){pk2(v0[0], v0[1]), pk2(v0[2], v0[3]), pk2(v1[0], v1[1]), pk2(v1[2], v1[3])}; }
                    ss += __shfl_xor(ss, 16); ss += __shfl_xor(ss, 32);
                    if (fq == 0) SS[(size_t)row * 4 + wc] = ss; }
        } else if (pn >= 13 && pn < 17) {
            float* LF = (float*)(ws + WS_LOGF); bf16_t* KB = (bf16_t*)(ws + WS_KB); const int cb = (pn - 13) * 256 + ct;
            float lb[2][8];
#pragma unroll
            for (int bj = 0; bj < 2; ++bj)
#pragma unroll
                for (int i = 0; i < 8; ++i) { const int c = cb + bj * 128 + i; lb[bj][i] = sigmoidf_(lbl[c] - lbl[1024 + c]); }
#pragma unroll
            for (int ai = 0; ai < 2; ++ai)
#pragma unroll
                for (int m = 0; m < 4; ++m) { const int row = row0 + ai * 128 + m * 16;
#pragma unroll
                    for (int bj = 0; bj < 2; ++bj) { float f[8], lg[8];
#pragma unroll
                        for (int i = 0; i < 8; ++i) { const float a = acc[ai][bj][m][i >> 2][i & 3]; f[i] = lb[bj][i] + (1.f - lb[bj][i]) * sigmoidf_(a); lg[i] = __logf(f[i]); }
                        float* lp = LF + (size_t)row * 1024 + cb + bj * 128;
                        *(f32x4*)lp = (f32x4){lg[0], lg[1], lg[2], lg[3]}; *(f32x4*)(lp + 4) = (f32x4){lg[4], lg[5], lg[6], lg[7]};
                        *(u32x4*)(KB + (size_t)row * 1024 + cb + bj * 128) = (u32x4){pk2(1.f - f[0], 1.f - f[1]), pk2(1.f - f[2], 1.f - f[3]), pk2(1.f - f[4], 1.f - f[5]), pk2(1.f - f[6], 1.f - f[7])}; } }
        } else if (pn == 25) {
            bf16_t* IK = (bf16_t*)(ws + WS_IK); float* IW = (float*)(ws + WS_IW);
#pragma unroll
            for (int ai = 0; ai < 2; ++ai)
#pragma unroll
                for (int m = 0; m < 4; ++m) { const int row = row0 + ai * 128 + m * 16; const f32x4 v0 = acc[ai][0][m][0], v1 = acc[ai][0][m][1];
                    if (wc < 2) *(u32x4*)(IK + (size_t)row * 64 + ct) = (u32x4){pk2(v0[0], v0[1]), pk2(v0[2], v0[3]), pk2(v1[0], v1[1]), pk2(v1[2], v1[3])};
                    else if (wc == 2 && fq < 2) { float* p = IW + (size_t)row * 16 + 8 * fq; *(f32x4*)p = v0 * 0.03125f; *(f32x4*)(p + 4) = v1 * 0.03125f; } }
        } else {
            size_t off; int t0; bool gate = false;
            if (pn < 9) { off = WS_IQ; t0 = 5; } else if (pn < 13) { off = WS_QB; t0 = 9; } else if (pn < 21) { off = WS_IB; t0 = 17; } else { off = WS_GB; t0 = 21; gate = true; }
            bf16_t* O = (bf16_t*)(ws + off); const int cb = (pn - t0) * 256 + ct;
#pragma unroll
            for (int ai = 0; ai < 2; ++ai)
#pragma unroll
                for (int m = 0; m < 4; ++m) { const int row = row0 + ai * 128 + m * 16;
#pragma unroll
                    for (int bj = 0; bj < 2; ++bj) { f32x4 v0 = acc[ai][bj][m][0], v1 = acc[ai][bj][m][1];
                        if (gate) {
#pragma unroll
                            for (int i = 0; i < 4; ++i) { v0[i] = v0[i] * sigmoidf_(v0[i]); v1[i] = v1[i] * sigmoidf_(v1[i]); } }
                        *(u32x4*)(O + (size_t)row * 1024 + cb + bj * 128) = (u32x4){pk2(v0[0], v0[1]), pk2(v0[2], v0[3]), pk2(v1[0], v1[1]), pk2(v1[2], v1[3])}; } }
        }
    }
};
struct EpiKV {
    static constexpr bool PERM = true;
    unsigned char* ws;
    __device__ __forceinline__ void operator()(const f32x4 (&acc)[2][2][4][2], const pg8::Unit& u, int wr, int wc, int fr, int fq) const {
        const int pn = u.pn, row0 = u.pm * 256 + wr * 64 + fr, ct = 32 * wc + 8 * fq;
        bf16_t* O = (bf16_t*)(ws + (pn < 4 ? WS_K : WS_V)); const float* SS = (const float*)(ws + WS_CKVSS); const int hp = (pn & 3) * 2;
#pragma unroll
        for (int ai = 0; ai < 2; ++ai)
#pragma unroll
            for (int m = 0; m < 4; ++m) { const int row = row0 + ai * 128 + m * 16, b = row >> 11, s = row & 2047;
                const f32x4 q = *(const f32x4*)(SS + (size_t)row * 4); const float rstd = 1.f / sqrtf(((q[0] + q[1]) + (q[2] + q[3])) * (1.f / 256.f) + EPS);
#pragma unroll
                for (int bj = 0; bj < 2; ++bj) { const f32x4 v0 = acc[ai][bj][m][0] * rstd, v1 = acc[ai][bj][m][1] * rstd;
                    *(u32x4*)(O + ((size_t)(b * 8 + hp + bj) * 2048 + s) * 128 + ct) = (u32x4){pk2(v0[0], v0[1]), pk2(v0[2], v0[3]), pk2(v1[0], v1[1]), pk2(v1[2], v1[3])}; } }
    }
};
struct EpiOut {
    static constexpr bool PERM = false;
    const float* x; float* x1; const float* mod;
    __device__ __forceinline__ void operator()(const f32x4 (&acc)[2][2][4][2], const pg8::Unit& u, int wr, int wc, int fr, int fq) const {
        const int row0 = u.pm * 256 + wr * 64 + fr, col0 = u.pn * 256 + wc * 32 + 4 * fq, b = (u.pm * 256) >> 11;
        f32x4 g1[2][2];
#pragma unroll
        for (int bj = 0; bj < 2; ++bj)
#pragma unroll
            for (int n = 0; n < 2; ++n) g1[bj][n] = *(const f32x4*)(mod + b * 12288 + 4096 + col0 + bj * 128 + n * 16);
#pragma unroll
        for (int ai = 0; ai < 2; ++ai)
#pragma unroll
            for (int m = 0; m < 4; ++m) { const size_t off = (size_t)(row0 + ai * 128 + m * 16) * 2048 + col0;
#pragma unroll
                for (int bj = 0; bj < 2; ++bj)
#pragma unroll
                    for (int n = 0; n < 2; ++n) { const f32x4 xv = *(const f32x4*)(x + off + bj * 128 + n * 16);
                        *(f32x4*)(x1 + off + bj * 128 + n * 16) = xv + g1[bj][n] * acc[ai][bj][m][n]; }
                asm volatile("" ::: "memory"); }
    }
};

__device__ __forceinline__ void p3_indexer(Frame& F, int first_uid_dummy) {
    (void)first_uid_dummy;
    const int tid = F.tid, lane = F.lane, w = F.wave, c = lane & 31, half = lane >> 5;
    const bf16_t* IQ = WSP(bf16_t, WS_IQ); const bf16_t* IK = WSP(bf16_t, WS_IK); const float* IW = WSP(float, WS_IW); unsigned* MASK = WSP(unsigned, WS_MASK);
    const float NEG = -__builtin_inff();
    float gk[8];
#pragma unroll
    for (int j = 0; j < 8; ++j) gk[j] = F.in[I_IKG][8 * (tid & 7) + j];
    const int sw = (c >> 1) & 7;
    int boff[4];
#pragma unroll
    for (int s = 0; s < 4; ++s) boff[s] = c * 128 + (((2 * s + half) ^ sw) * 16);
    for (;;) {
        __syncthreads();
        if (tid == 0) F.MISC[16] = __hip_atomic_fetch_add(F.ctl + CW_IDXQ, 1u, RLX_AGENT);
        __syncthreads();
        const int uid = (int)F.MISC[16];
        if (uid >= 1024) break;
        const int b = uid & 7, q0 = (127 - (uid >> 3)) * 16, nkeys = q0 + 16, qmax = q0 + 15;
        const int myq = q0 + 2 * w + half;
        bf16x8 Af[4];
        { const int sel = (c >> 2) & 1, head = (c & 3) + 4 * (c >> 3);
          const bf16_t* p = IQ + (size_t)(b * 2048 + q0 + 2 * w + sel) * 1024 + head * 64 + 8 * half;
#pragma unroll
          for (int s = 0; s < 4; ++s) Af[s] = *(const bf16x8*)(p + 16 * s); }
        float wv[16];
        { const f32x4* p = (const f32x4*)(IW + (size_t)(b * 2048 + myq) * 16);
#pragma unroll
          for (int i = 0; i < 4; ++i) { const f32x4 t = p[i]; wv[4 * i] = t[0]; wv[4 * i + 1] = t[1]; wv[4 * i + 2] = t[2]; wv[4 * i + 3] = t[3]; } }
        float v[64];
#pragma unroll
        for (int kt = 0; kt < 64; ++kt) v[kt] = NEG;
#pragma unroll
        for (int pass = 0; pass < 2; ++pass) {
            if (pass * 1024 < nkeys) {
                if (pass) __syncthreads();
                const int klo = pass * 1024, n = (nkeys - klo) < 1024 ? (nkeys - klo) : 1024;
                for (int it = 0; it * 64 < n; ++it) {
                    const int kk = it * 64 + (tid >> 3), ch = tid & 7; float x[8]; float ss = 0.f;
                    if (kk < n) { const u32x4 r = *(const u32x4*)(IK + (size_t)(b * 2048 + klo + kk) * 64 + 8 * ch);
                        x[0] = bflo(r.x); x[1] = bfhi(r.x); x[2] = bflo(r.y); x[3] = bfhi(r.y); x[4] = bflo(r.z); x[5] = bfhi(r.z); x[6] = bflo(r.w); x[7] = bfhi(r.w);
#pragma unroll
                        for (int j = 0; j < 8; ++j) ss += x[j] * x[j]; }
                    else {
#pragma unroll
                        for (int j = 0; j < 8; ++j) x[j] = 0.f; }
                    ss += __shfl_xor(ss, 1); ss += __shfl_xor(ss, 2); ss += __shfl_xor(ss, 4);
                    const float rstd = 1.f / sqrtf(ss * (1.f / 64.f) + EPS);
                    if (kk < n) { u32x4 o; o.x = pk2(x[0] * rstd * gk[0], x[1] * rstd * gk[1]); o.y = pk2(x[2] * rstd * gk[2], x[3] * rstd * gk[3]);
                        o.z = pk2(x[4] * rstd * gk[4], x[5] * rstd * gk[5]); o.w = pk2(x[6] * rstd * gk[6], x[7] * rstd * gk[7]);
                        *(LAS u32x4*)(F.lds + kk * 128 + ((ch ^ ((kk >> 1) & 7)) * 16)) = o; }
                }
                __syncthreads();
#pragma unroll
                for (int kl = 0; kl < 32; ++kl) { const int kt = pass * 32 + kl;
                    if (32 * kt <= qmax) {
                        f32x16 acc = {};
#pragma unroll
                        for (int s = 0; s < 4; ++s) { const bf16x8 bfr = *(const LAS bf16x8*)(F.lds + boff[s] + kl * 4096);
                            acc = __builtin_amdgcn_mfma_f32_32x32x16_bf16(Af[s], bfr, acc, 0, 0, 0); }
                        float sc = 0.f;
#pragma unroll
                        for (int i = 0; i < 16; ++i) sc = fmaf(wv[i], fmaxf(acc[i], 0.f), sc);
                        v[kt] = (32 * kt + c <= myq) ? sc : NEG;
                    }
                }
            }
        }
        float tau = -3.0e38f;
        if (qmax + 1 > TOPK) {
            float mx = NEG, mn = __builtin_inff();
#pragma unroll
            for (int kt = 0; kt < 64; ++kt) { mx = fmaxf(mx, v[kt]); mn = fminf(mn, v[kt] == NEG ? __builtin_inff() : v[kt]); }
#pragma unroll
            for (int o = 1; o < 32; o <<= 1) { mx = fmaxf(mx, __shfl_xor(mx, o)); mn = fminf(mn, __shfl_xor(mn, o)); }
            float lo = mn, hi = mx; bool done = (myq + 1 <= TOPK);
            for (int iter = 0; iter < 64; ++iter) {
                const float mid = 0.5f * lo + 0.5f * hi;
                if (!done && !(mid > lo && mid < hi)) { done = true; tau = lo; }
                if (__all(done)) break;
                int cnt = 0;
#pragma unroll
                for (int kt = 0; kt < 64; ++kt) cnt += (v[kt] >= mid) ? 1 : 0;
#pragma unroll
                for (int o = 1; o < 32; o <<= 1) cnt += __shfl_xor(cnt, o);
                if (!done) { if (cnt == TOPK) { done = true; tau = mid; } else if (cnt > TOPK) lo = mid; else hi = mid; }
            }
            if (!done) tau = lo;
        }
        int mA = 0, mB = 0;
#define IDX_WL(kt) { const unsigned long long m_ = __ballot(v[kt] >= tau); wlane<kt>(mA, (int)(unsigned)m_); wlane<kt>(mB, (int)(unsigned)(m_ >> 32)); }
#define IDX_WL8(k0) IDX_WL(k0) IDX_WL(k0 + 1) IDX_WL(k0 + 2) IDX_WL(k0 + 3) IDX_WL(k0 + 4) IDX_WL(k0 + 5) IDX_WL(k0 + 6) IDX_WL(k0 + 7) __builtin_amdgcn_sched_barrier(0);
        IDX_WL8(0) IDX_WL8(8) IDX_WL8(16) IDX_WL8(24) IDX_WL8(32) IDX_WL8(40) IDX_WL8(48) IDX_WL8(56)
#undef IDX_WL8
#undef IDX_WL
        MASK[(size_t)(b * 2048 + q0 + 2 * w) * 64 + lane] = (unsigned)mA;
        MASK[(size_t)(b * 2048 + q0 + 2 * w + 1) * 64 + lane] = (unsigned)mB;
    }
}

constexpr int HG_PITCH = 272, HG_QD = 0, HG_KI = 16 * HG_PITCH, HG_KDT = 2 * 16 * HG_PITCH, HG_VT = HG_KDT + 4096, HG_DL = HG_VT + 4096, HG_BUF = HG_DL + 512;
__device__ __forceinline__ void p3_hgrn(Frame& F, int bh) {
    const int tid = F.tid, lane = F.lane, w = F.wave, r = lane & 15, g = lane >> 4;
    const int b = bh >> 3, h = bh & 7;
    const float* LOGF = WSP(float, WS_LOGF); const bf16_t* QB = WSP(bf16_t, WS_QB); const bf16_t* KBp = WSP(bf16_t, WS_KB); const bf16_t* IB = WSP(bf16_t, WS_IB); float* HO = WSP(float, WS_HO);
    const int pc = 16 * w + r;
    const size_t colbase = (size_t)h * 128;
    f32x4 S[8];
#pragma unroll
    for (int m = 0; m < 8; ++m) S[m] = (f32x4){0.f, 0.f, 0.f, 0.f};
    float lf[4]; bf16_t qq[4], kk[4]; u32x2 vraw;
#define HG_LOAD(ci) do { const size_t row0 = (size_t)b * 2048 + (ci) * 16; \
        _Pragma("unroll") for (int j = 0; j < 4; ++j) { const size_t o = (row0 + 4 * g + j) * 1024 + colbase + pc; lf[j] = LOGF[o]; qq[j] = QB[o]; kk[j] = KBp[o]; } \
        vraw = *(const u32x2*)(IB + (row0 + (tid >> 5)) * 1024 + colbase + (tid & 31) * 4); } while (0)
#define HG_WRITE(buf) do { LAS unsigned char* L = F.lds + (buf) * HG_BUF; \
        float c0 = lf[0], c1 = c0 + lf[1], c2 = c1 + lf[2], c3 = c2 + lf[3]; \
        const float t0_ = __shfl(c3, r), t1_ = __shfl(c3, r + 16), t2_ = __shfl(c3, r + 32), t3_ = __shfl(c3, r + 48); \
        const float pre = (g > 0 ? t0_ : 0.f) + (g > 1 ? t1_ : 0.f) + (g > 2 ? t2_ : 0.f); const float blast = (t0_ + t1_) + (t2_ + t3_); \
        const float dd = __expf(blast); float bc[4] = {pre + c0, pre + c1, pre + c2, pre + c3}; unsigned kd[4]; \
        _Pragma("unroll") for (int j = 0; j < 4; ++j) { const float e1 = __expf(bc[j]), e3 = 1.f / e1; const float qv = bf1(qq[j]), kv = bf1(kk[j]); const int t = 4 * g + j; \
            *(LAS bf16_t*)(L + HG_QD + t * HG_PITCH + pc * 2) = (bf16_t)f2bf(qv * e1); *(LAS bf16_t*)(L + HG_KI + t * HG_PITCH + pc * 2) = (bf16_t)f2bf(kv * e3); kd[j] = f2bf(kv * dd * e3); } \
        *(LAS u32x2*)(L + HG_KDT + pc * 32 + g * 8) = (u32x2){kd[0] | (kd[1] << 16), kd[2] | (kd[3] << 16)}; \
        if (g == 0) *(LAS float*)(L + HG_DL + pc * 4) = dd; \
        { const int t = tid >> 5, v4 = (tid & 31) * 4; LAS bf16_t* vt = (LAS bf16_t*)(L + HG_VT); \
          vt[(v4 + 0) * 16 + t] = (bf16_t)(vraw.x & 0xffffu); vt[(v4 + 1) * 16 + t] = (bf16_t)(vraw.x >> 16); vt[(v4 + 2) * 16 + t] = (bf16_t)(vraw.y & 0xffffu); vt[(v4 + 3) * 16 + t] = (bf16_t)(vraw.y >> 16); } } while (0)
    HG_LOAD(0); HG_WRITE(0);
    __syncthreads();
    for (int ci = 0; ci < 128; ++ci) {
        const int buf = ci & 1; LAS unsigned char* L = F.lds + buf * HG_BUF;
        if (ci + 1 < 128) HG_LOAD(ci + 1);
        f32x4 sT = (f32x4){0.f, 0.f, 0.f, 0.f};
#pragma unroll
        for (int i = 0; i < 4; ++i) { const bf16x8 a = *(const LAS bf16x8*)(L + HG_KI + r * HG_PITCH + (32 * i + 8 * g) * 2), bq = *(const LAS bf16x8*)(L + HG_QD + r * HG_PITCH + (32 * i + 8 * g) * 2);
            sT = __builtin_amdgcn_mfma_f32_16x16x32_bf16(a, bq, sT, 0, 0, 0); }
#pragma unroll
        for (int j = 0; j < 4; ++j) if (4 * g + j > r) sT[j] = 0.f;
        const u32x4 pw = {pk2(sT[0], sT[1]), pk2(sT[2], sT[3]), 0u, 0u};
        const bf16x8 pfrag = __builtin_bit_cast(bf16x8, pw);
        const u32x2 vi = *(const LAS u32x2*)(L + HG_VT + (16 * w + r) * 32 + g * 8);
        const u32x4 viw = {vi.x, vi.y, 0u, 0u};
        f32x4 oT = __builtin_amdgcn_mfma_f32_16x16x32_bf16(__builtin_bit_cast(bf16x8, viw), pfrag, (f32x4){0.f, 0.f, 0.f, 0.f}, 0, 0, 0);
#pragma unroll
        for (int i = 0; i < 4; ++i) { const u32x4 sa = {pk2(S[2 * i][0], S[2 * i][1]), pk2(S[2 * i][2], S[2 * i][3]), pk2(S[2 * i + 1][0], S[2 * i + 1][1]), pk2(S[2 * i + 1][2], S[2 * i + 1][3])};
            const u32x2 q0 = *(const LAS u32x2*)(L + HG_QD + r * HG_PITCH + (32 * i + 4 * g) * 2), q1 = *(const LAS u32x2*)(L + HG_QD + r * HG_PITCH + (32 * i + 16 + 4 * g) * 2);
            const u32x4 qb = {q0.x, q0.y, q1.x, q1.y};
            oT = __builtin_amdgcn_mfma_f32_16x16x32_bf16(__builtin_bit_cast(bf16x8, sa), __builtin_bit_cast(bf16x8, qb), oT, 0, 0, 0); }
        *(f32x4*)(HO + ((size_t)b * 2048 + ci * 16 + r) * 1024 + colbase + 16 * w + 4 * g) = oT;
        u32x4 vb = {0u, 0u, 0u, 0u};
        if (g < 2) vb = *(const LAS u32x4*)(L + HG_VT + (16 * w + r) * 32 + g * 16);
#pragma unroll
        for (int m = 0; m < 8; ++m) { const f32x4 dv = *(const LAS f32x4*)(L + HG_DL + (16 * m + 4 * g) * 4);
            u32x4 ka = {0u, 0u, 0u, 0u};
            if (g < 2) ka = *(const LAS u32x4*)(L + HG_KDT + (16 * m + r) * 32 + g * 16);
            S[m] = __builtin_amdgcn_mfma_f32_16x16x32_bf16(__builtin_bit_cast(bf16x8, ka), __builtin_bit_cast(bf16x8, vb), S[m] * dv, 0, 0, 0); }
        if (ci + 1 < 128) HG_WRITE(buf ^ 1);
        __syncthreads();
    }
#undef HG_LOAD
#undef HG_WRITE
}

__device__ __forceinline__ int t5_bucket(int n) {
    if (n < 16) return n;
    int l = 16 + (int)(logf((float)n * (1.f / 16.f)) / logf(8.f) * 16.f);
    return l < 31 ? l : 31;
}
__device__ __forceinline__ void p4_attn_naive(Frame& F) {
    const int lane = F.lane, w = F.wave, gw = F.bx * NWAVES + w, NGW = F.G * NWAVES;
    LAS int* list = (LAS int*)(F.lds + w * 4096); LAS float* pl = (LAS float*)(F.lds + w * 4096 + 1024); LAS float* ql = (LAS float*)(F.lds + w * 4096 + 2048);
    const unsigned* MASK = WSP(unsigned, WS_MASK); const bf16_t* QA = WSP(bf16_t, WS_QA); const bf16_t* Kp = WSP(bf16_t, WS_K); const bf16_t* Vp = WSP(bf16_t, WS_V); bf16_t* AO = WSP(bf16_t, WS_AO);
    const float* relb = F.in[I_RELB];
#pragma nounroll
    for (int item = gw; item < T; item += NGW) { const int b = item >> 11, q = item & 2047;
        unsigned mw = MASK[(size_t)item * 64 + lane];
        const int cnt = __popc(mw); int pre = cnt;
#pragma unroll
        for (int o = 1; o < 64; o <<= 1) { const int t = __shfl_up(pre, o); if (lane >= o) pre += t; }
        int nsel = __shfl(pre, 63); int pos = pre - cnt; if (nsel > 256) nsel = 256;
        while (mw) { const int bit = __builtin_ctz(mw); if (pos < 256) list[pos] = lane * 32 + bit; ++pos; mw &= mw - 1; }
        LDS_WAIT(); asm volatile("" ::: "memory");
        for (int h = 0; h < 8; ++h) { const size_t hb = (size_t)(b * 8 + h) * 2048;
            { const unsigned qv = *(const unsigned*)(QA + (hb + q) * 128 + 2 * lane); ql[2 * lane] = bflo(qv); ql[2 * lane + 1] = bfhi(qv); }
            LDS_WAIT(); asm volatile("" ::: "memory");
            float sc[4]; float mx = -__builtin_inff();
#pragma unroll
            for (int jj = 0; jj < 4; ++jj) { const int idx = lane + 64 * jj; sc[jj] = -__builtin_inff();
                if (idx < nsel) { const int key = list[idx]; const u32x4* kp = (const u32x4*)(Kp + (hb + key) * 128); float s = 0.f;
#pragma unroll
                    for (int ch = 0; ch < 16; ++ch) { const u32x4 kv = kp[ch]; const f32x4 qa = *(const LAS f32x4*)(ql + 8 * ch), qb = *(const LAS f32x4*)(ql + 8 * ch + 4);
                        s += bflo(kv.x) * qa[0] + bfhi(kv.x) * qa[1] + bflo(kv.y) * qa[2] + bfhi(kv.y) * qa[3] + bflo(kv.z) * qb[0] + bfhi(kv.z) * qb[1] + bflo(kv.w) * qb[2] + bfhi(kv.w) * qb[3]; }
                    sc[jj] = s * ATT_SCALE + relb[t5_bucket(q - key > 0 ? q - key : 0) * 8 + h]; }
                mx = fmaxf(mx, sc[jj]); }
#pragma unroll
            for (int o = 1; o < 64; o <<= 1) mx = fmaxf(mx, __shfl_xor(mx, o));
            float ls = 0.f;
#pragma unroll
            for (int jj = 0; jj < 4; ++jj) { const int idx = lane + 64 * jj; const float p = (idx < nsel) ? __expf(sc[jj] - mx) : 0.f; ls += p; pl[idx] = p; }
            ls = wave_sum(ls);
            LDS_WAIT(); asm volatile("" ::: "memory");
            const int dg = lane & 15, kg = lane >> 4; float o[8];
#pragma unroll
            for (int i = 0; i < 8; ++i) o[i] = 0.f;
#pragma unroll 4
            for (int i0 = 0; i0 < nsel; i0 += 4) { const int i = i0 + kg;
                if (i < nsel) { const int key = list[i]; const float p = pl[i]; const u32x4 vv = *(const u32x4*)(Vp + (hb + key) * 128 + 8 * dg);
                    o[0] += p * bflo(vv.x); o[1] += p * bfhi(vv.x); o[2] += p * bflo(vv.y); o[3] += p * bfhi(vv.y); o[4] += p * bflo(vv.z); o[5] += p * bfhi(vv.z); o[6] += p * bflo(vv.w); o[7] += p * bfhi(vv.w); } }
            const float inv = 1.f / ls;
#pragma unroll
            for (int i = 0; i < 8; ++i) { o[i] += __shfl_xor(o[i], 16); o[i] += __shfl_xor(o[i], 32); o[i] *= inv; }
            if (kg == 0) *(u32x4*)(AO + (hb + q) * 128 + 8 * dg) = (u32x4){pk2(o[0], o[1]), pk2(o[2], o[3]), pk2(o[4], o[5]), pk2(o[6], o[7])};
            LDS_WAIT(); asm volatile("" ::: "memory");
        }
    }
}

__device__ __forceinline__ void p5_finalize(Frame& F) {
    const int lane = F.lane, gw = F.bx * NWAVES + F.wave, NGW = F.G * NWAVES;
    const bf16_t* AO = WSP(bf16_t, WS_AO); const float* HO = WSP(float, WS_HO); const bf16_t* GB = WSP(bf16_t, WS_GB); bf16_t* A2 = WSP(bf16_t, WS_A2);
    const float* ag = F.in[I_AOG]; const float* hg = F.in[I_HOG];
#pragma nounroll
    for (int m = gw; m < T; m += NGW) { const int b = m >> 11, s = m & 2047;
        const int hh = lane >> 3, c0 = 16 * (lane & 7);
        const u32x4* ap = (const u32x4*)(AO + ((size_t)(b * 8 + hh) * 2048 + s) * 128 + c0);
        const u32x4 a0 = ap[0], a1 = ap[1]; float av[16];
        av[0] = bflo(a0.x); av[1] = bfhi(a0.x); av[2] = bflo(a0.y); av[3] = bfhi(a0.y); av[4] = bflo(a0.z); av[5] = bfhi(a0.z); av[6] = bflo(a0.w); av[7] = bfhi(a0.w);
        av[8] = bflo(a1.x); av[9] = bfhi(a1.x); av[10] = bflo(a1.y); av[11] = bfhi(a1.y); av[12] = bflo(a1.z); av[13] = bfhi(a1.z); av[14] = bflo(a1.w); av[15] = bfhi(a1.w);
        float ss = 0.f;
#pragma unroll
        for (int i = 0; i < 16; ++i) ss += av[i] * av[i];
        const float rstd = 1.f / sqrtf(wave_sum(ss) * (1.f / 1024.f) + EPS);
        unsigned ow[8];
#pragma unroll
        for (int i = 0; i < 8; ++i) ow[i] = pk2(av[2 * i] * rstd * ag[16 * lane + 2 * i], av[2 * i + 1] * rstd * ag[16 * lane + 2 * i + 1]);
        u32x4* op = (u32x4*)(A2 + (size_t)m * 2048 + 16 * lane);
        op[0] = (u32x4){ow[0], ow[1], ow[2], ow[3]}; op[1] = (u32x4){ow[4], ow[5], ow[6], ow[7]};
        const f32x4* hp = (const f32x4*)(HO + (size_t)m * 1024 + 16 * lane); float hv[16];
#pragma unroll
        for (int i = 0; i < 4; ++i) { const f32x4 t = hp[i]; hv[4 * i] = t[0]; hv[4 * i + 1] = t[1]; hv[4 * i + 2] = t[2]; hv[4 * i + 3] = t[3]; }
        float s2 = 0.f;
#pragma unroll
        for (int i = 0; i < 16; ++i) s2 += hv[i] * hv[i];
        s2 += __shfl_xor(s2, 1); s2 += __shfl_xor(s2, 2); s2 += __shfl_xor(s2, 4);
        const float r2 = 1.f / sqrtf(s2 * (1.f / 128.f) + EPS);
        const u32x4* gp = (const u32x4*)(GB + (size_t)m * 1024 + 16 * lane); const u32x4 g0 = gp[0], g1 = gp[1]; float gv[16];
        gv[0] = bflo(g0.x); gv[1] = bfhi(g0.x); gv[2] = bflo(g0.y); gv[3] = bfhi(g0.y); gv[4] = bflo(g0.z); gv[5] = bfhi(g0.z); gv[6] = bflo(g0.w); gv[7] = bfhi(g0.w);
        gv[8] = bflo(g1.x); gv[9] = bfhi(g1.x); gv[10] = bflo(g1.y); gv[11] = bfhi(g1.y); gv[12] = bflo(g1.z); gv[13] = bfhi(g1.z); gv[14] = bflo(g1.w); gv[15] = bfhi(g1.w);
#pragma unroll
        for (int i = 0; i < 8; ++i) ow[i] = pk2(hv[2 * i] * r2 * hg[16 * lane + 2 * i] * gv[2 * i], hv[2 * i + 1] * r2 * hg[16 * lane + 2 * i + 1] * gv[2 * i + 1]);
        op = (u32x4*)(A2 + (size_t)m * 2048 + 1024 + 16 * lane);
        op[0] = (u32x4){ow[0], ow[1], ow[2], ow[3]}; op[1] = (u32x4){ow[4], ow[5], ow[6], ow[7]};
    }
}

constexpr int R_GM = 0, R_SH = 8192, R_LG = 16384, R_SC = 32768, R_HIST = 49152, R_BASE = 49408;
__device__ __forceinline__ void p7_router(Frame& F) {
    const int tid = F.tid, lane = F.lane, w = F.wave, r = lane & 15, g = lane >> 4;
    const float* X1 = WSP(float, WS_X1); const float* mod = WSP(float, WS_MOD); const float* n2g = F.in[I_N2G]; const float* rbias = F.in[I_RBIAS];
    bf16_t* H2 = WSP(bf16_t, WS_H2); const u32x4* WR = WSP(u32x4, WS_WR);
    int* LTOK = WSP(int, WS_LTOK); int* LDSTp = WSP(int, WS_LDST); float* LWp = WSP(float, WS_LW);
    LAS float* GM = (LAS float*)(F.lds + R_GM); LAS float* SH = (LAS float*)(F.lds + R_SH); LAS float* LG = (LAS float*)(F.lds + R_LG); LAS float* SC = (LAS float*)(F.lds + R_SC);
    LAS int* HIST = (LAS int*)(F.lds + R_HIST); LAS int* BASE = (LAS int*)(F.lds + R_BASE);
    if (F.bx == 0 && tid < 256) WSP(u32x4, WS_H2 + (size_t)T * 2048 * 2)[tid] = (u32x4){0u, 0u, 0u, 0u};
    for (int unit = F.bx; unit < T / 64; unit += F.G) {
        const int tok0 = unit * 64, b = tok0 >> 11;
        __syncthreads();
        for (int i = tid; i < 2048; i += NTHR) { GM[i] = n2g[i] * (1.f + mod[b * 12288 + 8192 + i]); SH[i] = mod[b * 12288 + 6144 + i]; }
        if (tid < 64) HIST[tid] = 0;
        __syncthreads();
        const int row = tok0 + 8 * w + (r & 7);
        const float* xr = X1 + (size_t)row * 2048 + 8 * g;
        float ss = 0.f;
#pragma unroll 8
        for (int s = 0; s < 64; ++s) { const f32x4 a = *(const f32x4*)(xr + 32 * s), c = *(const f32x4*)(xr + 32 * s + 4);
            ss += (a[0] * a[0] + a[1] * a[1]) + (a[2] * a[2] + a[3] * a[3]) + (c[0] * c[0] + c[1] * c[1]) + (c[2] * c[2] + c[3] * c[3]); }
        ss += __shfl_xor(ss, 16); ss += __shfl_xor(ss, 32);
        const float rstd = 1.f / sqrtf(ss * (1.f / 2048.f) + EPS);
        f32x4 acc[4];
#pragma unroll
        for (int nt = 0; nt < 4; ++nt) acc[nt] = (f32x4){0.f, 0.f, 0.f, 0.f};
#pragma unroll 2
        for (int s = 0; s < 64; ++s) { const int k0 = 32 * s + 8 * g;
            const f32x4 a = *(const f32x4*)(xr + 32 * s), c = *(const f32x4*)(xr + 32 * s + 4);
            const f32x4 g0 = *(const LAS f32x4*)(GM + k0), g1 = *(const LAS f32x4*)(GM + k0 + 4), s0 = *(const LAS f32x4*)(SH + k0), s1 = *(const LAS f32x4*)(SH + k0 + 4);
            const f32x4 h0 = a * rstd * g0 + s0, h1 = c * rstd * g1 + s1;
            unsigned hi[4], lo[4];
#pragma unroll
            for (int j = 0; j < 2; ++j) { const unsigned p0 = f2bf(h0[2 * j]), p1 = f2bf(h0[2 * j + 1]); hi[j] = p0 | (p1 << 16); lo[j] = pk2(h0[2 * j] - bf1((bf16_t)p0), h0[2 * j + 1] - bf1((bf16_t)p1)); }
#pragma unroll
            for (int j = 0; j < 2; ++j) { const unsigned p0 = f2bf(h1[2 * j]), p1 = f2bf(h1[2 * j + 1]); hi[2 + j] = p0 | (p1 << 16); lo[2 + j] = pk2(h1[2 * j] - bf1((bf16_t)p0), h1[2 * j + 1] - bf1((bf16_t)p1)); }
            const u32x4 hiw = {hi[0], hi[1], hi[2], hi[3]}, low = {lo[0], lo[1], lo[2], lo[3]};
            if (r < 8) *(u32x4*)(H2 + (size_t)row * 2048 + k0) = hiw;
            const bf16x8 ah = __builtin_bit_cast(bf16x8, hiw), al = __builtin_bit_cast(bf16x8, low);
#pragma unroll
            for (int nt = 0; nt < 4; ++nt) { const u32x4 bh = WR[(size_t)((s * 4 + nt) * 2) * 64 + lane], bl = WR[(size_t)((s * 4 + nt) * 2 + 1) * 64 + lane];
                acc[nt] = __builtin_amdgcn_mfma_f32_16x16x32_bf16(ah, __builtin_bit_cast(bf16x8, bh), acc[nt], 0, 0, 0);
                acc[nt] = __builtin_amdgcn_mfma_f32_16x16x32_bf16(al, __builtin_bit_cast(bf16x8, bh), acc[nt], 0, 0, 0);
                acc[nt] = __builtin_amdgcn_mfma_f32_16x16x32_bf16(ah, __builtin_bit_cast(bf16x8, bl), acc[nt], 0, 0, 0); }
        }
        if (g < 2) {
#pragma unroll
            for (int nt = 0; nt < 4; ++nt)
#pragma unroll
                for (int j = 0; j < 4; ++j) LG[(w * 8 + 4 * g + j) * 64 + 16 * nt + r] = acc[nt][j]; }
        LDS_WAIT(); asm volatile("" ::: "memory");
        int ee[8], lp[8]; float ww[8];
        if (lane < 8) { const int base = (w * 8 + lane) * 64;
            for (int e = 0; e < 64; ++e) SC[base + e] = sigmoidf_(LG[base + e]);
            float grp[8];
#pragma unroll
            for (int gg = 0; gg < 8; ++gg) { float m1 = -__builtin_inff(), m2 = -__builtin_inff();
                for (int j = 0; j < 8; ++j) { const float v = SC[base + gg * 8 + j] + rbias[gg * 8 + j]; if (v > m1) { m2 = m1; m1 = v; } else if (v > m2) m2 = v; }
                grp[gg] = m1 + m2; }
            unsigned gsel = 0u;
#pragma unroll
            for (int it = 0; it < 4; ++it) { float best = -__builtin_inff(); int bi = 0;
#pragma unroll
                for (int gg = 0; gg < 8; ++gg) if (!((gsel >> gg) & 1u) && grp[gg] > best) { best = grp[gg]; bi = gg; }
                gsel |= 1u << bi; }
            unsigned long long taken = 0ull; float wsum = 0.f;
#pragma unroll
            for (int k = 0; k < 8; ++k) { float best = -__builtin_inff(); int bi = 0;
                for (int e = 0; e < 64; ++e) { if (!((gsel >> (e >> 3)) & 1u) || ((taken >> e) & 1ull)) continue; const float v = SC[base + e] + rbias[e]; if (v > best) { best = v; bi = e; } }
                taken |= 1ull << bi; ee[k] = bi; ww[k] = SC[base + bi]; wsum += ww[k]; }
            const float sc_ = 2.5f / wsum;
#pragma unroll
            for (int k = 0; k < 8; ++k) { ww[k] *= sc_; lp[k] = __hip_atomic_fetch_add(HIST + ee[k], 1, __ATOMIC_RELAXED, __HIP_MEMORY_SCOPE_WORKGROUP); }
        }
        __syncthreads();
        if (tid < 64) BASE[tid] = (int)__hip_atomic_fetch_add(F.ctl + CW_CNT + tid, (unsigned)HIST[tid], RLX_AGENT);
        __syncthreads();
        if (lane < 8) { const int tok = tok0 + 8 * w + lane;
#pragma unroll
            for (int k = 0; k < 8; ++k) { const size_t o = (size_t)ee[k] * 16384 + BASE[ee[k]] + lp[k]; LTOK[o] = tok; LDSTp[o] = tok * 9 + k; LWp[o] = ww[k]; } }
    }
}

struct MoeSched {
    const char* A; const char* Bt; const int* ltok; LAS const int* tab;
    int K, ncol, nexp, G, c, gather;
    __device__ __forceinline__ bool next(int i, pg8::Unit& u) const {
        const int L = i * G + c; if (L >= tab[160 + 65] * ncol) return false;
        int e = 0; while (tab[160 + e + 1] * ncol <= L) ++e;
        const int rem = L - tab[160 + e] * ncol, nb = tab[80 + e];
        u.pn = rem / nb; u.pm = rem % nb; u.e = e | (tab[160 + e] << 8); u.cnt = tab[e]; return true;
    }
    __device__ __forceinline__ const char* a_base() const { return A; }
    __device__ __forceinline__ unsigned a_off(const pg8::Unit& u, int h, int R) const {
        const int e = u.e & 255, pos = u.pm * 256 + h * 128 + R;
        if (gather) { const int tok = (e == 64) ? pos : (pos < u.cnt ? ltok[(size_t)e * 16384 + pos] : T); return (unsigned)tok * (unsigned)(K * 2); }
        return (unsigned)((u.e >> 8) * 256 + pos) * (unsigned)(K * 2);
    }
    __device__ __forceinline__ const char* b_tile(const pg8::Unit& u) const { return Bt + ((size_t)(u.e & 255) * nexp + (size_t)u.pn * 256) * K * 2; }
};
__device__ __forceinline__ void moe_tables(Frame& F) {
    LAS int* tab = (LAS int*)(F.lds + SCHED_OFF);
    __syncthreads();
    if (F.tid == 0) { int cum = 0;
        for (int e = 0; e < 65; ++e) { const int c = (e < 64) ? (int)__hip_atomic_load(F.ctl + CW_CNT + e, RLX_AGENT) : T; const int nb = (c + 255) >> 8; tab[e] = c; tab[80 + e] = nb; tab[160 + e] = cum; cum += nb; }
        tab[160 + 65] = cum; }
    __syncthreads();
}
struct EpiMoe1 {
    static constexpr bool PERM = true;
    bf16_t* act;
    __device__ __forceinline__ void operator()(const f32x4 (&acc)[2][2][4][2], const pg8::Unit& u, int wr, int wc, int fr, int fq) const {
        const int row0 = (u.e >> 8) * 256 + u.pm * 256 + wr * 64 + fr, col0 = 128 * u.pn + 16 * wc + 4 * fq;
#pragma unroll
        for (int ai = 0; ai < 2; ++ai)
#pragma unroll
            for (int m = 0; m < 4; ++m) { bf16_t* rp = act + (size_t)(row0 + ai * 128 + m * 16) * 512 + col0;
#pragma unroll
                for (int bj = 0; bj < 2; ++bj) { const f32x4 gt = acc[ai][bj][m][0], up = acc[ai][bj][m][1]; float a[4];
#pragma unroll
                    for (int i = 0; i < 4; ++i) a[i] = gt[i] * sigmoidf_(gt[i]) * up[i];
                    *(u32x2*)(rp + 64 * bj) = (u32x2){pk2(a[0], a[1]), pk2(a[2], a[3])}; } }
    }
};
struct EpiMoe2 {
    static constexpr bool PERM = true;
    bf16_t* y; const int* ldst; const float* lw;
    __device__ __forceinline__ void operator()(const f32x4 (&acc)[2][2][4][2], const pg8::Unit& u, int wr, int wc, int fr, int fq) const {
        const int e = u.e & 255, p0 = u.pm * 256 + wr * 64 + fr, col0 = 256 * u.pn + 32 * wc + 8 * fq;
#pragma unroll
        for (int ai = 0; ai < 2; ++ai)
#pragma unroll
            for (int m = 0; m < 4; ++m) { const int pos = p0 + ai * 128 + m * 16; int dst; float wg;
                if (e == 64) { dst = pos * 9 + 8; wg = 1.f; } else if (pos < u.cnt) { dst = ldst[(size_t)e * 16384 + pos]; wg = lw[(size_t)e * 16384 + pos]; } else { dst = -1; wg = 0.f; }
                if (dst >= 0) { bf16_t* rp = y + (size_t)dst * 2048 + col0;
#pragma unroll
                    for (int bj = 0; bj < 2; ++bj) { const f32x4 v0 = acc[ai][bj][m][0] * wg, v1 = acc[ai][bj][m][1] * wg;
                        *(u32x4*)(rp + 128 * bj) = (u32x4){pk2(v0[0], v0[1]), pk2(v0[2], v0[3]), pk2(v1[0], v1[1]), pk2(v1[2], v1[3])}; } } }
    }
};
__device__ __forceinline__ void p11_final(Frame& F) {
    const int gw = F.bx * NWAVES + F.wave, NGW = F.G * NWAVES, lane = F.lane;
    const float* X1 = WSP(float, WS_X1); const bf16_t* Y = WSP(bf16_t, WS_Y); const float* mod = WSP(float, WS_MOD); const float* fg = F.in[I_FNG];
    LAS float* vb = (LAS float*)(F.lds + F.wave * 8192);
#pragma nounroll
    for (int m = gw; m < T; m += NGW) { const int b = m >> 11; float ss = 0.f;
#pragma nounroll
        for (int j = 0; j < 4; ++j) { const int c = 8 * lane + 512 * j; float a[8];
#pragma unroll
            for (int i = 0; i < 8; ++i) a[i] = 0.f;
#pragma unroll
            for (int k = 0; k < 9; ++k) { const u32x4 t = *(const u32x4*)(Y + ((size_t)m * 9 + k) * 2048 + c);
                a[0] += bflo(t.x); a[1] += bfhi(t.x); a[2] += bflo(t.y); a[3] += bfhi(t.y); a[4] += bflo(t.z); a[5] += bfhi(t.z); a[6] += bflo(t.w); a[7] += bfhi(t.w); }
            const f32x4 x0 = *(const f32x4*)(X1 + (size_t)m * 2048 + c), x1 = *(const f32x4*)(X1 + (size_t)m * 2048 + c + 4);
            const f32x4 g0 = *(const f32x4*)(mod + b * 12288 + 10240 + c), g1 = *(const f32x4*)(mod + b * 12288 + 10240 + c + 4);
            const f32x4 v0 = {x0[0] + g0[0] * a[0], x0[1] + g0[1] * a[1], x0[2] + g0[2] * a[2], x0[3] + g0[3] * a[3]};
            const f32x4 v1 = {x1[0] + g1[0] * a[4], x1[1] + g1[1] * a[5], x1[2] + g1[2] * a[6], x1[3] + g1[3] * a[7]};
            ss += (v0[0] * v0[0] + v0[1] * v0[1]) + (v0[2] * v0[2] + v0[3] * v0[3]) + (v1[0] * v1[0] + v1[1] * v1[1]) + (v1[2] * v1[2] + v1[3] * v1[3]);
            *(LAS f32x4*)(vb + c) = v0; *(LAS f32x4*)(vb + c + 4) = v1; }
        const float rstd = 1.f / sqrtf(wave_sum(ss) * (1.f / 2048.f) + EPS);
#pragma nounroll
        for (int j = 0; j < 4; ++j) { const int c = 8 * lane + 512 * j;
            const f32x4 v0 = *(const LAS f32x4*)(vb + c), v1 = *(const LAS f32x4*)(vb + c + 4);
            const f32x4 f0 = *(const f32x4*)(fg + c), f1 = *(const f32x4*)(fg + c + 4);
            *(f32x4*)(F.out + (size_t)m * 2048 + c) = v0 * rstd * f0; *(f32x4*)(F.out + (size_t)m * 2048 + c + 4) = v1 * rstd * f1; }
    }
}

#ifndef DIAG
#define DIAG 0
#endif
constexpr int CW_DIAG = 9000;
__device__ __forceinline__ void diag_compute(Frame& F) {
#if DIAG == 1
    const unsigned* MASK = WSP(unsigned, WS_MASK);
    for (int row = F.bx * NWAVES + F.wave; row < T; row += F.G * NWAVES) { const int q = row & 2047;
        const unsigned mw = MASK[(size_t)row * 64 + F.lane]; int c = __popc(mw);
        for (int o = 1; o < 64; o <<= 1) c += __shfl_xor(c, o);
        unsigned bad = 0; { const int k0 = F.lane * 32; for (int bb = 0; bb < 32; ++bb) if (((mw >> bb) & 1u) && (k0 + bb > q)) bad = 1; }
        bad = __any(bad) ? 1u : 0u;
        if (F.lane == 0) { atomicMax(F.ctl + CW_DIAG, (unsigned)c); if (c != (q + 1 < 256 ? q + 1 : 256)) atomicAdd(F.ctl + CW_DIAG + 1, 1u); if (bad) atomicAdd(F.ctl + CW_DIAG + 2, 1u); } }
#endif
#if DIAG == 2
    const unsigned* p = (const unsigned*)(F.ws + (size_t)DIAG_OFF); const size_t n = (size_t)DIAG_LEN / 4; unsigned acc = 0;
    for (size_t i = (size_t)F.bx * NTHR + F.tid; i < n; i += (size_t)F.G * NTHR) acc += p[i] * 2654435761u + (unsigned)i;
    for (int o = 1; o < 64; o <<= 1) acc += __shfl_xor(acc, o);
    if (F.lane == 0) atomicAdd(F.ctl + CW_DIAG, acc);
#endif
}
__device__ __forceinline__ void diag_emit(Frame& F) {
    if (F.bx == 0 && F.tid == 0) { const unsigned a = F.ctl[CW_DIAG], b = F.ctl[CW_DIAG + 1], c = F.ctl[CW_DIAG + 2];
        F.out[0] = 50.f + (float)(b + c) * 1000.f + 0.f * (float)a; (void)a; (void)b; (void)c; }
}
constexpr int N_PHASES = DIAG ? 14 : 12;
__global__ void __launch_bounds__(NTHR, 2) mk_fwd(Args args) {
    extern __shared__ __attribute__((aligned(16))) unsigned char lds[];
    Frame F;
    F.lds = (LAS unsigned char*)lds; F.MISC = (volatile LAS unsigned*)(F.lds + MISC_OFF);
    F.tid = threadIdx.x; F.lane = F.tid & 63; F.wave = __builtin_amdgcn_readfirstlane(F.tid >> 6);
    F.G = gridDim.x; F.bx = blockIdx.x; F.ws = args.ws; F.ctl = (unsigned*)(args.ws + WS_CTL); F.in = args.in; F.out = args.out;
    for (int u = F.tid; u < (LDS_BYTES - RING_BYTES) / 4; u += NTHR) ((LAS unsigned*)(F.lds + RING_BYTES))[u] = 0u;
    __syncthreads();
    const int lo = args.ph_lo, hi = args.ph_hi;
    XcdBarrier bar; bar.bar = F.ctl + CW_BAR; bar.x = 0; bar.st = nullptr;
    if (hi - lo > 1) bar = xcd_barrier_post(F.ctl + CW_BAR, F.MISC + 8);
#ifndef PH_MASK
#define PH_MASK 0xFFFFF
#endif
#define IN(k) (((PH_MASK >> (k)) & 1) && lo <= (k) && (k) < hi)
#define SEAM(k) do { if (IN(k) && IN((k) + 1)) xcd_barrier(bar); } while (0)
    if (IN(0)) { p0_prologue(F); } SEAM(0);
    if (IN(1)) { p0b_mod(F); } SEAM(1);
    if (IN(2)) { p1_h1(F); } SEAM(2);
    if (IN(3)) { pg8::DenseSched S; S.init(WSP(bf16_t, WS_H1), WSP(bf16_t, WS_WIN), T, NPROJ, 2048, F.G, F.bx);
        EpiProj E{F.ws, F.in[I_LBL]}; pg8::gemm_phase<EpiProj, pg8::DenseSched, true, true>(F.lds, 2048, S, E); } SEAM(3);
    if (IN(4)) { if ((PH_MASK >> 12) & 1) { pg8::DenseSched S; S.init(WSP(bf16_t, WS_CKV), WSP(bf16_t, WS_WKV), T, 2048, 256, F.G, F.bx);
          EpiKV E{F.ws}; pg8::gemm_phase<EpiKV, pg8::DenseSched, true, true>(F.lds, 256, S, E); }
        __syncthreads();
        if (((PH_MASK >> 13) & 1) && F.bx < 64) { p3_hgrn(F, F.bx); }
        if ((PH_MASK >> 14) & 1) p3_indexer(F, 0); } SEAM(4);
    if (IN(5)) { p4_attn_naive(F); } SEAM(5);
    if (IN(6)) { p5_finalize(F); } SEAM(6);
    if (IN(7)) { pg8::DenseSched S; S.init(WSP(bf16_t, WS_A2), WSP(bf16_t, WS_WOUT), T, 2048, 2048, F.G, F.bx);
        EpiOut E{F.in[I_X], WSP(float, WS_X1), WSP(float, WS_MOD)}; pg8::gemm_phase<EpiOut, pg8::DenseSched, true, true>(F.lds, 2048, S, E); } SEAM(7);
    if (IN(8)) { p7_router(F); } SEAM(8);
    if (IN(9)) { moe_tables(F);
        MoeSched S; S.A = (const char*)WSP(bf16_t, WS_H2); S.Bt = (const char*)WSP(bf16_t, WS_W1); S.ltok = WSP(int, WS_LTOK); S.tab = (LAS const int*)(F.lds + SCHED_OFF); S.K = 2048; S.ncol = 4; S.nexp = 1024; S.G = F.G; S.c = F.bx; S.gather = 1;
        EpiMoe1 E{WSP(bf16_t, WS_ACT)}; pg8::gemm_phase<EpiMoe1, MoeSched, true, true>(F.lds, 2048, S, E); } SEAM(9);
    if (IN(10)) { moe_tables(F);
        MoeSched S; S.A = (const char*)WSP(bf16_t, WS_ACT); S.Bt = (const char*)WSP(bf16_t, WS_W2); S.ltok = nullptr; S.tab = (LAS const int*)(F.lds + SCHED_OFF); S.K = 512; S.ncol = 8; S.nexp = 2048; S.G = F.G; S.c = F.bx; S.gather = 0;
        EpiMoe2 E{WSP(bf16_t, WS_Y), WSP(int, WS_LDST), WSP(float, WS_LW)}; pg8::gemm_phase<EpiMoe2, MoeSched, true, true>(F.lds, 512, S, E); } SEAM(10);
    if (IN(11)) { p11_final(F); }
    if (DIAG && lo <= 12 && 12 < hi) diag_compute(F);
    if (DIAG && lo <= 13 && 13 < hi) diag_emit(F);
#undef IN
#undef SEAM
}

extern "C" void kernel_launch(void* const* d_in, const int* in_sizes, int n_in, void* d_out, int out_size, void* d_ws, size_t ws_size, hipStream_t stream) {
    static int grid = 0;
    if (grid == 0) {
        if (n_in != 25 || in_sizes[0] != T * D || out_size != T * D || ws_size < WS_END) { fprintf(stderr, "kernel_launch: unexpected shapes (n_in %d, in0 %d, out %d, ws %zu < %zu)\n", n_in, n_in > 0 ? in_sizes[0] : -1, out_size, ws_size, (size_t)WS_END); grid = -1; return; }
        int dev = 0, cus = 0, per_cu = 0;
        if (hipGetDevice(&dev) != hipSuccess || hipDeviceGetAttribute(&cus, hipDeviceAttributeMultiprocessorCount, dev) != hipSuccess) { grid = -1; return; }
        if (hipFuncSetAttribute((const void*)mk_fwd, hipFuncAttributeMaxDynamicSharedMemorySize, LDS_BYTES) != hipSuccess) { fprintf(stderr, "kernel_launch: hipFuncSetAttribute failed\n"); grid = -1; return; }
        if (hipOccupancyMaxActiveBlocksPerMultiprocessor(&per_cu, (const void*)mk_fwd, NTHR, LDS_BYTES) != hipSuccess || per_cu < 1) { fprintf(stderr, "kernel_launch: occupancy query says %d\n", per_cu); }
        (void)hipGetLastError();
        grid = cus;
    }
    if (grid < 0) return;
    (void)hipMemsetAsync((char*)d_ws + WS_CTL, 0, CTL_ZERO_BYTES, stream);
    Args a{};
    for (int i = 0; i < 25; ++i) a.in[i] = (const float*)d_in[i];
    a.out = (float*)d_out; a.ws = (unsigned char*)d_ws;
    constexpr int NL = DIAG ? 14 : MK_N_LAUNCHES;
    for (int li = 0; li < NL; ++li) {
        a.ph_lo = li * N_PHASES / NL; a.ph_hi = (li + 1) * N_PHASES / NL;
        hipLaunchKernelGGL(mk_fwd, dim3(grid), dim3(NTHR), LDS_BYTES, stream, a);
    }
}
```

```cpp
#include <hip/hip_runtime.h>
#include <cstdio>
#include <cstdint>

#define NOBIAS 0
#define QREG 0
#define NOSEL 0
#ifndef MK_N_LAUNCHES
#define MK_N_LAUNCHES 1
#endif

#define GAS __attribute__((address_space(1)))
#define LAS __attribute__((address_space(3)))
typedef unsigned short bf16_t;
typedef short bf16x8 __attribute__((ext_vector_type(8)));
typedef short s16x4 __attribute__((ext_vector_type(4)));
typedef float f32x4 __attribute__((ext_vector_type(4)));
typedef float f32x2 __attribute__((ext_vector_type(2)));
typedef float f32x16 __attribute__((ext_vector_type(16)));
typedef unsigned u32x4 __attribute__((ext_vector_type(4)));
typedef unsigned u32x2 __attribute__((ext_vector_type(2)));

constexpr int NB = 8, SEQ = 2048, T = NB * SEQ, D = 2048;
constexpr int NH = 8, HD = 128, CKV = 256, IH = 16, IDIM = 64, TOPK = 256;
constexpr int NPROJ = 6656;
constexpr int NE = 64, DE = 512, KSEL = 8, NSLOT = 9;
constexpr float EPS = 1e-6f;
constexpr float ATT_SCALE = 0.08838834764831845f;

constexpr size_t MiB = 1u << 20;
constexpr size_t WS_CTL = 0, CTL_ZERO_BYTES = 1 * MiB;
constexpr size_t WS_MOD = 1 * MiB;
constexpr size_t WS_CKVSS = 2 * MiB;
constexpr size_t WS_WR = 3 * MiB;
constexpr size_t WS_LTOK = 4 * MiB, WS_LDST = 8 * MiB, WS_LW = 12 * MiB;
constexpr size_t WS_MODP = 16 * MiB;
constexpr size_t WS_W2 = 32 * MiB;
constexpr size_t WS_X1 = 162 * MiB;
constexpr size_t WS_WIN = 162 * MiB;
constexpr size_t WS_WKV = 188 * MiB;
constexpr size_t WS_H1 = 190 * MiB;
constexpr size_t WS_ACT = 290 * MiB;
constexpr size_t WS_K = 290 * MiB, WS_V = 322 * MiB;
constexpr size_t WS_AO = 354 * MiB;
constexpr size_t WS_HO = 386 * MiB;
constexpr size_t WS_A2 = 290 * MiB;
constexpr size_t WS_Y = 450 * MiB;
constexpr size_t WS_W1 = 450 * MiB;
constexpr size_t WS_QA = 710 * MiB;
constexpr size_t WS_CKV = 742 * MiB;
constexpr size_t WS_IQ = 750 * MiB;
constexpr size_t WS_QB = 782 * MiB;
constexpr size_t WS_LOGF = 814 * MiB;
constexpr size_t WS_KB = 878 * MiB;
constexpr size_t WS_IB = 910 * MiB;
constexpr size_t WS_GB = 942 * MiB;
constexpr size_t WS_IK = 974 * MiB;
constexpr size_t WS_IW = 976 * MiB;
constexpr size_t WS_MASK = 977 * MiB;
constexpr size_t WS_WOUT = 981 * MiB;
constexpr size_t WS_H2 = 710 * MiB;
constexpr size_t WS_END = 1026 * MiB;
constexpr int CW_TMO = 0, CW_BAR = 4096, CW_CNT = 8192  , CW_IDXQ = 8448  ;

constexpr int RING_BYTES = 131072, LDS_BYTES = 163840, CTLZ_OFF = LDS_BYTES - 4096, MISC_OFF = CTLZ_OFF + 320;
constexpr int SCHED_OFF = CTLZ_OFF + 1024;

#define RLX_AGENT __ATOMIC_RELAXED, __HIP_MEMORY_SCOPE_AGENT
#define LDS_WAIT() asm volatile("s_waitcnt lgkmcnt(0)" ::: "memory")
#define VM_WAIT() asm volatile("s_waitcnt vmcnt(0)" ::: "memory")

__device__ __forceinline__ unsigned f2bf(float f) { unsigned u = __builtin_bit_cast(unsigned, f); return (u + 0x7fffu + ((u >> 16) & 1u)) >> 16; }
__device__ __forceinline__ unsigned pk2(float lo, float hi) { unsigned r; asm volatile("v_cvt_pk_bf16_f32 %0, %1, %2" : "=v"(r) : "v"(lo), "v"(hi)); return r; }
__device__ __forceinline__ float bflo(unsigned w) { return __builtin_bit_cast(float, w << 16); }
__device__ __forceinline__ float bfhi(unsigned w) { return __builtin_bit_cast(float, w & 0xffff0000u); }
__device__ __forceinline__ float bf1(bf16_t h) { return __builtin_bit_cast(float, ((unsigned)h) << 16); }
__device__ __forceinline__ float sigmoidf_(float x) { return 1.f / (1.f + __expf(-x)); }
template <int LN> __device__ __forceinline__ void wlane(int& vd, int sval) { asm volatile("s_nop 4\n\tv_writelane_b32 %0, %1, %2" : "+v"(vd) : "s"(sval), "n"(LN));   }
template <int XM> __device__ __forceinline__ float swz_xor(float v) { return __builtin_bit_cast(float, __builtin_amdgcn_ds_swizzle(__builtin_bit_cast(int, v), (XM << 10) | 0x1f)); }
__device__ __forceinline__ float wave_sum(float v) {
    v += swz_xor<1>(v); v += swz_xor<2>(v); v += swz_xor<4>(v); v += swz_xor<8>(v); v += swz_xor<16>(v);
    return __builtin_bit_cast(float, __builtin_amdgcn_readlane(__builtin_bit_cast(int, v), 0)) + __builtin_bit_cast(float, __builtin_amdgcn_readlane(__builtin_bit_cast(int, v), 32));
}
__device__ __forceinline__ int opaque(int x) { asm volatile("" : "+v"(x)); return x; }

#define XB_TMO      128
#define XB_XCNT(j)  (256  + 64 * (j))
#define XB_XSUB(j)  (1280 + 64 * (j))
#define XB_XGEN(j)  (2304 + 64 * (j))
#define XB_TOP      3328
#define XB_TOPGEN   3392
#define XCD_BAR_WORDS 3456
#define XB_SPIN_CAP (1u << 20)
__device__ __forceinline__ unsigned xb_ld(unsigned* p)              { return __hip_atomic_load(p, __ATOMIC_RELAXED, __HIP_MEMORY_SCOPE_AGENT); }
__device__ __forceinline__ unsigned xb_add(unsigned* p, unsigned v) { return __hip_atomic_fetch_add(p, v, __ATOMIC_RELAXED, __HIP_MEMORY_SCOPE_AGENT); }
__device__ __forceinline__ unsigned xb_xcc_id() { return (unsigned)__builtin_amdgcn_s_getreg((3 << 11) | 20) & 0xFu; }
#define XB_SPIN(cond, bar) do { unsigned _sp = 0; while (cond) { __builtin_amdgcn_s_sleep(1); \
    if ((++_sp & 255u) == 0u) { if (xb_ld(&(bar)[XB_TMO])) break; if (_sp > XB_SPIN_CAP) { atomicAdd(&(bar)[XB_TMO], 1u); break; } } } } while (0)
struct XcdBarrier { unsigned* bar; unsigned x; volatile LAS unsigned* st; };
__device__ __forceinline__ XcdBarrier xcd_barrier_post(unsigned* bar, volatile LAS unsigned* st) {
    XcdBarrier b; b.bar = bar; b.x = xb_xcc_id(); b.st = st;
    if (threadIdx.x == 0) (void)xb_add(&bar[XB_XCNT(b.x)], 1u);
    return b;
}
__device__ __forceinline__ void xcd_barrier_complete(unsigned* bar, unsigned x, unsigned& nloc, unsigned& nx) {
    const unsigned G = gridDim.x * gridDim.y * gridDim.z;
    unsigned sum, cnt, mine, sp = 0u;
    for (;;) {
        sum = 0u; cnt = 0u; mine = 0u;
#pragma unroll
        for (unsigned j = 0; j < 16; ++j) { const unsigned c = xb_ld(&bar[XB_XCNT(j)]); sum += c; cnt += (c > 0u) ? 1u : 0u; mine = (j == x) ? c : mine; }
        if (sum == G) break;
        __builtin_amdgcn_s_sleep(1);
        if ((++sp & 255u) == 0u) { if (xb_ld(&bar[XB_TMO])) break; if (sp > XB_SPIN_CAP) { atomicAdd(&bar[XB_TMO], 1u); break; } }
    }
    nloc = mine > 0u ? mine : 1u; nx = cnt > 0u ? cnt : 1u;
}
__device__ __forceinline__ void xcd_barrier(const XcdBarrier& b) {
    asm volatile("s_waitcnt vmcnt(0)" ::: "memory");
    __syncthreads();
    if (threadIdx.x == 0) {
        unsigned* bar = b.bar;
        __builtin_amdgcn_s_waitcnt(0);
        unsigned nloc = b.st[0], nx = b.st[1];
        if (nloc == 0u) { xcd_barrier_complete(bar, b.x, nloc, nx); b.st[0] = nloc; b.st[1] = nx; }
        const unsigned old = xb_add(&bar[XB_XSUB(b.x)], 1u);
        const unsigned gen = old / nloc;
        if (old + 1u == (gen + 1u) * nloc) {
            __builtin_amdgcn_fence(__ATOMIC_RELEASE, "agent");
            asm volatile("s_waitcnt vmcnt(0)" ::: "memory");
            const unsigned og = xb_add(&bar[XB_TOP], 1u);
            const unsigned tg = og / nx;
            if (og + 1u == (tg + 1u) * nx) xb_add(&bar[XB_TOPGEN], 1u);
            else XB_SPIN(xb_ld(&bar[XB_TOPGEN]) == tg, bar);
            __builtin_amdgcn_fence(__ATOMIC_ACQUIRE, "agent");
            xb_add(&bar[XB_XGEN(b.x)], 1u);
            asm volatile("s_waitcnt vmcnt(0)" ::: "memory");
        } else {
            XB_SPIN(xb_ld(&bar[XB_XGEN(b.x)]) == gen, bar);
            __builtin_amdgcn_fence(__ATOMIC_ACQUIRE, "agent");
            asm volatile("s_waitcnt vmcnt(0)" ::: "memory");
        }
    }
    __syncthreads();
}

namespace pg8 {
constexpr int BM = 256, BK = 64, HALF = 128, HTB = HALF * BK * 2, STAGE_BYTES = 8 * HTB, NXCD = 8, WGM = 8;
__host__ __device__ __forceinline__ int lds_byte(int r, int c) { const int st = (r >> 4) * 2 + (c >> 5), rr = r & 15, cc = c & 31, ob = rr * 64 + cc * 2; return st * 1024 + (ob ^ (((ob >> 9) & 1) << 5)); }
__host__ __device__ __forceinline__ void stage_rc(int b, int& R, int& C) { const int st = b / 1024, sb = b % 1024, swz = sb ^ (((sb >> 9) & 1) << 5); R = (st >> 1) * 16 + swz / 64; C = (st & 1) * 32 + (swz % 64) / 2; }
__host__ __device__ __forceinline__ int perm32(int rho) { const int n = rho >> 4, i = rho & 15; return 8 * (i >> 2) + 4 * n + (i & 3); }

struct Unit { int pm, pn, e, cnt; };

struct DenseSched {
    const char* A; const char* Bt; int nM, nN, nwg, G, c, K, rep;
    __device__ __forceinline__ void init(const void* A_, const void* Bt_, int M, int N, int K_, int G_, int c_) { rep = 1; A = (const char*)A_; Bt = (const char*)Bt_; nM = M / BM; nN = N / BM; nwg = nM * nN; G = G_; c = c_; K = K_; }
    __device__ __forceinline__ bool next(int i, Unit& u) const {
        long L = (long)i * G + c; if (L >= (long)nwg * rep) return false; L %= nwg;
        int wgid = (int)L; { const int q = nwg / NXCD, r = nwg % NXCD, xcd = wgid % NXCD, off = wgid / NXCD; wgid = (xcd < r ? xcd * (q + 1) : r * (q + 1) + (xcd - r) * q) + off; }
        const int nig = WGM * nN, gid = wgid / nig, fm = gid * WGM, gsz = (nM - fm) < WGM ? (nM - fm) : WGM;
        u.pm = fm + ((wgid % nig) % gsz); u.pn = (wgid % nig) / gsz; u.e = 0; u.cnt = 0; return true;
    }
    __device__ __forceinline__ const char* a_base() const { return A; }
    __device__ __forceinline__ unsigned a_off(const Unit& u, int h, int R) const { return (unsigned)(u.pm * BM + h * HALF + R) * (unsigned)(K * 2); }
    __device__ __forceinline__ const char* b_tile(const Unit& u) const { return Bt + (size_t)u.pn * BM * K * 2; }
};

template <class Epi, class Sched, bool ALIGN_EPI, bool SP2>
__device__ __forceinline__ void gemm_phase(LAS unsigned char* lds, const int K, const Sched& S, const Epi& E) {
    const int tid = threadIdx.x, wid = __builtin_amdgcn_readfirstlane(tid >> 6), lane = tid & 63, wr = wid >> 2, wc = wid & 3, fr = lane & 15, fq = lane >> 4;
    const int nt = K / BK;
    int Rr[2], Cc[2]; unsigned voffB[2];
#pragma unroll
    for (int i = 0; i < 2; ++i) { int R, C; stage_rc(tid * 16 + i * 8192, R, C); const int Rb = Epi::PERM ? ((R & ~31) + perm32(R & 31)) : R;
        Rr[i] = R; Cc[i] = C * 2; voffB[i] = (unsigned)(Rb * K + C) * 2u; }
    const size_t kstep = (size_t)(BK * 2);
    const size_t hstep = (size_t)HALF * K * 2;
    const unsigned ldsw = (unsigned)wid * 1024u;
    const int aoff = lds_byte(wr * 64 + fr, fq * 8), boff = lds_byte(wc * 32 + fr, fq * 8);
#define PG8_SA(b, h) (((b) * 2 + (h)) * HTB)
#define PG8_SB(b, h) ((4 + (b) * 2 + (h)) * HTB)
#define PG8_STAGE2(bufoff, gbase, v0, v1) do { \
        __builtin_amdgcn_global_load_lds((const unsigned*)((const char*)(gbase) + (v0)), (LAS unsigned*)(lds + (bufoff) + ldsw), 16, 0, 0); \
        __builtin_amdgcn_global_load_lds((const unsigned*)((const char*)(gbase) + (v1)), (LAS unsigned*)(lds + (bufoff) + ldsw + 8192), 16, 0, 0); } while (0)
#define PG8_STAGEB(bufoff, gbase) PG8_STAGE2(bufoff, gbase, voffB[0], voffB[1])
#define PG8_LDA(dst, b, h) do { _Pragma("unroll") for (int m = 0; m < 4; ++m) _Pragma("unroll") for (int k = 0; k < 2; ++k) dst[m][k] = *(const LAS bf16x8*)(lds + PG8_SA(b, h) + aoff + m * 2048 + k * 1024); } while (0)
#define PG8_LDB(dst, b, h) do { _Pragma("unroll") for (int n = 0; n < 2; ++n) _Pragma("unroll") for (int k = 0; k < 2; ++k) dst[n][k] = *(const LAS bf16x8*)(lds + PG8_SB(b, h) + boff + n * 2048 + k * 1024); } while (0)
#define PG8_MMA(ai, bj, At, Bt) do { __builtin_amdgcn_s_setprio(1); _Pragma("unroll") for (int m = 0; m < 4; ++m) _Pragma("unroll") for (int n = 0; n < 2; ++n) _Pragma("unroll") for (int k = 0; k < 2; ++k) \
        acc[ai][bj][m][n] = __builtin_amdgcn_mfma_f32_16x16x32_bf16(Bt[n][k], At[m][k], acc[ai][bj][m][n], 0, 0, 0); __builtin_amdgcn_s_setprio(0); } while (0)
#define PG8_WAIT_V(n) asm volatile("s_waitcnt vmcnt(" #n ")" ::: "memory")
#define PG8_WAIT_L(n) asm volatile("s_waitcnt lgkmcnt(" #n ")" ::: "memory")
#define PG8_BAR __builtin_amdgcn_s_barrier()
#define PG8_SCHED __builtin_amdgcn_sched_barrier(0)
    Unit cur, nxt; int ui = 0;
    if (!S.next(0, cur)) return;
    f32x4 acc[2][2][4][2];
#pragma unroll
    for (int a = 0; a < 2; ++a)
#pragma unroll
        for (int b = 0; b < 2; ++b)
#pragma unroll
            for (int m = 0; m < 4; ++m)
#pragma unroll
                for (int n = 0; n < 2; ++n) acc[a][b][m][n] = (f32x4){0.f, 0.f, 0.f, 0.f};
    bf16x8 At[4][2], B0[2][2], B1[2][2];
    const char* const A0 = S.a_base();
    const char* cB = S.b_tile(cur);
    unsigned c00 = S.a_off(cur, 0, Rr[0]) + Cc[0], c01 = S.a_off(cur, 0, Rr[1]) + Cc[1], c10 = S.a_off(cur, 1, Rr[0]) + Cc[0], c11 = S.a_off(cur, 1, Rr[1]) + Cc[1];
    PG8_STAGEB(PG8_SB(0, 0), cB); PG8_STAGEB(PG8_SB(0, 1), cB + hstep); PG8_STAGE2(PG8_SA(0, 0), A0, c00, c01); PG8_STAGE2(PG8_SA(0, 1), A0, c10, c11);
    if (wr == 1) PG8_BAR;
    PG8_WAIT_V(2); PG8_BAR;
    PG8_STAGEB(PG8_SB(1, 0), cB + kstep); PG8_STAGE2(PG8_SA(1, 0), A0 + kstep, c00, c01); PG8_STAGEB(PG8_SB(1, 1), cB + hstep + kstep);
    PG8_WAIT_V(6); PG8_BAR;
    for (;;) {
        const bool has_next = S.next(ui + 1, nxt);
        if (!has_next) nxt = cur;
        const char* nB = has_next ? S.b_tile(nxt) : cB;
        unsigned n00 = c00, n01 = c01, n10 = c10, n11 = c11;
        if (has_next) { n00 = S.a_off(nxt, 0, Rr[0]) + Cc[0]; n01 = S.a_off(nxt, 0, Rr[1]) + Cc[1]; n10 = S.a_off(nxt, 1, Rr[0]) + Cc[0]; n11 = S.a_off(nxt, 1, Rr[1]) + Cc[1]; }
#pragma nounroll
        for (int t = 0; t < nt; t += 2) {
            const bool last = (t == nt - 2);
            const char* a1 = A0 + (size_t)(t + 1) * kstep;
            const char* a2 = last ? A0 : A0 + (size_t)(t + 2) * kstep; const char* b2 = last ? nB : cB + (size_t)(t + 2) * kstep;
            const char* a3 = a2 + kstep; const char* b3 = b2 + kstep;
            unsigned x00 = c00, x01 = c01, x10 = c10, x11 = c11;
            if (last) { x00 = n00; x01 = n01; x10 = n10; x11 = n11; }
            PG8_LDB(B0, 0, 0); PG8_LDB(B1, 0, 1); PG8_SCHED; PG8_LDA(At, 0, 0); PG8_STAGE2(PG8_SA(1, 1), a1, c10, c11);
            PG8_WAIT_V(8); PG8_WAIT_L(0); PG8_BAR; PG8_MMA(0, 0, At, B0); PG8_MMA(0, 1, At, B1); PG8_BAR; PG8_SCHED;
            PG8_LDA(At, 0, 1); PG8_STAGEB(PG8_SB(0, 0), b2); PG8_STAGEB(PG8_SB(0, 1), b2 + hstep); PG8_STAGE2(PG8_SA(0, 0), a2, x00, x01);
            PG8_WAIT_V(8); PG8_WAIT_L(0); PG8_BAR; PG8_MMA(1, 0, At, B0); PG8_MMA(1, 1, At, B1); PG8_BAR; PG8_SCHED;
            PG8_LDB(B0, 1, 0); PG8_LDB(B1, 1, 1); PG8_SCHED; PG8_LDA(At, 1, 0); PG8_STAGE2(PG8_SA(0, 1), a2, x10, x11);
            PG8_WAIT_V(8); PG8_WAIT_L(0); PG8_BAR; PG8_MMA(0, 0, At, B0); PG8_MMA(0, 1, At, B1); PG8_BAR; PG8_SCHED;
            PG8_LDA(At, 1, 1); PG8_STAGEB(PG8_SB(1, 0), b3); PG8_STAGEB(PG8_SB(1, 1), b3 + hstep); PG8_STAGE2(PG8_SA(1, 0), a3, x00, x01);
            PG8_WAIT_V(8); PG8_WAIT_L(0); PG8_BAR; PG8_MMA(1, 0, At, B0); PG8_MMA(1, 1, At, B1); PG8_BAR; PG8_SCHED;
        }
        if constexpr (ALIGN_EPI) { if (wr == 0) PG8_BAR; }
        E(acc, cur, wr, wc, fr, fq);
        if (!has_next) break;
#pragma unroll
        for (int a = 0; a < 2; ++a)
#pragma unroll
            for (int b = 0; b < 2; ++b)
#pragma unroll
                for (int m = 0; m < 4; ++m)
#pragma unroll
                    for (int n = 0; n < 2; ++n) acc[a][b][m][n] = (f32x4){0.f, 0.f, 0.f, 0.f};
        cur = nxt; cB = nB; c00 = n00; c01 = n01; c10 = n10; c11 = n11; ++ui;
        if constexpr (ALIGN_EPI) { if (wr == 1) PG8_BAR; }
    }
    PG8_WAIT_V(0);
    if constexpr (!ALIGN_EPI) { if (wr == 0) PG8_BAR; }
    PG8_BAR;
#undef PG8_SA
#undef PG8_SB
#undef PG8_STAGE2
#undef PG8_STAGEB
#undef PG8_LDA
#undef PG8_LDB
#undef PG8_MMA
#undef PG8_WAIT_V
#undef PG8_WAIT_L
#undef PG8_BAR
#undef PG8_SCHED
}
}

struct Args { const float* in[25]; float* out; unsigned char* ws; int ph_lo, ph_hi; };
constexpr int NWAVES = 8, NTHR = 512;
struct Frame {
    LAS unsigned char* lds;
    volatile LAS unsigned* MISC;
    unsigned* ctl;
    unsigned char* ws;
    const float* const* in;
    float* out;
    int tid, lane, wave, G, bx;
};
enum { I_X = 0, I_C, I_WADA, I_BADA, I_N1G, I_WIN, I_CKVG, I_IKG, I_WUK, I_WUV, I_RELB, I_LBL, I_AOG, I_HOG, I_WOUT, I_N2G, I_WROUT, I_RBIAS, I_EG, I_EU, I_ED, I_SG, I_SU, I_SD, I_FNG };
#define WSP(T_, off) ((T_*)(F.ws + (off)))

struct SrcWin { const float* W; __device__ __forceinline__ float operator()(int k, int p) const {
    int o; if (p < 2304) o = p; else if (p < 6400) o = p + 80; else if (p < 6480) o = p - 4096; else return 0.f;
    return W[(size_t)k * 6480 + o]; } };
struct SrcPlain { const float* W; int N; __device__ __forceinline__ float operator()(int k, int n) const { return W[(size_t)k * N + n]; } };
struct SrcWkv { const float* W; const float* g; __device__ __forceinline__ float operator()(int k, int n) const { return W[(size_t)k * 128 + n] * g[k]; } };
struct SrcW1 { const float* Wg; const float* Wu; __device__ __forceinline__ float operator()(int k, int n) const {
    const int j = (n >> 3) * 4 + (n & 3); const unsigned long long a = (unsigned long long)Wg, bb = (unsigned long long)Wu, msk = 0ull - (unsigned long long)((n >> 2) & 1);
    const float* p = (const float*)(a ^ ((a ^ bb) & msk)); return p[(size_t)k * 512 + j]; } };
template <class Src> __device__ __forceinline__ void p0_tr_item(const Src& src, int K, int nblk, bf16_t* WT, int row_off, LAS float* scr, int item, int lane) {
    const int kb = item / nblk, nb = item % nblk, k0 = 64 * kb, n0 = 32 * nb;
#pragma unroll 8
    for (int i = 0; i < 32; ++i) { const int kk = 2 * i + (lane >> 5); scr[kk * 33 + (lane & 31)] = src(k0 + kk, n0 + (lane & 31)); }
    LDS_WAIT(); asm volatile("" ::: "memory");
    const int c = lane & 7;
#pragma unroll
    for (int j = 0; j < 4; ++j) { const int n = (lane >> 3) + 8 * j; const LAS float* s = scr + (8 * c) * 33 + n;
        u32x4 o; o.x = pk2(s[0 * 33], s[1 * 33]); o.y = pk2(s[2 * 33], s[3 * 33]); o.z = pk2(s[4 * 33], s[5 * 33]); o.w = pk2(s[6 * 33], s[7 * 33]);
        *(u32x4*)(WT + (size_t)(row_off + n0 + n) * K + k0 + 8 * c) = o; }
    LDS_WAIT(); asm volatile("" ::: "memory");
}
__device__ __forceinline__ void p0_prologue(Frame& F) {
    LAS float* scr = (LAS float*)(F.lds + F.wave * 16384);
    const int gw = F.bx * NWAVES + F.wave, NGW = F.G * NWAVES, lane = F.lane;
    constexpr int I_W1 = 65 * 1024, I_W2 = 65 * 512, I_WINI = 32 * 208, I_WO = 32 * 64, I_KV = 256, I_ADA = 768, I_RT = 256;
    constexpr int NITEMS = I_W1 + I_W2 + I_WINI + I_WO + I_KV + I_ADA + I_RT;
    for (int it = gw; it < NITEMS; it += NGW) {
        int r = it;
        if (r < I_W1) { const int e = r >> 10, rr = r & 1023;
            SrcW1 s; if (e < 64) { s.Wg = F.in[I_EG] + (size_t)e * 2048 * 512; s.Wu = F.in[I_EU] + (size_t)e * 2048 * 512; } else { s.Wg = F.in[I_SG]; s.Wu = F.in[I_SU]; }
            p0_tr_item(s, 2048, 32, WSP(bf16_t, WS_W1) + (size_t)e * 1024 * 2048, 0, scr, rr, lane); continue; } r -= I_W1;
        if (r < I_W2) { const int e = r >> 9, rr = r & 511;
            SrcPlain s; s.W = (e < 64) ? F.in[I_ED] + (size_t)e * 512 * 2048 : F.in[I_SD]; s.N = 2048;
            p0_tr_item(s, 512, 64, WSP(bf16_t, WS_W2) + (size_t)e * 2048 * 512, 0, scr, rr, lane); continue; } r -= I_W2;
        if (r < I_WINI) { SrcWin s; s.W = F.in[I_WIN]; p0_tr_item(s, 2048, 208, WSP(bf16_t, WS_WIN), 0, scr, r, lane); continue; } r -= I_WINI;
        if (r < I_WO) { SrcPlain s; s.W = F.in[I_WOUT]; s.N = 2048; p0_tr_item(s, 2048, 64, WSP(bf16_t, WS_WOUT), 0, scr, r, lane); continue; } r -= I_WO;
        if (r < I_KV) { const int kv = r >> 7, h = (r >> 4) & 7, rr = r & 15;
            SrcWkv s; s.W = F.in[kv ? I_WUV : I_WUK] + (size_t)h * 256 * 128; s.g = F.in[I_CKVG];
            p0_tr_item(s, 256, 4, WSP(bf16_t, WS_WKV), kv * 1024 + h * 128, scr, rr, lane); continue; } r -= I_KV;
        if (r < I_ADA) { const int ks = r / 48, cb = r % 48;
            const float* cc = F.in[I_C];
#pragma unroll
            for (int j = 0; j < 16; ++j) { const int b = lane >> 3, kk = (lane & 7) + 8 * j; const float v = cc[b * 2048 + ks * 128 + kk]; scr[b * 128 + kk] = v * sigmoidf_(v); }
            LDS_WAIT(); asm volatile("" ::: "memory");
            f32x4 acc[8];
#pragma unroll
            for (int b = 0; b < 8; ++b) acc[b] = (f32x4){0.f, 0.f, 0.f, 0.f};
            const float* wp = F.in[I_WADA] + (size_t)(ks * 128) * 12288 + cb * 256 + lane * 4;
#pragma unroll 4
            for (int k = 0; k < 128; ++k) { const f32x4 w = *(const f32x4*)(wp + (size_t)k * 12288);
#pragma unroll
                for (int b = 0; b < 8; ++b) acc[b] += w * scr[b * 128 + k]; }
            float* mp = WSP(float, WS_MODP) + (size_t)ks * 8 * 12288 + cb * 256 + lane * 4;
#pragma unroll
            for (int b = 0; b < 8; ++b) *(f32x4*)(mp + (size_t)b * 12288) = acc[b];
            LDS_WAIT(); asm volatile("" ::: "memory"); continue; } r -= I_ADA;
        if (r < I_RT) { const int s = r >> 2, nt = r & 3, n = lane & 15, g = lane >> 4; const float* wr_ = F.in[I_WROUT];
            float v[8]; unsigned hi[4], lo[4];
#pragma unroll
            for (int j = 0; j < 8; ++j) v[j] = wr_[(size_t)(32 * s + 8 * g + j) * 64 + 16 * nt + n];
#pragma unroll
            for (int j = 0; j < 4; ++j) { const unsigned h0 = f2bf(v[2 * j]), h1 = f2bf(v[2 * j + 1]); hi[j] = h0 | (h1 << 16);
                lo[j] = f2bf(v[2 * j] - bf1((bf16_t)h0)) | (f2bf(v[2 * j + 1] - bf1((bf16_t)h1)) << 16); }
            u32x4* o = WSP(u32x4, WS_WR) + (size_t)((s * 4 + nt) * 2) * 64 + lane;
            o[0] = (u32x4){hi[0], hi[1], hi[2], hi[3]}; o[64] = (u32x4){lo[0], lo[1], lo[2], lo[3]}; continue; }
    }
}
__device__ __forceinline__ void p0b_mod(Frame& F) {
    const float* mp = WSP(float, WS_MODP); float* mod = WSP(float, WS_MOD); const float* ba = F.in[I_BADA];
    for (int i = F.bx * NTHR + F.tid; i < 8 * 12288; i += F.G * NTHR) { float s = ba[i % 12288];
#pragma unroll
        for (int ks = 0; ks < 16; ++ks) s += mp[(size_t)ks * 8 * 12288 + i];
        mod[i] = s; }
}
__device__ __forceinline__ void p1_h1(Frame& F) {
    const int gw = F.bx * NWAVES + F.wave, NGW = F.G * NWAVES, lane = F.lane;
    const float* mod = WSP(float, WS_MOD); const float* g = F.in[I_N1G]; bf16_t* H1 = WSP(bf16_t, WS_H1);
#pragma nounroll
    for (int m = gw; m < T; m += NGW) { const int b = m >> 11;
        const f32x4* xr = (const f32x4*)(F.in[I_X] + (size_t)m * D) + lane;
        f32x4 v[8]; float s = 0.f;
#pragma unroll
        for (int j = 0; j < 8; ++j) { v[j] = xr[64 * j]; s += (v[j].x * v[j].x + v[j].y * v[j].y) + (v[j].z * v[j].z + v[j].w * v[j].w); }
        const float rstd = 1.f / sqrtf(wave_sum(s) * (1.f / D) + EPS);
        u32x2* o = (u32x2*)(H1 + (size_t)m * D) + lane;
#pragma unroll
        for (int j = 0; j < 8; ++j) { const int c = 4 * lane + 256 * j;
            const f32x4 gg = *(const f32x4*)(g + c), sc = *(const f32x4*)(mod + b * 12288 + 2048 + c), sh = *(const f32x4*)(mod + b * 12288 + c);
            const f32x4 h = v[j] * rstd * gg * (sc + 1.f) + sh;
            o[64 * j] = (u32x2){pk2(h.x, h.y), pk2(h.z, h.w)}; }
    }
}

struct EpiProj {
    static constexpr bool PERM = true;
    unsigned char* ws; const float* lbl;
    __device__ __forceinline__ void operator()(const f32x4 (&acc)[2][2][4][2], const pg8::Unit& u, int wr, int wc, int fr, int fq) const {
        const int pn = u.pn, row0 = u.pm * 256 + wr * 64 + fr, ct = 32 * wc + 8 * fq;
        if (pn < 4) {
            bf16_t* QA = (bf16_t*)(ws + WS_QA);
#pragma unroll
            for (int ai = 0; ai < 2; ++ai)
#pragma unroll
                for (int m = 0; m < 4; ++m) { const int row = row0 + ai * 128 + m * 16, b = row >> 11, s = row & 2047;
#pragma unroll
                    for (int bj = 0; bj < 2; ++bj) { const f32x4 v0 = acc[ai][bj][m][0], v1 = acc[ai][bj][m][1];
                        *(u32x4*)(QA + ((size_t)(b * 8 + 2 * pn + bj) * 2048 + s) * 128 + ct) = (u32x4){pk2(v0[0], v0[1]), pk2(v0[2], v0[3]), pk2(v1[0], v1[1]), pk2(v1[2], v1[3])}; } }
        } else if (pn == 4) {
            bf16_t* O = (bf16_t*)(ws + WS_CKV); float* SS = (float*)(ws + WS_CKVSS);
#pragma unroll
            for (int ai = 0; ai < 2; ++ai)
#pragma unroll
                for (int m = 0; m < 4; ++m) { const int row = row0 + ai * 128 + m * 16; float ss = 0.f;
#pragma unroll
                    for (int bj = 0; bj < 2; ++bj) { const f32x4 v0 = acc[ai][bj][m][0], v1 = acc[ai][bj][m][1];
                        ss += (v0[0] * v0[0] + v0[1] * v0[1]) + (v0[2] * v0[2] + v0[3] * v0[3]) + (v1[0] * v1[0] + v1[1] * v1[1]) + (v1[2] * v1[2] + v1[3] * v1[3]);
                        *(u32x4*)(O + (size_t)row * 256 + bj * 128 + ct) = (u32x4){pk2(v0[0], v0[1]), pk2(v0[2], v0[3]), pk2(v1[0], v1[1]), pk2(v1[2], v1[3])}; }
                    ss += __shfl_xor(ss, 16); ss += __shfl_xor(ss, 32);
                    if (fq == 0) SS[(size_t)row * 4 + wc] = ss; }
        } else if (pn >= 13 && pn < 17) {
            float* LF = (float*)(ws + WS_LOGF); bf16_t* KB = (bf16_t*)(ws + WS_KB); const int cb = (pn - 13) * 256 + ct;
            float lb[2][8];
#pragma unroll
            for (int bj = 0; bj < 2; ++bj)
#pragma unroll
                for (int i = 0; i < 8; ++i) { const int c = cb + bj * 128 + i; lb[bj][i] = sigmoidf_(lbl[c] - lbl[1024 + c]); }
#pragma unroll
            for (int ai = 0; ai < 2; ++ai)
#pragma unroll
                for (int m = 0; m < 4; ++m) { const int row = row0 + ai * 128 + m * 16;
#pragma unroll
                    for (int bj = 0; bj < 2; ++bj) { float f[8], lg[8];
#pragma unroll
                        for (int i = 0; i < 8; ++i) { const float a = acc[ai][bj][m][i >> 2][i & 3]; f[i] = lb[bj][i] + (1.f - lb[bj][i]) * sigmoidf_(a); lg[i] = __logf(f[i]); }
                        float* lp = LF + (size_t)row * 1024 + cb + bj * 128;
                        *(f32x4*)lp = (f32x4){lg[0], lg[1], lg[2], lg[3]}; *(f32x4*)(lp + 4) = (f32x4){lg[4], lg[5], lg[6], lg[7]};
                        *(u32x4*)(KB + (size_t)row * 1024 + cb + bj * 128) = (u32x4){pk2(1.f - f[0], 1.f - f[1]), pk2(1.f - f[2], 1.f - f[3]), pk2(1.f - f[4], 1.f - f[5]), pk2(1.f - f[6], 1.f - f[7])}; } }
        } else if (pn == 25) {
            bf16_t* IK = (bf16_t*)(ws + WS_IK); float* IW = (float*)(ws + WS_IW);
#pragma unroll
            for (int ai = 0; ai < 2; ++ai)
#pragma unroll
                for (int m = 0; m < 4; ++m) { const int row = row0 + ai * 128 + m * 16; const f32x4 v0 = acc[ai][0][m][0], v1 = acc[ai][0][m][1];
                    if (wc < 2) *(u32x4*)(IK + (size_t)row * 64 + ct) = (u32x4){pk2(v0[0], v0[1]), pk2(v0[2], v0[3]), pk2(v1[0], v1[1]), pk2(v1[2], v1[3])};
                    else if (wc == 2 && fq < 2) { float* p = IW + (size_t)row * 16 + 8 * fq; *(f32x4*)p = v0 * 0.03125f; *(f32x4*)(p + 4) = v1 * 0.03125f; } }
        } else {
            size_t off; int t0; bool gate = false;
            if (pn < 9) { off = WS_IQ; t0 = 5; } else if (pn < 13) { off = WS_QB; t0 = 9; } else if (pn < 21) { off = WS_IB; t0 = 17; } else { off = WS_GB; t0 = 21; gate = true; }
            bf16_t* O = (bf16_t*)(ws + off); const int cb = (pn - t0) * 256 + ct;
#pragma unroll
            for (int ai = 0; ai < 2; ++ai)
#pragma unroll
                for (int m = 0; m < 4; ++m) { const int row = row0 + ai * 128 + m * 16;
#pragma unroll
                    for (int bj = 0; bj < 2; ++bj) { f32x4 v0 = acc[ai][bj][m][0], v1 = acc[ai][bj][m][1];
                        if (gate) {
#pragma unroll
                            for (int i = 0; i < 4; ++i) { v0[i] = v0[i] * sigmoidf_(v0[i]); v1[i] = v1[i] * sigmoidf_(v1[i]); } }
                        *(u32x4*)(O + (size_t)row * 1024 + cb + bj * 128) = (u32x4){pk2(v0[0], v0[1]), pk2(v0[2], v0[3]), pk2(v1[0], v1[1]), pk2(v1[2], v1[3])}; } }
        }
    }
};
struct EpiKV {
    static constexpr bool PERM = true;
    unsigned char* ws;
    __device__ __forceinline__ void operator()(const f32x4 (&acc)[2][2][4][2], const pg8::Unit& u, int wr, int wc, int fr, int fq) const {
        const int pn = u.pn, row0 = u.pm * 256 + wr * 64 + fr, ct = 32 * wc + 8 * fq;
        bf16_t* O = (bf16_t*)(ws + (pn < 4 ? WS_K : WS_V)); const float* SS = (const float*)(ws + WS_CKVSS); const int hp = (pn & 3) * 2;
#pragma unroll
        for (int ai = 0; ai < 2; ++ai)
#pragma unroll
            for (int m = 0; m < 4; ++m) { const int row = row0 + ai * 128 + m * 16, b = row >> 11, s = row & 2047;
                const f32x4 q = *(const f32x4*)(SS + (size_t)row * 4); const float rstd = 1.f / sqrtf(((q[0] + q[1]) + (q[2] + q[3])) * (1.f / 256.f) + EPS);
#pragma unroll
                for (int bj = 0; bj < 2; ++bj) { const f32x4 v0 = acc[ai][bj][m][0] * rstd, v1 = acc[ai][bj][m][1] * rstd;
                    *(u32x4*)(O + ((size_t)(b * 8 + hp + bj) * 2048 + s) * 128 + ct) = (u32x4){pk2(v0[0], v0[1]), pk2(v0[2], v0[3]), pk2(v1[0], v1[1]), pk2(v1[2], v1[3])}; } }
    }
};
struct EpiOut {
    static constexpr bool PERM = false;
    const float* x; float* x1; const float* mod;
    __device__ __forceinline__ void operator()(const f32x4 (&acc)[2][2][4][2], const pg8::Unit& u, int wr, int wc, int fr, int fq) const {
        const int row0 = u.pm * 256 + wr * 64 + fr, col0 = u.pn * 256 + wc * 32 + 4 * fq, b = (u.pm * 256) >> 11;
        f32x4 g1[2][2];
#pragma unroll
        for (int bj = 0; bj < 2; ++bj)
#pragma unroll
            for (int n = 0; n < 2; ++n) g1[bj][n] = *(const f32x4*)(mod + b * 12288 + 4096 + col0 + bj * 128 + n * 16);
#pragma unroll
        for (int ai = 0; ai < 2; ++ai)
#pragma unroll
            for (int m = 0; m < 4; ++m) { const size_t off = (size_t)(row0 + ai * 128 + m * 16) * 2048 + col0;
#pragma unroll
                for (int bj = 0; bj < 2; ++bj)
#pragma unroll
                    for (int n = 0; n < 2; ++n) { const f32x4 xv = *(const f32x4*)(x + off + bj * 128 + n * 16);
                        *(f32x4*)(x1 + off + bj * 128 + n * 16) = xv + g1[bj][n] * acc[ai][bj][m][n]; }
                asm volatile("" ::: "memory"); }
    }
};

__device__ __forceinline__ void p3_indexer(Frame& F, int first_uid_dummy) {
    (void)first_uid_dummy;
    const int tid = F.tid, lane = F.lane, w = F.wave, c = lane & 31, half = lane >> 5;
    const bf16_t* IQ = WSP(bf16_t, WS_IQ); const bf16_t* IK = WSP(bf16_t, WS_IK); const float* IW = WSP(float, WS_IW); unsigned* MASK = WSP(unsigned, WS_MASK);
    const float NEG = -__builtin_inff();
    float gk[8];
#pragma unroll
    for (int j = 0; j < 8; ++j) gk[j] = F.in[I_IKG][8 * (tid & 7) + j];
    const int sw = (c >> 1) & 7;
    int boff[4];
#pragma unroll
    for (int s = 0; s < 4; ++s) boff[s] = c * 128 + (((2 * s + half) ^ sw) * 16);
    for (;;) {
        __syncthreads();
        if (tid == 0) F.MISC[16] = __hip_atomic_fetch_add(F.ctl + CW_IDXQ, 1u, RLX_AGENT);
        __syncthreads();
        const int uid = (int)F.MISC[16];
        if (uid >= 1024) break;
        const int b = uid & 7, q0 = (127 - (uid >> 3)) * 16, nkeys = q0 + 16, qmax = q0 + 15;
        const int myq = q0 + 2 * w + half;
        bf16x8 Af[4];
        { const int sel = (c >> 2) & 1, head = (c & 3) + 4 * (c >> 3);
          const bf16_t* p = IQ + (size_t)(b * 2048 + q0 + 2 * w + sel) * 1024 + head * 64 + 8 * half;
#pragma unroll
          for (int s = 0; s < 4; ++s) Af[s] = *(const bf16x8*)(p + 16 * s); }
        float wv[16];
        { const f32x4* p = (const f32x4*)(IW + (size_t)(b * 2048 + myq) * 16);
#pragma unroll
          for (int i = 0; i < 4; ++i) { const f32x4 t = p[i]; wv[4 * i] = t[0]; wv[4 * i + 1] = t[1]; wv[4 * i + 2] = t[2]; wv[4 * i + 3] = t[3]; } }
        float v[64];
#pragma unroll
        for (int kt = 0; kt < 64; ++kt) v[kt] = NEG;
#pragma unroll
        for (int pass = 0; pass < 2; ++pass) {
            if (pass * 1024 < nkeys) {
                if (pass) __syncthreads();
                const int klo = pass * 1024, n = (nkeys - klo) < 1024 ? (nkeys - klo) : 1024;
                for (int it = 0; it * 64 < n; ++it) {
                    const int kk = it * 64 + (tid >> 3), ch = tid & 7; float x[8]; float ss = 0.f;
                    if (kk < n) { const u32x4 r = *(const u32x4*)(IK + (size_t)(b * 2048 + klo + kk) * 64 + 8 * ch);
                        x[0] = bflo(r.x); x[1] = bfhi(r.x); x[2] = bflo(r.y); x[3] = bfhi(r.y); x[4] = bflo(r.z); x[5] = bfhi(r.z); x[6] = bflo(r.w); x[7] = bfhi(r.w);
#pragma unroll
                        for (int j = 0; j < 8; ++j) ss += x[j] * x[j]; }
                    else {
#pragma unroll
                        for (int j = 0; j < 8; ++j) x[j] = 0.f; }
                    ss += __shfl_xor(ss, 1); ss += __shfl_xor(ss, 2); ss += __shfl_xor(ss, 4);
                    const float rstd = 1.f / sqrtf(ss * (1.f / 64.f) + EPS);
                    if (kk < n) { u32x4 o; o.x = pk2(x[0] * rstd * gk[0], x[1] * rstd * gk[1]); o.y = pk2(x[2] * rstd * gk[2], x[3] * rstd * gk[3]);
                        o.z = pk2(x[4] * rstd * gk[4], x[5] * rstd * gk[5]); o.w = pk2(x[6] * rstd * gk[6], x[7] * rstd * gk[7]);
                        *(LAS u32x4*)(F.lds + kk * 128 + ((ch ^ ((kk >> 1) & 7)) * 16)) = o; }
                }
                __syncthreads();
#pragma unroll
                for (int kl = 0; kl < 32; ++kl) { const int kt = pass * 32 + kl;
                    if (32 * kt <= qmax) {
                        f32x16 acc = {};
#pragma unroll
                        for (int s = 0; s < 4; ++s) { const bf16x8 bfr = *(const LAS bf16x8*)(F.lds + boff[s] + kl * 4096);
                            acc = __builtin_amdgcn_mfma_f32_32x32x16_bf16(Af[s], bfr, acc, 0, 0, 0); }
                        float sc = 0.f;
#pragma unroll
                        for (int i = 0; i < 16; ++i) sc = fmaf(wv[i], fmaxf(acc[i], 0.f), sc);
                        v[kt] = (32 * kt + c <= myq) ? sc : NEG;
                    }
                }
            }
        }
        float tau = -3.0e38f;
        if (qmax + 1 > TOPK) {
            float mx = NEG, mn = __builtin_inff();
#pragma unroll
            for (int kt = 0; kt < 64; ++kt) { mx = fmaxf(mx, v[kt]); mn = fminf(mn, v[kt] == NEG ? __builtin_inff() : v[kt]); }
#pragma unroll
            for (int o = 1; o < 32; o <<= 1) { mx = fmaxf(mx, __shfl_xor(mx, o)); mn = fminf(mn, __shfl_xor(mn, o)); }
            float lo = mn, hi = mx; bool done = (myq + 1 <= TOPK);
            for (int iter = 0; iter < 64; ++iter) {
                const float mid = 0.5f * lo + 0.5f * hi;
                if (!done && !(mid > lo && mid < hi)) { done = true; tau = lo; }
                if (__all(done)) break;
                int cnt = 0;
#pragma unroll
                for (int kt = 0; kt < 64; ++kt) cnt += (v[kt] >= mid) ? 1 : 0;
#pragma unroll
                for (int o = 1; o < 32; o <<= 1) cnt += __shfl_xor(cnt, o);
                if (!done) { if (cnt == TOPK) { done = true; tau = mid; } else if (cnt > TOPK) lo = mid; else hi = mid; }
            }
            if (!done) tau = lo;
        }
        int mA = 0, mB = 0;
#define IDX_WL(kt) { const unsigned long long m_ = __ballot(v[kt] >= tau); wlane<kt>(mA, (int)(unsigned)m_); wlane<kt>(mB, (int)(unsigned)(m_ >> 32)); }
#define IDX_WL8(k0) IDX_WL(k0) IDX_WL(k0 + 1) IDX_WL(k0 + 2) IDX_WL(k0 + 3) IDX_WL(k0 + 4) IDX_WL(k0 + 5) IDX_WL(k0 + 6) IDX_WL(k0 + 7) __builtin_amdgcn_sched_barrier(0);
        IDX_WL8(0) IDX_WL8(8) IDX_WL8(16) IDX_WL8(24) IDX_WL8(32) IDX_WL8(40) IDX_WL8(48) IDX_WL8(56)
#undef IDX_WL8
#undef IDX_WL
        MASK[(size_t)(b * 2048 + q0 + 2 * w) * 64 + lane] = (unsigned)mA;
        MASK[(size_t)(b * 2048 + q0 + 2 * w + 1) * 64 + lane] = (unsigned)mB;
    }
}

constexpr int HG_PITCH = 272, HG_QD = 0, HG_KI = 16 * HG_PITCH, HG_KDT = 2 * 16 * HG_PITCH, HG_VT = HG_KDT + 4096, HG_DL = HG_VT + 4096, HG_BUF = HG_DL + 512;
__device__ __forceinline__ void p3_hgrn(Frame& F, int bh) {
    const int tid = F.tid, lane = F.lane, w = F.wave, r = lane & 15, g = lane >> 4;
    const int b = bh >> 3, h = bh & 7;
    const float* LOGF = WSP(float, WS_LOGF); const bf16_t* QB = WSP(bf16_t, WS_QB); const bf16_t* KBp = WSP(bf16_t, WS_KB); const bf16_t* IB = WSP(bf16_t, WS_IB); float* HO = WSP(float, WS_HO);
    const int pc = 16 * w + r;
    const size_t colbase = (size_t)h * 128;
    f32x4 S[8];
#pragma unroll
    for (int m = 0; m < 8; ++m) S[m] = (f32x4){0.f, 0.f, 0.f, 0.f};
    float lf[4]; bf16_t qq[4], kk[4]; u32x2 vraw;
#define HG_LOAD(ci) do { const size_t row0 = (size_t)b * 2048 + (ci) * 16; \
        _Pragma("unroll") for (int j = 0; j < 4; ++j) { const size_t o = (row0 + 4 * g + j) * 1024 + colbase + pc; lf[j] = LOGF[o]; qq[j] = QB[o]; kk[j] = KBp[o]; } \
        vraw = *(const u32x2*)(IB + (row0 + (tid >> 5)) * 1024 + colbase + (tid & 31) * 4); } while (0)
#define HG_WRITE(buf) do { LAS unsigned char* L = F.lds + (buf) * HG_BUF; \
        float c0 = lf[0], c1 = c0 + lf[1], c2 = c1 + lf[2], c3 = c2 + lf[3]; \
        const float t0_ = __shfl(c3, r), t1_ = __shfl(c3, r + 16), t2_ = __shfl(c3, r + 32), t3_ = __shfl(c3, r + 48); \
        const float pre = (g > 0 ? t0_ : 0.f) + (g > 1 ? t1_ : 0.f) + (g > 2 ? t2_ : 0.f); const float blast = (t0_ + t1_) + (t2_ + t3_); \
        const float dd = __expf(blast); float bc[4] = {pre + c0, pre + c1, pre + c2, pre + c3}; unsigned kd[4]; \
        _Pragma("unroll") for (int j = 0; j < 4; ++j) { const float e1 = __expf(bc[j]), e3 = 1.f / e1; const float qv = bf1(qq[j]), kv = bf1(kk[j]); const int t = 4 * g + j; \
            *(LAS bf16_t*)(L + HG_QD + t * HG_PITCH + pc * 2) = (bf16_t)f2bf(qv * e1); *(LAS bf16_t*)(L + HG_KI + t * HG_PITCH + pc * 2) = (bf16_t)f2bf(kv * e3); kd[j] = f2bf(kv * dd * e3); } \
        *(LAS u32x2*)(L + HG_KDT + pc * 32 + g * 8) = (u32x2){kd[0] | (kd[1] << 16), kd[2] | (kd[3] << 16)}; \
        if (g == 0) *(LAS float*)(L + HG_DL + pc * 4) = dd; \
        { const int t = tid >> 5, v4 = (tid & 31) * 4; LAS bf16_t* vt = (LAS bf16_t*)(L + HG_VT); \
          vt[(v4 + 0) * 16 + t] = (bf16_t)(vraw.x & 0xffffu); vt[(v4 + 1) * 16 + t] = (bf16_t)(vraw.x >> 16); vt[(v4 + 2) * 16 + t] = (bf16_t)(vraw.y & 0xffffu); vt[(v4 + 3) * 16 + t] = (bf16_t)(vraw.y >> 16); } } while (0)
    HG_LOAD(0); HG_WRITE(0);
    __syncthreads();
    for (int ci = 0; ci < 128; ++ci) {
        const int buf = ci & 1; LAS unsigned char* L = F.lds + buf * HG_BUF;
        if (ci + 1 < 128) HG_LOAD(ci + 1);
        f32x4 sT = (f32x4){0.f, 0.f, 0.f, 0.f};
#pragma unroll
        for (int i = 0; i < 4; ++i) { const bf16x8 a = *(const LAS bf16x8*)(L + HG_KI + r * HG_PITCH + (32 * i + 8 * g) * 2), bq = *(const LAS bf16x8*)(L + HG_QD + r * HG_PITCH + (32 * i + 8 * g) * 2);
            sT = __builtin_amdgcn_mfma_f32_16x16x32_bf16(a, bq, sT, 0, 0, 0); }
#pragma unroll
        for (int j = 0; j < 4; ++j) if (4 * g + j > r) sT[j] = 0.f;
        const u32x4 pw = {pk2(sT[0], sT[1]), pk2(sT[2], sT[3]), 0u, 0u};
        const bf16x8 pfrag = __builtin_bit_cast(bf16x8, pw);
        const u32x2 vi = *(const LAS u32x2*)(L + HG_VT + (16 * w + r) * 32 + g * 8);
        const u32x4 viw = {vi.x, vi.y, 0u, 0u};
        f32x4 oT = __builtin_amdgcn_mfma_f32_16x16x32_bf16(__builtin_bit_cast(bf16x8, viw), pfrag, (f32x4){0.f, 0.f, 0.f, 0.f}, 0, 0, 0);
#pragma unroll
        for (int i = 0; i < 4; ++i) { const u32x4 sa = {pk2(S[2 * i][0], S[2 * i][1]), pk2(S[2 * i][2], S[2 * i][3]), pk2(S[2 * i + 1][0], S[2 * i + 1][1]), pk2(S[2 * i + 1][2], S[2 * i + 1][3])};
            const u32x2 q0 = *(const LAS u32x2*)(L + HG_QD + r * HG_PITCH + (32 * i + 4 * g) * 2), q1 = *(const LAS u32x2*)(L + HG_QD + r * HG_PITCH + (32 * i + 16 + 4 * g) * 2);
            const u32x4 qb = {q0.x, q0.y, q1.x, q1.y};
            oT = __builtin_amdgcn_mfma_f32_16x16x32_bf16(__builtin_bit_cast(bf16x8, sa), __builtin_bit_cast(bf16x8, qb), oT, 0, 0, 0); }
        *(f32x4*)(HO + ((size_t)b * 2048 + ci * 16 + r) * 1024 + colbase + 16 * w + 4 * g) = oT;
        u32x4 vb = {0u, 0u, 0u, 0u};
        if (g < 2) vb = *(const LAS u32x4*)(L + HG_VT + (16 * w + r) * 32 + g * 16);
#pragma unroll
        for (int m = 0; m < 8; ++m) { const f32x4 dv = *(const LAS f32x4*)(L + HG_DL + (16 * m + 4 * g) * 4);
            u32x4 ka = {0u, 0u, 0u, 0u};
            if (g < 2) ka = *(const LAS u32x4*)(L + HG_KDT + (16 * m + r) * 32 + g * 16);
            S[m] = __builtin_amdgcn_mfma_f32_16x16x32_bf16(__builtin_bit_cast(bf16x8, ka), __builtin_bit_cast(bf16x8, vb), S[m] * dv, 0, 0, 0); }
        if (ci + 1 < 128) HG_WRITE(buf ^ 1);
        __syncthreads();
    }
#undef HG_LOAD
#undef HG_WRITE
}

__device__ __forceinline__ int t5_bucket(int n) {
    if (n < 16) return n;
    int l = 16 + (int)(logf((float)n * (1.f / 16.f)) / logf(8.f) * 16.f);
    return l < 31 ? l : 31;
}
__device__ __forceinline__ void p4_attn_naive(Frame& F) {
    const int lane = F.lane, w = F.wave, gw = F.bx * NWAVES + w, NGW = F.G * NWAVES;
    LAS int* list = (LAS int*)(F.lds + w * 4096); LAS float* pl = (LAS float*)(F.lds + w * 4096 + 1024); LAS float* ql = (LAS float*)(F.lds + w * 4096 + 2048);
    const unsigned* MASK = WSP(unsigned, WS_MASK); const bf16_t* QA = WSP(bf16_t, WS_QA); const bf16_t* Kp = WSP(bf16_t, WS_K); const bf16_t* Vp = WSP(bf16_t, WS_V); bf16_t* AO = WSP(bf16_t, WS_AO);
    const float* relb = F.in[I_RELB];
#pragma nounroll
    for (int item = gw; item < T; item += NGW) { const int b = item >> 11, q = item & 2047;
        unsigned mw = MASK[(size_t)item * 64 + lane]; if (NOSEL) { const int k0_ = lane * 32; mw = (q >= k0_ + 31) ? 0xFFFFFFFFu : (q < k0_ ? 0u : ((2u << (q - k0_)) - 1u)); }
        const int cnt = __popc(mw); int pre = cnt;
#pragma unroll
        for (int o = 1; o < 64; o <<= 1) { const int t = __shfl_up(pre, o); if (lane >= o) pre += t; }
        int nsel = __shfl(pre, 63); int pos = pre - cnt; if (nsel > 256) nsel = 256;
        while (mw) { const int bit = __builtin_ctz(mw); if (pos < 256) list[pos] = lane * 32 + bit; ++pos; mw &= mw - 1; }
        LDS_WAIT(); asm volatile("" ::: "memory");
        for (int h = 0; h < 8; ++h) { const size_t hb = (size_t)(b * 8 + h) * 2048;
            { const unsigned qv = *(const unsigned*)(QA + (hb + q) * 128 + 2 * lane); ql[2 * lane] = bflo(qv); ql[2 * lane + 1] = bfhi(qv); }
            LDS_WAIT(); asm volatile("" ::: "memory");
            float sc[4]; float mx = -__builtin_inff();
#pragma unroll
            for (int jj = 0; jj < 4; ++jj) { const int idx = lane + 64 * jj; sc[jj] = -__builtin_inff();
                if (idx < nsel) { const int key = list[idx]; const u32x4* kp = (const u32x4*)(Kp + (hb + key) * 128); float s = 0.f;
#pragma unroll
                    for (int ch = 0; ch < 16; ++ch) { const u32x4 kv = kp[ch]; const f32x4 qa = *(const LAS f32x4*)(ql + 8 * ch), qb = *(const LAS f32x4*)(ql + 8 * ch + 4);
                        s += bflo(kv.x) * qa[0] + bfhi(kv.x) * qa[1] + bflo(kv.y) * qa[2] + bfhi(kv.y) * qa[3] + bflo(kv.z) * qb[0] + bfhi(kv.z) * qb[1] + bflo(kv.w) * qb[2] + bfhi(kv.w) * qb[3]; }
                    sc[jj] = s * ATT_SCALE + (NOBIAS ? 0.f : relb[t5_bucket(q - key > 0 ? q - key : 0) * 8 + h]); }
                mx = fmaxf(mx, sc[jj]); }
#pragma unroll
            for (int o = 1; o < 64; o <<= 1) mx = fmaxf(mx, __shfl_xor(mx, o));
            float ls = 0.f;
#pragma unroll
            for (int jj = 0; jj < 4; ++jj) { const int idx = lane + 64 * jj; const float p = (idx < nsel) ? __expf(sc[jj] - mx) : 0.f; ls += p; pl[idx] = p; }
            ls = wave_sum(ls);
            LDS_WAIT(); asm volatile("" ::: "memory");
            const int dg = lane & 15, kg = lane >> 4; float o[8];
#pragma unroll
            for (int i = 0; i < 8; ++i) o[i] = 0.f;
#pragma unroll 4
            for (int i0 = 0; i0 < nsel; i0 += 4) { const int i = i0 + kg;
                if (i < nsel) { const int key = list[i]; const float p = pl[i]; const u32x4 vv = *(const u32x4*)(Vp + (hb + key) * 128 + 8 * dg);
                    o[0] += p * bflo(vv.x); o[1] += p * bfhi(vv.x); o[2] += p * bflo(vv.y); o[3] += p * bfhi(vv.y); o[4] += p * bflo(vv.z); o[5] += p * bfhi(vv.z); o[6] += p * bflo(vv.w); o[7] += p * bfhi(vv.w); } }
            const float inv = 1.f / ls;
#pragma unroll
            for (int i = 0; i < 8; ++i) { o[i] += __shfl_xor(o[i], 16); o[i] += __shfl_xor(o[i], 32); o[i] *= inv; }
            if (kg == 0) *(u32x4*)(AO + (hb + q) * 128 + 8 * dg) = (u32x4){pk2(o[0], o[1]), pk2(o[2], o[3]), pk2(o[4], o[5]), pk2(o[6], o[7])};
            LDS_WAIT(); asm volatile("" ::: "memory");
        }
    }
}

namespace att {
constexpr int NW = 8, QBLK = 32, KVBLK = 64, QB = NW * QBLK, DH = 128;
constexpr int SHM_V = KVBLK * DH * 2, SHM_K = KVBLK * DH * 2;
constexpr int OFF_WS = 2 * SHM_V + 2 * SHM_K, OFF_TB = OFF_WS + NW * 64 * 4, TB_N = 384, OFF_MK = OFF_TB + 8 * TB_N * 4, OFF_Q = OFF_MK + 4096;
constexpr float SCALE = 0.08838834764831845f, THR = 8.f;
constexpr unsigned WBIG = 0x40000000u;
#define KSWZ(row, colB) ((row) * 256 + ((colB) ^ (((row) & 7) << 4)))
#define SBAR() __builtin_amdgcn_sched_barrier(0)
__device__ __forceinline__ int v_st(int k, int c) { const int kk = (k & ~0xC) | ((k & 4) << 1) | ((k & 8) >> 1); return ((kk >> 3) * 4 + (c >> 5)) * 512 + ((kk & 7) * 32 + (c & 31)) * 2; }
__device__ __forceinline__ int v_rd_base(int lane) { return ((lane & 3) << 3) | (((lane >> 2) & 3) << 6) | (((lane >> 4) & 1) << 5) | (((lane >> 5) & 1) << 8); }
constexpr int v_rd_off(int d0, int ks, int half) { return d0 * 512 + ks * 4096 + half * 2048; }
__device__ __forceinline__ int crow(int r, int hi) { return (r & 3) + 8 * (r >> 2) + 4 * hi; }
__device__ __forceinline__ void mask_tile(f32x16& p0, f32x16& p1, int dq, unsigned W) {
    const float NEG = -__builtin_inff();
#pragma unroll
    for (int r = 0; r < 16; ++r) { const int c = (r & 3) + 8 * (r >> 2);
        if ((unsigned)(dq - c) >= W) p0[r] = NEG;
        if ((unsigned)(dq - c - 32) >= W) p1[r] = NEG; }
}
__device__ __forceinline__ void swap32(unsigned& a, unsigned& b) { asm volatile("s_nop 1\n\tv_permlane32_swap_b32 %0, %1\n\ts_nop 1" : "+v"(a), "+v"(b)); }
__device__ __forceinline__ float selmask(float p, unsigned ws, int c) { if (NOSEL) return p; return __builtin_bit_cast(float, __builtin_bit_cast(unsigned, p) & (unsigned)__builtin_amdgcn_sbfe((int)ws, c, 1)); }
__device__ __forceinline__ void partialSM(f32x16& p0, f32x16& p1, float& m_reg, float& mn, float& alpha, unsigned w0s) {
    float pmax = p0[0]; for (int r = 1; r < 16; ++r) pmax = fmaxf(pmax, p0[r]); for (int r = 0; r < 16; ++r) pmax = fmaxf(pmax, p1[r]);
    { unsigned xa = __builtin_bit_cast(unsigned, pmax), xb = xa; swap32(xa, xb);
      pmax = fmaxf(__builtin_bit_cast(float, xa), __builtin_bit_cast(float, xb)); }
    constexpr float C2 = 1.4426950408889634f * SCALE;
    if (__builtin_expect(__all((pmax - m_reg) * SCALE <= THR), 1)) { mn = m_reg; alpha = 1.f; }
    else { mn = fmaxf(m_reg, pmax); alpha = __builtin_amdgcn_exp2f((m_reg - mn) * C2); m_reg = mn; }
    const float mnL = -mn * C2;
    for (int r = 0; r < 16; ++r) p0[r] = fmaf(p0[r], C2, mnL); for (int r = 0; r < 16; ++r) p1[r] = fmaf(p1[r], C2, mnL);
    for (int r = 0; r < 16; ++r) p0[r] = selmask(__builtin_amdgcn_exp2f(p0[r]), w0s, (r & 3) + 8 * (r >> 2));
}
__device__ __forceinline__ void finishSM(f32x16& p0, f32x16& p1, float alpha, float& l_reg, bf16x8& pa0, bf16x8& pa1, bf16x8& pa2, bf16x8& pa3, unsigned w1s) {
    for (int r = 0; r < 16; ++r) p1[r] = selmask(__builtin_amdgcn_exp2f(p1[r]), w1s, (r & 3) + 8 * (r >> 2));
    float ps = 0; for (int r = 0; r < 16; ++r) ps += p0[r]; for (int r = 0; r < 16; ++r) ps += p1[r];
    { unsigned xa = __builtin_bit_cast(unsigned, ps), xb = xa; swap32(xa, xb);
      ps = __builtin_bit_cast(float, xa) + __builtin_bit_cast(float, xb); }
    l_reg = l_reg * alpha + ps;
#define PK4(P, B_, OUT) do { unsigned a0 = pk2(P[B_+0], P[B_+1]), a1 = pk2(P[B_+2], P[B_+3]);                          \
        unsigned b0 = pk2(P[B_+4], P[B_+5]), b1 = pk2(P[B_+6], P[B_+7]);                                             \
        auto r0 = __builtin_amdgcn_permlane32_swap(a0, b0, false, false); auto r1 = __builtin_amdgcn_permlane32_swap(a1, b1, false, false); \
        u32x4 w = {r0[0], r1[0], r0[1], r1[1]}; OUT = __builtin_bit_cast(bf16x8, w); } while (0)
    PK4(p0, 0, pa0); PK4(p0, 8, pa1); PK4(p1, 0, pa2); PK4(p1, 8, pa3);
#undef PK4
}
template <int KB>
__device__ __forceinline__ void qkt(f32x16& p0, f32x16& p1, const char* K_lds, int r32, int hi, const char* qb, const bf16x8* qr_) {
    p0 = f32x16{}; p1 = f32x16{};
    const char* kb[4];
#pragma unroll
    for (int dd = 0; dd < 4; ++dd) kb[dd] = K_lds + KB * SHM_K + KSWZ(r32, (dd * 16 + hi * 8) * 2);
#pragma unroll
    for (int d0 = 0; d0 < 8; ++d0) { const char* a = kb[d0 & 3] + (d0 >> 2) * 128;
        bf16x8 b0 = *reinterpret_cast<const bf16x8*>(a);
        bf16x8 b1 = *reinterpret_cast<const bf16x8*>(a + 32 * 256);
        const bf16x8 qf = QREG ? qr_[d0] : *reinterpret_cast<const bf16x8*>(qb + d0 * 1024);
        p0 = __builtin_amdgcn_mfma_f32_32x32x16_bf16(b0, qf, p0, 0, 0, 0);
        p1 = __builtin_amdgcn_mfma_f32_32x32x16_bf16(b1, qf, p1, 0, 0, 0); }
}
template <int VB>
__device__ __forceinline__ void pv_tile(f32x16* o, int vb0, bf16x8 pa0, bf16x8 pa1, bf16x8 pa2, bf16x8 pa3) {
#define TRRD(dst, off) asm volatile("ds_read_b64_tr_b16 %0, %1 offset:%2" : "=&v"(dst) : "v"(vb0), "i"(off) : "memory")
#define PV_D0(d0) do { s16x4 l0, l1, l2, l3, h0, h1, h2, h3; constexpr int b_ = VB * SHM_V + v_rd_off(d0, 0, 0); \
        TRRD(l0, b_); TRRD(h0, b_ + 2048); TRRD(l1, b_ + 4096); TRRD(h1, b_ + 6144); TRRD(l2, b_ + 8192); TRRD(h2, b_ + 10240); TRRD(l3, b_ + 12288); TRRD(h3, b_ + 14336); \
        asm volatile("s_waitcnt lgkmcnt(0)" ::: "memory"); SBAR();   \
        o[d0] = __builtin_amdgcn_mfma_f32_32x32x16_bf16(pa0, (bf16x8){l0[0], l0[1], l0[2], l0[3], h0[0], h0[1], h0[2], h0[3]}, o[d0], 0, 0, 0);   \
        o[d0] = __builtin_amdgcn_mfma_f32_32x32x16_bf16(pa1, (bf16x8){l1[0], l1[1], l1[2], l1[3], h1[0], h1[1], h1[2], h1[3]}, o[d0], 0, 0, 0);   \
        o[d0] = __builtin_amdgcn_mfma_f32_32x32x16_bf16(pa2, (bf16x8){l2[0], l2[1], l2[2], l2[3], h2[0], h2[1], h2[2], h2[3]}, o[d0], 0, 0, 0);   \
        o[d0] = __builtin_amdgcn_mfma_f32_32x32x16_bf16(pa3, (bf16x8){l3[0], l3[1], l3[2], l3[3], h3[0], h3[1], h3[2], h3[3]}, o[d0], 0, 0, 0); } while (0)
    PV_D0(0); PV_D0(1); PV_D0(2); PV_D0(3);
#undef PV_D0
#undef TRRD
}
struct BlockRef { const bf16_t* Q; const bf16_t* K; const bf16_t* V; bf16_t* O; const unsigned* M; int P0; int h; };
struct Seam { bf16x8 st_v0, st_v1, st_k0, st_k1; unsigned st_m; };
#define ROW(p, k0, rr) ((p) + (size_t)((k0) + (rr)) * DH + sc)
#define VMW() asm volatile("s_waitcnt vmcnt(0)" ::: "memory")
#define VMWN(n) asm volatile("s_waitcnt vmcnt(%0)" :: "i"(n) : "memory")
#define LD8(p) (*reinterpret_cast<const bf16x8*>(p))
#define SLOAD_H(Kp, Vp, Mp, k0) do { S.st_v0 = LD8(ROW(Vp, k0, sr)); S.st_v1 = LD8(ROW(Vp, k0, 32 + sr)); S.st_k0 = LD8(ROW(Kp, k0, sr)); S.st_k1 = LD8(ROW(Kp, k0, 32 + sr)); \
        S.st_m = (Mp)[(tid >> 1) * 64 + ((k0) >> 5) + (tid & 1)]; } while (0)
#define SWRITE_HK(bf) do { *(bf16x8*)(K_lds + (bf) * SHM_K + kws) = S.st_k0; *(bf16x8*)(K_lds + (bf) * SHM_K + kws + 32 * 256) = S.st_k1; *(unsigned*)(lds + OFF_MK + (bf) * 2048 + tid * 4) = S.st_m; } while (0)
#define SWRITE_HV(bf) do { *(bf16x8*)(V_lds + (bf) * SHM_V + vst0) = S.st_v0; *(bf16x8*)(V_lds + (bf) * SHM_V + vst1) = S.st_v1; } while (0)
#define SWRITE_H(bf) do { SWRITE_HV(bf); SWRITE_HK(bf); } while (0)
__device__ __forceinline__ void prime(const BlockRef& cur, char* lds, Seam& S) {
    const int tid = threadIdx.x, wid = __builtin_amdgcn_readfirstlane(tid >> 6), lane = tid & 63, r32 = lane & 31, hi = lane >> 5;
    const int sr = tid >> 4, sc = (tid & 15) * 8, kws = KSWZ(sr, sc * 2); char* K_lds = lds + 2 * SHM_V;
    (void)wid; (void)lane; (void)r32; (void)hi;
    SLOAD_H(cur.K, cur.V, cur.M, 0); VMW(); SWRITE_HK(0);
    __syncthreads();
}
__device__ __forceinline__ void block(const BlockRef& cur, const BlockRef& nxt, char* lds, Seam& S) {
    const int tid = threadIdx.x, wid = __builtin_amdgcn_readfirstlane(tid >> 6), lane = tid & 63, r32 = lane & 31, hi = lane >> 5;
    const int NT = (cur.P0 + QB - 1) / KVBLK + 1;
    const int qlo = cur.P0 + wid * QBLK, qm = qlo + r32 - 4 * hi;
    char* V_lds = lds; char* K_lds = lds + 2 * SHM_V;
    float* ws = (float*)(lds + OFF_WS) + wid * 64; float* li_l = ws, * al_l = ws + 32;
    const char* tbh = lds + OFF_TB + cur.h * (TB_N * 4);
    float m_reg = -1e30f, l_reg = 0; f32x16 o[4] = {};
    const int sr = tid >> 4, sc = (tid & 15) * 8, vst0 = v_st(sr, sc), vst1 = v_st(32 + sr, sc), kws = KSWZ(sr, sc * 2);
    const int vb0 = (int)(uintptr_t)V_lds + v_rd_base(lane);
    const bf16_t* Kh = cur.K; const bf16_t* Vh = cur.V;
    const unsigned* Mh = cur.M;
    char* qb = lds + OFF_Q + wid * 8192 + lane * 16;
    bf16x8 qrr[8];
    { const bf16_t* qs2 = cur.Q + (size_t)(wid * QBLK + r32) * DH + hi * 8;
#pragma unroll
      for (int d0 = 0; d0 < 8; ++d0) qrr[d0] = QREG ? LD8(qs2 + d0 * 16) : bf16x8{}; }
    { bf16x8 qt[8]; const bf16_t* qsrc = cur.Q + (size_t)(wid * QBLK + opaque(r32)) * DH + opaque(hi) * 8;
#pragma unroll
      for (int d0 = 0; d0 < 8; ++d0) qt[d0] = LD8(qsrc + d0 * 16);
#pragma unroll
      for (int d0 = 0; d0 < 8; ++d0) *(bf16x8*)(qb + d0 * 1024) = qt[d0]; }
    const char* mkl = lds + OFF_MK + (wid * QBLK + r32) * 8;
#define MW0(bf) ((*(const unsigned*)(mkl + (bf) * 2048)) >> (4 * hi))
#define MW1(bf) ((*(const unsigned*)(mkl + (bf) * 2048 + 4)) >> (4 * hi))
#define RESC(a) do { if (__any((a) < 1.f)) { if (hi == 0) al_l[r32] = (a); asm volatile("s_waitcnt lgkmcnt(0)" ::: "memory");              \
                     for (int d_ = 0; d_ < 4; ++d_) for (int r = 0; r < 16; ++r) o[d_][r] *= al_l[crow(r, hi)]; } } while (0)
#define KBASE(t) ((t) * KVBLK)
#define MASKT(P0_, P1_, t) do { const int kb_ = KBASE(t); if (kb_ + KVBLK - 1 > qlo) mask_tile(P0_, P1_, qm - kb_, WBIG); } while (0)
#define BIAST(P0_, P1_, t) do { const int kb_ = KBASE(t); const int dmax_ = qlo + QBLK - 1 - kb_, dmin_ = qlo - kb_ - (KVBLK - 1);                     \
        if (!NOBIAS && dmax_ >= 0 && dmin_ < 113) { const char* tp_ = tbh + (287 - (qm - kb_)) * 4;                                                               \
            _Pragma("unroll") for (int r = 0; r < 16; ++r) { const int c_ = (r & 3) + 8 * (r >> 2);                                                    \
                P0_[r] += *(const float*)(tp_ + c_ * 4); P1_[r] += *(const float*)(tp_ + (c_ + 32) * 4); } } } while (0)
#define SEAM_K0() do { VMW(); SWRITE_HK(0); SBAR(); } while (0)
    f32x16 pA0, pA1, pB0, pB1; float mnA, mnB, alA, alB; bf16x8 pa0, pa1, pa2, pa3;
    SWRITE_HV(0); SBAR();
    if (NT > 1) { SLOAD_H(Kh, Vh, Mh, KBASE(1)); }
    SBAR(); qkt<0>(pA0, pA1, K_lds, r32, hi, qb, qrr);
    BIAST(pA0, pA1, 0); MASKT(pA0, pA1, 0); partialSM(pA0, pA1, m_reg, mnA, alA, MW0(0));
    if (NT > 1) { VMW(); SWRITE_H(1); }
    __syncthreads();
#define HALF_STEP(PX0, PX1, mnX, alX, PY0, PY1, alY, t, KB, VB, SB) do {                                                      \
        SBAR(); qkt<KB>(PX0, PX1, K_lds, r32, hi, qb, qrr);                                                                      \
        finishSM(PY0, PY1, alY, l_reg, pa0, pa1, pa2, pa3, MW1(VB)); SBAR();                                                  \
        if ((t) + 1 < NT) { SLOAD_H(Kh, Vh, Mh, KBASE((t) + 1)); SBAR(); }                                                    \
        pv_tile<VB>(o, vb0, pa0, pa1, pa2, pa3); BIAST(PX0, PX1, (t)); MASKT(PX0, PX1, (t)); partialSM(PX0, PX1, m_reg, mnX, alX, MW0(KB));  \
        __syncthreads();                                                                                                      \
        if ((t) + 1 < NT) { VMW(); SWRITE_H(SB); }                                                                            \
        RESC(alX); __syncthreads(); } while (0)
    for (int t = 1; t + 1 < NT; t += 2) {
        HALF_STEP(pB0, pB1, mnB, alB, pA0, pA1, alA, t, 1, 0, 0);
        HALF_STEP(pA0, pA1, mnA, alA, pB0, pB1, alB, t + 1, 0, 1, 1);
    }
    const bool even = (NT & 1) == 0;
    if (even) { SBAR(); qkt<1>(pB0, pB1, K_lds, r32, hi, qb, qrr); SBAR(); }
    SLOAD_H(nxt.K, nxt.V, nxt.M, 0); SBAR();
    finishSM(pA0, pA1, alA, l_reg, pa0, pa1, pa2, pa3, MW1(0)); SBAR();
    pv_tile<0>(o, vb0, pa0, pa1, pa2, pa3);
    if (even) { BIAST(pB0, pB1, NT - 1); MASKT(pB0, pB1, NT - 1); partialSM(pB0, pB1, m_reg, mnB, alB, MW0(1)); __syncthreads(); RESC(alB);
        finishSM(pB0, pB1, alB, l_reg, pa0, pa1, pa2, pa3, MW1(1)); SBAR(); pv_tile<1>(o, vb0, pa0, pa1, pa2, pa3); }
    else __syncthreads();
    SBAR(); SEAM_K0();
    if (hi == 0) li_l[r32] = l_reg; asm volatile("s_waitcnt lgkmcnt(0)" ::: "memory");
    { const int hie = opaque(hi), r32e = opaque(r32);
    float rli[16];
#pragma unroll
    for (int r = 0; r < 16; ++r) rli[r] = __builtin_amdgcn_rcpf(li_l[crow(r, hie)]);
    bf16_t* Ow = cur.O + (size_t)(wid * QBLK) * DH;
#pragma unroll
    for (int r = 0; r < 16; ++r) { const int orow = crow(r, hie);
#pragma unroll
        for (int d0 = 0; d0 < 4; ++d0) { const float v = o[d0][r] * rli[r]; const float vn = __shfl_xor(v, 1);
            if ((r32e & 1) == 0) *(unsigned*)(Ow + (size_t)orow * DH + d0 * 32 + r32e) = pk2(v, vn); } } }
    __syncthreads();
#undef RESC
#undef KBASE
#undef MASKT
#undef BIAST
#undef SEAM_K0
#undef HALF_STEP
#undef MW0
#undef MW1
}
#undef ROW
#undef VMW
#undef VMWN
#undef LD8
#undef SLOAD_H
#undef SWRITE_HK
#undef SWRITE_HV
#undef SWRITE_H
#undef KSWZ
#undef SBAR
}
__device__ __forceinline__ void p4_attn_dense(Frame& F, bf16_t* AO) {
    char* lds = (char*)F.lds;
    const bf16_t* QA = WSP(bf16_t, WS_QA); const bf16_t* Kp = WSP(bf16_t, WS_K); const bf16_t* Vp = WSP(bf16_t, WS_V); const unsigned* MASK = WSP(unsigned, WS_MASK);
    { const float* relb = F.in[I_RELB]; LAS float* tb = (LAS float*)(F.lds + att::OFF_TB);
      for (int i = F.tid; i < 8 * att::TB_N; i += NTHR) { const int h = i / att::TB_N, j = i % att::TB_N, d = 287 - j;
          tb[i] = (d >= 0 && d < 128) ? (relb[t5_bucket(d) * 8 + h] - relb[31 * 8 + h]) * (1.f / att::SCALE) : 0.f; } }
    __syncthreads();
    const int total = 64 * 4;
    int L = F.bx; if (L >= total) return;
    auto mkref = [&](int item, int pass) { const int bh = item >> 2, y = item & 3, qb = pass ? 7 - y : y; att::BlockRef r;
        r.Q = QA + ((size_t)bh * 2048 + qb * 256) * 128; r.O = AO + ((size_t)bh * 2048 + qb * 256) * 128; r.K = Kp + (size_t)bh * 2048 * 128; r.V = Vp + (size_t)bh * 2048 * 128;
        r.M = MASK + ((size_t)(bh >> 3) * 2048 + qb * 256) * 64; r.P0 = qb * 256; r.h = bh & 7; return r; };
    int pass = 0; att::BlockRef cur = mkref(L, 0); att::Seam S;
    att::prime(cur, lds, S);
    for (;;) {
        const bool more_pass = pass == 0, more_item = L + F.G < total, last = !more_pass && !more_item;
        int passn = pass + 1, Ln = L;
        if (!more_pass) { passn = 0; Ln = more_item ? L + F.G : L; }
        const att::BlockRef nxt = last ? cur : mkref(Ln, passn);
        att::block(cur, nxt, lds, S);
        if (last) break;
        cur = nxt; pass = passn; L = Ln;
    }
}

__device__ __forceinline__ void p5_finalize(Frame& F) {
    const int lane = F.lane, gw = F.bx * NWAVES + F.wave, NGW = F.G * NWAVES;
    const bf16_t* AO = WSP(bf16_t, WS_AO); const float* HO = WSP(float, WS_HO); const bf16_t* GB = WSP(bf16_t, WS_GB); bf16_t* A2 = WSP(bf16_t, WS_A2);
    const float* ag = F.in[I_AOG]; const float* hg = F.in[I_HOG];
#pragma nounroll
    for (int m = gw; m < T; m += NGW) { const int b = m >> 11, s = m & 2047;
        const int hh = lane >> 3, c0 = 16 * (lane & 7);
        const u32x4* ap = (const u32x4*)(AO + ((size_t)(b * 8 + hh) * 2048 + s) * 128 + c0);
        const u32x4 a0 = ap[0], a1 = ap[1]; float av[16];
        av[0] = bflo(a0.x); av[1] = bfhi(a0.x); av[2] = bflo(a0.y); av[3] = bfhi(a0.y); av[4] = bflo(a0.z); av[5] = bfhi(a0.z); av[6] = bflo(a0.w); av[7] = bfhi(a0.w);
        av[8] = bflo(a1.x); av[9] = bfhi(a1.x); av[10] = bflo(a1.y); av[11] = bfhi(a1.y); av[12] = bflo(a1.z); av[13] = bfhi(a1.z); av[14] = bflo(a1.w); av[15] = bfhi(a1.w);
        float ss = 0.f;
#pragma unroll
        for (int i = 0; i < 16; ++i) ss += av[i] * av[i];
        const float rstd = 1.f / sqrtf(wave_sum(ss) * (1.f / 1024.f) + EPS);
        unsigned ow[8];
#pragma unroll
        for (int i = 0; i < 8; ++i) ow[i] = pk2(av[2 * i] * rstd * ag[16 * lane + 2 * i], av[2 * i + 1] * rstd * ag[16 * lane + 2 * i + 1]);
        u32x4* op = (u32x4*)(A2 + (size_t)m * 2048 + 16 * lane);
        op[0] = (u32x4){ow[0], ow[1], ow[2], ow[3]}; op[1] = (u32x4){ow[4], ow[5], ow[6], ow[7]};
        const f32x4* hp = (const f32x4*)(HO + (size_t)m * 1024 + 16 * lane); float hv[16];
#pragma unroll
        for (int i = 0; i < 4; ++i) { const f32x4 t = hp[i]; hv[4 * i] = t[0]; hv[4 * i + 1] = t[1]; hv[4 * i + 2] = t[2]; hv[4 * i + 3] = t[3]; }
        float s2 = 0.f;
#pragma unroll
        for (int i = 0; i < 16; ++i) s2 += hv[i] * hv[i];
        s2 += __shfl_xor(s2, 1); s2 += __shfl_xor(s2, 2); s2 += __shfl_xor(s2, 4);
        const float r2 = 1.f / sqrtf(s2 * (1.f / 128.f) + EPS);
        const u32x4* gp = (const u32x4*)(GB + (size_t)m * 1024 + 16 * lane); const u32x4 g0 = gp[0], g1 = gp[1]; float gv[16];
        gv[0] = bflo(g0.x); gv[1] = bfhi(g0.x); gv[2] = bflo(g0.y); gv[3] = bfhi(g0.y); gv[4] = bflo(g0.z); gv[5] = bfhi(g0.z); gv[6] = bflo(g0.w); gv[7] = bfhi(g0.w);
        gv[8] = bflo(g1.x); gv[9] = bfhi(g1.x); gv[10] = bflo(g1.y); gv[11] = bfhi(g1.y); gv[12] = bflo(g1.z); gv[13] = bfhi(g1.z); gv[14] = bflo(g1.w); gv[15] = bfhi(g1.w);
#pragma unroll
        for (int i = 0; i < 8; ++i) ow[i] = pk2(hv[2 * i] * r2 * hg[16 * lane + 2 * i] * gv[2 * i], hv[2 * i + 1] * r2 * hg[16 * lane + 2 * i + 1] * gv[2 * i + 1]);
        op = (u32x4*)(A2 + (size_t)m * 2048 + 1024 + 16 * lane);
        op[0] = (u32x4){ow[0], ow[1], ow[2], ow[3]}; op[1] = (u32x4){ow[4], ow[5], ow[6], ow[7]};
    }
}

constexpr int R_GM = 0, R_SH = 8192, R_LG = 16384, R_SC = 32768, R_HIST = 49152, R_BASE = 49408;
__device__ __forceinline__ void p7_router(Frame& F) {
    const int tid = F.tid, lane = F.lane, w = F.wave, r = lane & 15, g = lane >> 4;
    const float* X1 = WSP(float, WS_X1); const float* mod = WSP(float, WS_MOD); const float* n2g = F.in[I_N2G]; const float* rbias = F.in[I_RBIAS];
    bf16_t* H2 = WSP(bf16_t, WS_H2); const u32x4* WR = WSP(u32x4, WS_WR);
    int* LTOK = WSP(int, WS_LTOK); int* LDSTp = WSP(int, WS_LDST); float* LWp = WSP(float, WS_LW);
    LAS float* GM = (LAS float*)(F.lds + R_GM); LAS float* SH = (LAS float*)(F.lds + R_SH); LAS float* LG = (LAS float*)(F.lds + R_LG); LAS float* SC = (LAS float*)(F.lds + R_SC);
    LAS int* HIST = (LAS int*)(F.lds + R_HIST); LAS int* BASE = (LAS int*)(F.lds + R_BASE);
    if (F.bx == 0 && tid < 256) WSP(u32x4, WS_H2 + (size_t)T * 2048 * 2)[tid] = (u32x4){0u, 0u, 0u, 0u};
    for (int unit = F.bx; unit < T / 64; unit += F.G) {
        const int tok0 = unit * 64, b = tok0 >> 11;
        __syncthreads();
        for (int i = tid; i < 2048; i += NTHR) { GM[i] = n2g[i] * (1.f + mod[b * 12288 + 8192 + i]); SH[i] = mod[b * 12288 + 6144 + i]; }
        if (tid < 64) HIST[tid] = 0;
        __syncthreads();
        const int row = tok0 + 8 * w + (r & 7);
        const float* xr = X1 + (size_t)row * 2048 + 8 * g;
        float ss = 0.f;
#pragma unroll 8
        for (int s = 0; s < 64; ++s) { const f32x4 a = *(const f32x4*)(xr + 32 * s), c = *(const f32x4*)(xr + 32 * s + 4);
            ss += (a[0] * a[0] + a[1] * a[1]) + (a[2] * a[2] + a[3] * a[3]) + (c[0] * c[0] + c[1] * c[1]) + (c[2] * c[2] + c[3] * c[3]); }
        ss += __shfl_xor(ss, 16); ss += __shfl_xor(ss, 32);
        const float rstd = 1.f / sqrtf(ss * (1.f / 2048.f) + EPS);
        f32x4 acc[4];
#pragma unroll
        for (int nt = 0; nt < 4; ++nt) acc[nt] = (f32x4){0.f, 0.f, 0.f, 0.f};
#pragma unroll 2
        for (int s = 0; s < 64; ++s) { const int k0 = 32 * s + 8 * g;
            const f32x4 a = *(const f32x4*)(xr + 32 * s), c = *(const f32x4*)(xr + 32 * s + 4);
            const f32x4 g0 = *(const LAS f32x4*)(GM + k0), g1 = *(const LAS f32x4*)(GM + k0 + 4), s0 = *(const LAS f32x4*)(SH + k0), s1 = *(const LAS f32x4*)(SH + k0 + 4);
            const f32x4 h0 = a * rstd * g0 + s0, h1 = c * rstd * g1 + s1;
            unsigned hi[4], lo[4];
#pragma unroll
            for (int j = 0; j < 2; ++j) { const unsigned p0 = f2bf(h0[2 * j]), p1 = f2bf(h0[2 * j + 1]); hi[j] = p0 | (p1 << 16); lo[j] = pk2(h0[2 * j] - bf1((bf16_t)p0), h0[2 * j + 1] - bf1((bf16_t)p1)); }
#pragma unroll
            for (int j = 0; j < 2; ++j) { const unsigned p0 = f2bf(h1[2 * j]), p1 = f2bf(h1[2 * j + 1]); hi[2 + j] = p0 | (p1 << 16); lo[2 + j] = pk2(h1[2 * j] - bf1((bf16_t)p0), h1[2 * j + 1] - bf1((bf16_t)p1)); }
            const u32x4 hiw = {hi[0], hi[1], hi[2], hi[3]}, low = {lo[0], lo[1], lo[2], lo[3]};
            if (r < 8) *(u32x4*)(H2 + (size_t)row * 2048 + k0) = hiw;
            const bf16x8 ah = __builtin_bit_cast(bf16x8, hiw), al = __builtin_bit_cast(bf16x8, low);
#pragma unroll
            for (int nt = 0; nt < 4; ++nt) { const u32x4 bh = WR[(size_t)((s * 4 + nt) * 2) * 64 + lane], bl = WR[(size_t)((s * 4 + nt) * 2 + 1) * 64 + lane];
                acc[nt] = __builtin_amdgcn_mfma_f32_16x16x32_bf16(ah, __builtin_bit_cast(bf16x8, bh), acc[nt], 0, 0, 0);
                acc[nt] = __builtin_amdgcn_mfma_f32_16x16x32_bf16(al, __builtin_bit_cast(bf16x8, bh), acc[nt], 0, 0, 0);
                acc[nt] = __builtin_amdgcn_mfma_f32_16x16x32_bf16(ah, __builtin_bit_cast(bf16x8, bl), acc[nt], 0, 0, 0); }
        }
        if (g < 2) {
#pragma unroll
            for (int nt = 0; nt < 4; ++nt)
#pragma unroll
                for (int j = 0; j < 4; ++j) LG[(w * 8 + 4 * g + j) * 64 + 16 * nt + r] = acc[nt][j]; }
        LDS_WAIT(); asm volatile("" ::: "memory");
        int ee[8], lp[8]; float ww[8];
        if (lane < 8) { const int base = (w * 8 + lane) * 64;
            for (int e = 0; e < 64; ++e) SC[base + e] = sigmoidf_(LG[base + e]);
            float grp[8];
#pragma unroll
            for (int gg = 0; gg < 8; ++gg) { float m1 = -__builtin_inff(), m2 = -__builtin_inff();
                for (int j = 0; j < 8; ++j) { const float v = SC[base + gg * 8 + j] + rbias[gg * 8 + j]; if (v > m1) { m2 = m1; m1 = v; } else if (v > m2) m2 = v; }
                grp[gg] = m1 + m2; }
            unsigned gsel = 0u;
#pragma unroll
            for (int it = 0; it < 4; ++it) { float best = -__builtin_inff(); int bi = 0;
#pragma unroll
                for (int gg = 0; gg < 8; ++gg) if (!((gsel >> gg) & 1u) && grp[gg] > best) { best = grp[gg]; bi = gg; }
                gsel |= 1u << bi; }
            unsigned long long taken = 0ull; float wsum = 0.f;
#pragma unroll
            for (int k = 0; k < 8; ++k) { float best = -__builtin_inff(); int bi = 0;
                for (int e = 0; e < 64; ++e) { if (!((gsel >> (e >> 3)) & 1u) || ((taken >> e) & 1ull)) continue; const float v = SC[base + e] + rbias[e]; if (v > best) { best = v; bi = e; } }
                taken |= 1ull << bi; ee[k] = bi; ww[k] = SC[base + bi]; wsum += ww[k]; }
            const float sc_ = 2.5f / wsum;
#pragma unroll
            for (int k = 0; k < 8; ++k) { ww[k] *= sc_; lp[k] = __hip_atomic_fetch_add(HIST + ee[k], 1, __ATOMIC_RELAXED, __HIP_MEMORY_SCOPE_WORKGROUP); }
        }
        __syncthreads();
        if (tid < 64) BASE[tid] = (int)__hip_atomic_fetch_add(F.ctl + CW_CNT + tid, (unsigned)HIST[tid], RLX_AGENT);
        __syncthreads();
        if (lane < 8) { const int tok = tok0 + 8 * w + lane;
#pragma unroll
            for (int k = 0; k < 8; ++k) { const size_t o = (size_t)ee[k] * 16384 + BASE[ee[k]] + lp[k]; LTOK[o] = tok; LDSTp[o] = tok * 9 + k; LWp[o] = ww[k]; } }
    }
}

struct MoeSched {
    const char* A; const char* Bt; const int* ltok; LAS const int* tab;
    int K, ncol, nexp, G, c, gather, rep;
    __device__ __forceinline__ bool next(int i, pg8::Unit& u) const {
        int L = i * G + c; const int tot = tab[160 + 65] * ncol; if (L >= tot * rep) return false; L %= tot;
        int e = 0; while (tab[160 + e + 1] * ncol <= L) ++e;
        const int rem = L - tab[160 + e] * ncol, nb = tab[80 + e];
        u.pn = rem / nb; u.pm = rem % nb; u.e = e | (tab[160 + e] << 8); u.cnt = tab[e]; return true;
    }
    __device__ __forceinline__ const char* a_base() const { return A; }
    __device__ __forceinline__ unsigned a_off(const pg8::Unit& u, int h, int R) const {
        const int e = u.e & 255, pos = u.pm * 256 + h * 128 + R;
        if (gather) { const int tok = (e == 64) ? pos : (pos < u.cnt ? ltok[(size_t)e * 16384 + pos] : T); return (unsigned)tok * (unsigned)(K * 2); }
        return (unsigned)((u.e >> 8) * 256 + pos) * (unsigned)(K * 2);
    }
    __device__ __forceinline__ const char* b_tile(const pg8::Unit& u) const { return Bt + ((size_t)(u.e & 255) * nexp + (size_t)u.pn * 256) * K * 2; }
};
__device__ __forceinline__ void moe_tables(Frame& F) {
    LAS int* tab = (LAS int*)(F.lds + SCHED_OFF);
    __syncthreads();
    if (F.tid == 0) { int cum = 0;
        for (int e = 0; e < 65; ++e) { const int c = (e < 64) ? (int)__hip_atomic_load(F.ctl + CW_CNT + e, RLX_AGENT) : T; const int nb = (c + 255) >> 8; tab[e] = c; tab[80 + e] = nb; tab[160 + e] = cum; cum += nb; }
        tab[160 + 65] = cum; }
    __syncthreads();
}
struct EpiMoe1 {
    static constexpr bool PERM = true;
    bf16_t* act;
    __device__ __forceinline__ void operator()(const f32x4 (&acc)[2][2][4][2], const pg8::Unit& u, int wr, int wc, int fr, int fq) const {
        const int row0 = (u.e >> 8) * 256 + u.pm * 256 + wr * 64 + fr, col0 = 128 * u.pn + 16 * wc + 4 * fq;
#pragma unroll
        for (int ai = 0; ai < 2; ++ai)
#pragma unroll
            for (int m = 0; m < 4; ++m) { bf16_t* rp = act + (size_t)(row0 + ai * 128 + m * 16) * 512 + col0;
#pragma unroll
                for (int bj = 0; bj < 2; ++bj) { const f32x4 gt = acc[ai][bj][m][0], up = acc[ai][bj][m][1]; float a[4];
#pragma unroll
                    for (int i = 0; i < 4; ++i) a[i] = gt[i] * sigmoidf_(gt[i]) * up[i];
                    *(u32x2*)(rp + 64 * bj) = (u32x2){pk2(a[0], a[1]), pk2(a[2], a[3])}; } }
    }
};
struct EpiMoe2 {
    static constexpr bool PERM = true;
    bf16_t* y; const int* ldst; const float* lw;
    __device__ __forceinline__ void operator()(const f32x4 (&acc)[2][2][4][2], const pg8::Unit& u, int wr, int wc, int fr, int fq) const {
        const int e = u.e & 255, p0 = u.pm * 256 + wr * 64 + fr, col0 = 256 * u.pn + 32 * wc + 8 * fq;
#pragma unroll
        for (int ai = 0; ai < 2; ++ai)
#pragma unroll
            for (int m = 0; m < 4; ++m) { const int pos = p0 + ai * 128 + m * 16; int dst; float wg;
                if (e == 64) { dst = pos * 9 + 8; wg = 1.f; } else if (pos < u.cnt) { dst = ldst[(size_t)e * 16384 + pos]; wg = lw[(size_t)e * 16384 + pos]; } else { dst = -1; wg = 0.f; }
                if (dst >= 0) { bf16_t* rp = y + (size_t)dst * 2048 + col0;
#pragma unroll
                    for (int bj = 0; bj < 2; ++bj) { const f32x4 v0 = acc[ai][bj][m][0] * wg, v1 = acc[ai][bj][m][1] * wg;
                        *(u32x4*)(rp + 128 * bj) = (u32x4){pk2(v0[0], v0[1]), pk2(v0[2], v0[3]), pk2(v1[0], v1[1]), pk2(v1[2], v1[3])}; } } }
    }
};
__device__ __forceinline__ void p11_final(Frame& F) {
    const int gw = F.bx * NWAVES + F.wave, NGW = F.G * NWAVES, lane = F.lane;
    const float* X1 = WSP(float, WS_X1); const bf16_t* Y = WSP(bf16_t, WS_Y); const float* mod = WSP(float, WS_MOD); const float* fg = F.in[I_FNG];
    LAS float* vb = (LAS float*)(F.lds + F.wave * 8192);
#pragma nounroll
    for (int m = gw; m < T; m += NGW) { const int b = m >> 11; float ss = 0.f;
#pragma nounroll
        for (int j = 0; j < 4; ++j) { const int c = 8 * lane + 512 * j; float a[8];
#pragma unroll
            for (int i = 0; i < 8; ++i) a[i] = 0.f;
#pragma unroll
            for (int k = 0; k < 9; ++k) { const u32x4 t = *(const u32x4*)(Y + ((size_t)m * 9 + k) * 2048 + c);
                a[0] += bflo(t.x); a[1] += bfhi(t.x); a[2] += bflo(t.y); a[3] += bfhi(t.y); a[4] += bflo(t.z); a[5] += bfhi(t.z); a[6] += bflo(t.w); a[7] += bfhi(t.w); }
            const f32x4 x0 = *(const f32x4*)(X1 + (size_t)m * 2048 + c), x1 = *(const f32x4*)(X1 + (size_t)m * 2048 + c + 4);
            const f32x4 g0 = *(const f32x4*)(mod + b * 12288 + 10240 + c), g1 = *(const f32x4*)(mod + b * 12288 + 10240 + c + 4);
            const f32x4 v0 = {x0[0] + g0[0] * a[0], x0[1] + g0[1] * a[1], x0[2] + g0[2] * a[2], x0[3] + g0[3] * a[3]};
            const f32x4 v1 = {x1[0] + g1[0] * a[4], x1[1] + g1[1] * a[5], x1[2] + g1[2] * a[6], x1[3] + g1[3] * a[7]};
            ss += (v0[0] * v0[0] + v0[1] * v0[1]) + (v0[2] * v0[2] + v0[3] * v0[3]) + (v1[0] * v1[0] + v1[1] * v1[1]) + (v1[2] * v1[2] + v1[3] * v1[3]);
            *(LAS f32x4*)(vb + c) = v0; *(LAS f32x4*)(vb + c + 4) = v1; }
        const float rstd = 1.f / sqrtf(wave_sum(ss) * (1.f / 2048.f) + EPS);
#pragma nounroll
        for (int j = 0; j < 4; ++j) { const int c = 8 * lane + 512 * j;
            const f32x4 v0 = *(const LAS f32x4*)(vb + c), v1 = *(const LAS f32x4*)(vb + c + 4);
            const f32x4 f0 = *(const f32x4*)(fg + c), f1 = *(const f32x4*)(fg + c + 4);
            *(f32x4*)(F.out + (size_t)m * 2048 + c) = v0 * rstd * f0; *(f32x4*)(F.out + (size_t)m * 2048 + c + 4) = v1 * rstd * f1; }
    }
}

#ifndef DIAG
#define DIAG 0
#define DIAG_BH 0
#define DIAG_VSC 1.0f
#define DIAG_EMIT 0
#define DIAG_S 0
#define DIAG_VR 0
#define DIAG_CMP 2
#define DIAG_SEL (s_ == 0)
#endif
constexpr int CW_DIAG = 9000;
__device__ __forceinline__ void diag_compute(Frame& F) {
#if DIAG == 1
    const unsigned* MASK = WSP(unsigned, WS_MASK);
    for (int row = F.bx * NWAVES + F.wave; row < T; row += F.G * NWAVES) { const int q = row & 2047;
        const unsigned mw = MASK[(size_t)row * 64 + F.lane]; int c = __popc(mw);
        for (int o = 1; o < 64; o <<= 1) c += __shfl_xor(c, o);
        unsigned bad = 0; { const int k0 = F.lane * 32; for (int bb = 0; bb < 32; ++bb) if (((mw >> bb) & 1u) && (k0 + bb > q)) bad = 1; }
        bad = __any(bad) ? 1u : 0u;
        if (F.lane == 0) { atomicMax(F.ctl + CW_DIAG, (unsigned)c); if (c != (q + 1 < 256 ? q + 1 : 256)) atomicAdd(F.ctl + CW_DIAG + 1, 1u); if (bad) atomicAdd(F.ctl + CW_DIAG + 2, 1u); } }
#endif
#if DIAG == 3
    const bf16_t* A = WSP(bf16_t, WS_AO); const bf16_t* Bq = WSP(bf16_t, WS_H1);
    for (size_t i = (size_t)F.bx * NTHR + F.tid; i < (size_t)T * 1024; i += (size_t)F.G * NTHR) {
        const int d = (int)(i & 127), s_ = (int)((i >> 7) & 2047), bh = (int)(i >> 18); (void)d; (void)s_; (void)bh;
        if (!(DIAG_SEL)) continue;
        const bf16_t* Vv = WSP(bf16_t, WS_V); const float vref = DIAG_VSC * bf1(Vv[((size_t)bh * 2048 + DIAG_VR) * 128 + d]);
        const float df = (DIAG_CMP == 0) ? fabsf(bf1(A[i]) - bf1(Bq[i])) : (DIAG_CMP == 1) ? fabsf(bf1(A[i]) - vref) : fabsf(bf1(Bq[i]) - vref);
        const float bv = bf1(Bq[i]);
        atomicMax(F.ctl + CW_DIAG, (unsigned)(df * 4096.f)); if (DIAG_CMP == 3 ? (bv != bv) : DIAG_CMP == 4 ? (bv == 0.f) : (df > 0.05f)) atomicAdd(F.ctl + CW_DIAG + 1, 1u); }
#endif
#if DIAG == 4
    if (F.bx == 0 && F.wave == 0) { const bf16_t* Bq = WSP(bf16_t, WS_H1); const bf16_t* Vv = WSP(bf16_t, WS_V);
        float bv = 0.f, vv = 0.f, bb = 0.f;
        for (int d = F.lane; d < 128; d += 64) { const float x = bf1(Bq[((size_t)DIAG_BH * 2048 + DIAG_S) * 128 + d]), y = bf1(Vv[((size_t)DIAG_BH * 2048 + DIAG_VR) * 128 + d]); bv += x * y; vv += y * y; bb += x * x; }
        bv = wave_sum(bv); vv = wave_sum(vv); bb = wave_sum(bb);
        if (F.lane == 0) { F.ctl[CW_DIAG] = (unsigned)(int)(1000.f * bv / vv + 100000.f); F.ctl[CW_DIAG + 1] = (unsigned)(int)(1000.f * bb / vv); } }
#endif
#if DIAG == 2
    const unsigned* p = (const unsigned*)(F.ws + (size_t)DIAG_OFF); const size_t n = (size_t)DIAG_LEN / 4; unsigned acc = 0;
    for (size_t i = (size_t)F.bx * NTHR + F.tid; i < n; i += (size_t)F.G * NTHR) acc += p[i] * 2654435761u + (unsigned)i;
    for (int o = 1; o < 64; o <<= 1) acc += __shfl_xor(acc, o);
    if (F.lane == 0) atomicAdd(F.ctl + CW_DIAG, acc);
#endif
}
__device__ __forceinline__ void diag_emit(Frame& F) {
    if (F.bx == 0 && F.tid == 0) { const unsigned a = F.ctl[CW_DIAG], b = F.ctl[CW_DIAG + 1], c = F.ctl[CW_DIAG + 2];
        F.out[0] = (DIAG == 4) ? (float)((int)a - 100000) * (DIAG_EMIT == 0 ? 1.f : 0.f) + (float)b * (DIAG_EMIT == 1 ? 1.f : 0.f) : (DIAG_EMIT == 0 ? (float)b : (float)a * (100.f / 4096.f)) + 0.f * (float)(a + c); (void)a; (void)b; (void)c; }
}
constexpr int N_PHASES = DIAG ? 14 : 12;
__global__ void __launch_bounds__(NTHR, 2) mk_fwd(Args args) {
    extern __shared__ __attribute__((aligned(16))) unsigned char lds[];
    Frame F;
    F.lds = (LAS unsigned char*)lds; F.MISC = (volatile LAS unsigned*)(F.lds + MISC_OFF);
    F.tid = threadIdx.x; F.lane = F.tid & 63; F.wave = __builtin_amdgcn_readfirstlane(F.tid >> 6);
    F.G = gridDim.x; F.bx = blockIdx.x; F.ws = args.ws; F.ctl = (unsigned*)(args.ws + WS_CTL); F.in = args.in; F.out = args.out;
    for (int u = F.tid; u < (LDS_BYTES - CTLZ_OFF) / 4; u += NTHR) ((LAS unsigned*)(F.lds + CTLZ_OFF))[u] = 0u;
    __syncthreads();
    const int lo = args.ph_lo, hi = args.ph_hi;
    XcdBarrier bar; bar.bar = F.ctl + CW_BAR; bar.x = 0; bar.st = nullptr;
    if (hi - lo > 1) bar = xcd_barrier_post(F.ctl + CW_BAR, F.MISC + 8);
#ifndef PH_MASK
#define PH_MASK 0xFFFFF
#endif
#define IN(k) (((PH_MASK >> (k)) & 1) && lo <= (k) && (k) < hi)
#define SEAM(k) do { if (IN(k) && IN((k) + 1)) xcd_barrier(bar); } while (0)
#ifndef REP_PHASE
#define REP_PHASE -1
#endif
#define REPEAT(k) (REP_PHASE == (k) && hi - lo > 1)
    if (IN(0)) { p0_prologue(F); if (REPEAT(0)) { xcd_barrier(bar); p0_prologue(F); } } SEAM(0);
    if (IN(1)) { p0b_mod(F); } SEAM(1);
    if (IN(2)) { p1_h1(F); if (REPEAT(2)) { xcd_barrier(bar); p1_h1(F); } } SEAM(2);
    if (IN(3)) { pg8::DenseSched S; S.init(WSP(bf16_t, WS_H1), WSP(bf16_t, WS_WIN), T, NPROJ, 2048, F.G, F.bx); S.rep = (REP_PHASE == 3) ? 2 : 1;
        EpiProj E{F.ws, F.in[I_LBL]}; pg8::gemm_phase<EpiProj, pg8::DenseSched, true, true>(F.lds, 2048, S, E); } SEAM(3);
    if (IN(4)) { if ((PH_MASK >> 12) & 1) { pg8::DenseSched S; S.init(WSP(bf16_t, WS_CKV), WSP(bf16_t, WS_WKV), T, 2048, 256, F.G, F.bx);
          EpiKV E{F.ws}; pg8::gemm_phase<EpiKV, pg8::DenseSched, true, true>(F.lds, 256, S, E); }
        __syncthreads();
        if (((PH_MASK >> 13) & 1) && F.bx < 64) { p3_hgrn(F, F.bx); }
        if ((PH_MASK >> 14) & 1) p3_indexer(F, 0); } SEAM(4);
    if (IN(5)) { if (DIAG >= 3) { p4_attn_naive(F); __syncthreads(); p4_attn_dense(F, WSP(bf16_t, WS_H1)); } else p4_attn_dense(F, WSP(bf16_t, WS_AO)); } SEAM(5);
    if (IN(6)) { p5_finalize(F); if (REPEAT(6)) { xcd_barrier(bar); p5_finalize(F); } } SEAM(6);
    if (IN(7)) { pg8::DenseSched S; S.init(WSP(bf16_t, WS_A2), WSP(bf16_t, WS_WOUT), T, 2048, 2048, F.G, F.bx); S.rep = (REP_PHASE == 7) ? 2 : 1;
        EpiOut E{F.in[I_X], WSP(float, WS_X1), WSP(float, WS_MOD)}; pg8::gemm_phase<EpiOut, pg8::DenseSched, true, true>(F.lds, 2048, S, E); } SEAM(7);
    if (IN(8)) { p7_router(F); } SEAM(8);
    if (IN(9)) { moe_tables(F);
        MoeSched S; S.A = (const char*)WSP(bf16_t, WS_H2); S.Bt = (const char*)WSP(bf16_t, WS_W1); S.ltok = WSP(int, WS_LTOK); S.tab = (LAS const int*)(F.lds + SCHED_OFF); S.K = 2048; S.ncol = 4; S.nexp = 1024; S.G = F.G; S.c = F.bx; S.gather = 1; S.rep = (REP_PHASE == 9) ? 2 : 1;
        EpiMoe1 E{WSP(bf16_t, WS_ACT)}; pg8::gemm_phase<EpiMoe1, MoeSched, true, true>(F.lds, 2048, S, E); } SEAM(9);
    if (IN(10)) { moe_tables(F);
        MoeSched S; S.A = (const char*)WSP(bf16_t, WS_ACT); S.Bt = (const char*)WSP(bf16_t, WS_W2); S.ltok = nullptr; S.tab = (LAS const int*)(F.lds + SCHED_OFF); S.K = 512; S.ncol = 8; S.nexp = 2048; S.G = F.G; S.c = F.bx; S.gather = 0; S.rep = (REP_PHASE == 10) ? 2 : 1;
        EpiMoe2 E{WSP(bf16_t, WS_Y), WSP(int, WS_LDST), WSP(float, WS_LW)}; pg8::gemm_phase<EpiMoe2, MoeSched, true, true>(F.lds, 512, S, E); } SEAM(10);
    if (IN(11)) { p11_final(F); if (REPEAT(11)) { xcd_barrier(bar); p11_final(F); } }
    if (DIAG && lo <= 12 && 12 < hi) diag_compute(F);
    if (DIAG && lo <= 13 && 13 < hi) diag_emit(F);
#undef IN
#undef SEAM
}

extern "C" void kernel_launch(void* const* d_in, const int* in_sizes, int n_in, void* d_out, int out_size, void* d_ws, size_t ws_size, hipStream_t stream) {
    static int grid = 0;
    if (grid == 0) {
        if (n_in != 25 || in_sizes[0] != T * D || out_size != T * D || ws_size < WS_END) { fprintf(stderr, "kernel_launch: unexpected shapes (n_in %d, in0 %d, out %d, ws %zu < %zu)\n", n_in, n_in > 0 ? in_sizes[0] : -1, out_size, ws_size, (size_t)WS_END); grid = -1; return; }
        int dev = 0, cus = 0, per_cu = 0;
        if (hipGetDevice(&dev) != hipSuccess || hipDeviceGetAttribute(&cus, hipDeviceAttributeMultiprocessorCount, dev) != hipSuccess) { grid = -1; return; }
        if (hipFuncSetAttribute((const void*)mk_fwd, hipFuncAttributeMaxDynamicSharedMemorySize, LDS_BYTES) != hipSuccess) { fprintf(stderr, "kernel_launch: hipFuncSetAttribute failed\n"); grid = -1; return; }
        if (hipOccupancyMaxActiveBlocksPerMultiprocessor(&per_cu, (const void*)mk_fwd, NTHR, LDS_BYTES) != hipSuccess || per_cu < 1) { fprintf(stderr, "kernel_launch: occupancy query says %d\n", per_cu); }
        (void)hipGetLastError();
        grid = cus;
    }
    if (grid < 0) return;
    (void)hipMemsetAsync((char*)d_ws + WS_CTL, 0, CTL_ZERO_BYTES, stream);
    Args a{};
    for (int i = 0; i < 25; ++i) a.in[i] = (const float*)d_in[i];
    a.out = (float*)d_out; a.ws = (unsigned char*)d_ws;
    constexpr int NL = DIAG ? 14 : MK_N_LAUNCHES;
    for (int li = 0; li < NL; ++li) {
        a.ph_lo = li * N_PHASES / NL; a.ph_hi = (li + 1) * N_PHASES / NL;
        hipLaunchKernelGGL(mk_fwd, dim3(grid), dim3(NTHR), LDS_BYTES, stream, a);
    }
}
```

```cpp
#include <hip/hip_runtime.h>
#include <cstdio>
#include <cstdint>

#define NOBIAS 0
#define QREG 0
#define NOSEL 0
#ifndef MK_N_LAUNCHES
#define MK_N_LAUNCHES 1
#endif

#ifndef DIAG
#define DIAG 0
#endif
#define DSTAMP(F, i) do { if (DIAG == 6 && (F).bx == 0 && (F).tid == 0) (F).ctl[9100 + (i)] = (unsigned)__builtin_amdgcn_s_memrealtime(); } while (0)
#define GAS __attribute__((address_space(1)))
#define LAS __attribute__((address_space(3)))
typedef unsigned short bf16_t;
typedef short bf16x8 __attribute__((ext_vector_type(8)));
typedef short s16x4 __attribute__((ext_vector_type(4)));
typedef float f32x4 __attribute__((ext_vector_type(4)));
typedef float f32x2 __attribute__((ext_vector_type(2)));
typedef float f32x16 __attribute__((ext_vector_type(16)));
typedef unsigned u32x4 __attribute__((ext_vector_type(4)));
typedef unsigned u32x2 __attribute__((ext_vector_type(2)));

constexpr int NB = 8, SEQ = 2048, T = NB * SEQ, D = 2048;
constexpr int NH = 8, HD = 128, CKV = 256, IH = 16, IDIM = 64, TOPK = 256;
constexpr int NPROJ = 6656;
constexpr int NE = 64, DE = 512, KSEL = 8, NSLOT = 9;
constexpr float EPS = 1e-6f;
constexpr float ATT_SCALE = 0.08838834764831845f;
constexpr float W1_SCALE = 64.f, W2_SCALE = 32.f, ACT_SCALE = 4.f, Y_SCALE = 8.f, WO_SCALE = 64.f, A2_SCALE = 4.f, WIN_SCALE = 64.f, H1_SCALE = 4.f;

constexpr size_t MiB = 1u << 20;
constexpr size_t WS_CTL = 0, CTL_ZERO_BYTES = 1 * MiB;
constexpr size_t WS_MOD = 1 * MiB;
constexpr size_t WS_CKVSS = 2 * MiB;
constexpr size_t WS_WR = 3 * MiB;
constexpr size_t WS_LTOK = 4 * MiB, WS_LDST = 8 * MiB, WS_LW = 12 * MiB;
constexpr size_t WS_MODP = 324 * MiB;
constexpr size_t WS_IKSS = 16 * MiB;
constexpr size_t WS_IKGC = 17 * MiB;
constexpr size_t WS_W2 = 32 * MiB;
constexpr size_t WS_X1 = 162 * MiB;
constexpr size_t WS_WIN = 162 * MiB;
constexpr size_t WS_WKV = 188 * MiB;
constexpr size_t WS_H1 = 190 * MiB;
constexpr size_t WS_H1F8 = 254 * MiB;
constexpr size_t WS_WIN8 = 290 * MiB;
constexpr size_t WS_ACT = 290 * MiB;
constexpr size_t WS_K = 290 * MiB, WS_V = 322 * MiB;
constexpr size_t WS_AO = 354 * MiB;
constexpr size_t WS_HO = 386 * MiB;
constexpr size_t WS_A2 = 290 * MiB;
constexpr size_t WS_Y = 450 * MiB;
constexpr size_t WS_W1 = 450 * MiB;
constexpr size_t WS_QA = 710 * MiB;
constexpr size_t WS_CKV = 742 * MiB;
constexpr size_t WS_IQ = 750 * MiB;
constexpr size_t WS_QB = 782 * MiB;
constexpr size_t WS_LOGF = 814 * MiB;
constexpr size_t WS_KB = 878 * MiB;
constexpr size_t WS_IB = 910 * MiB;
constexpr size_t WS_GB = 942 * MiB;
constexpr size_t WS_IK = 974 * MiB;
constexpr size_t WS_IW = 976 * MiB;
constexpr size_t WS_MASK = 977 * MiB;
constexpr size_t WS_WOUT = 981 * MiB;
constexpr size_t WS_H2 = 710 * MiB;
constexpr size_t WS_END = 1026 * MiB;
constexpr int CW_TMO = 0, CW_BAR = 4096, CW_CNT = 8192  , CW_IDXQ = 8448  ;

constexpr int RING_BYTES = 131072, LDS_BYTES = 163840, CTLZ_OFF = LDS_BYTES - 4096, MISC_OFF = CTLZ_OFF + 320;
constexpr int SCHED_OFF = CTLZ_OFF + 1024;

#define RLX_AGENT __ATOMIC_RELAXED, __HIP_MEMORY_SCOPE_AGENT
#define LDS_WAIT() asm volatile("s_waitcnt lgkmcnt(0)" ::: "memory")
#define VM_WAIT() asm volatile("s_waitcnt vmcnt(0)" ::: "memory")

__device__ __forceinline__ unsigned f2bf(float f) { unsigned u = __builtin_bit_cast(unsigned, f); return (u + 0x7fffu + ((u >> 16) & 1u)) >> 16; }
typedef __bf16 bf16x2_t __attribute__((ext_vector_type(2)));
__device__ __forceinline__ unsigned pk2(float lo, float hi) { const f32x2 v = {lo, hi}; const bf16x2_t b = __builtin_convertvector(v, bf16x2_t); return __builtin_bit_cast(unsigned, b); }
__device__ __forceinline__ unsigned pk4_f8(float a, float b, float c, float d) {
    a = __builtin_amdgcn_fmed3f(a, -448.f, 448.f); b = __builtin_amdgcn_fmed3f(b, -448.f, 448.f); c = __builtin_amdgcn_fmed3f(c, -448.f, 448.f); d = __builtin_amdgcn_fmed3f(d, -448.f, 448.f);
    int w = 0; w = __builtin_amdgcn_cvt_pk_fp8_f32(a, b, w, false); w = __builtin_amdgcn_cvt_pk_fp8_f32(c, d, w, true); return (unsigned)w; }
__device__ __forceinline__ float bflo(unsigned w) { return __builtin_bit_cast(float, w << 16); }
__device__ __forceinline__ float bfhi(unsigned w) { return __builtin_bit_cast(float, w & 0xffff0000u); }
__device__ __forceinline__ float bf1(bf16_t h) { return __builtin_bit_cast(float, ((unsigned)h) << 16); }
__device__ __forceinline__ float sigmoidf_(float x) { return 1.f / (1.f + __expf(-x)); }
template <int LN> __device__ __forceinline__ void wlane(int& vd, int sval) { asm volatile("s_nop 4\n\tv_writelane_b32 %0, %1, %2" : "+v"(vd) : "s"(sval), "n"(LN));   }
template <int XM> __device__ __forceinline__ float swz_xor(float v) { return __builtin_bit_cast(float, __builtin_amdgcn_ds_swizzle(__builtin_bit_cast(int, v), (XM << 10) | 0x1f)); }
__device__ __forceinline__ float wave_sum(float v) {
    v += swz_xor<1>(v); v += swz_xor<2>(v); v += swz_xor<4>(v); v += swz_xor<8>(v); v += swz_xor<16>(v);
    return __builtin_bit_cast(float, __builtin_amdgcn_readlane(__builtin_bit_cast(int, v), 0)) + __builtin_bit_cast(float, __builtin_amdgcn_readlane(__builtin_bit_cast(int, v), 32));
}
__device__ __forceinline__ int opaque(int x) { asm volatile("" : "+v"(x)); return x; }

#define XB_TMO      128
#define XB_XCNT(j)  (256  + 64 * (j))
#define XB_XSUB(j)  (1280 + 64 * (j))
#define XB_XGEN(j)  (2304 + 64 * (j))
#define XB_TOP      3328
#define XB_TOPGEN   3392
#define XCD_BAR_WORDS 3456
#define XB_SPIN_CAP (1u << 20)
__device__ __forceinline__ unsigned xb_ld(unsigned* p)              { return __hip_atomic_load(p, __ATOMIC_RELAXED, __HIP_MEMORY_SCOPE_AGENT); }
__device__ __forceinline__ unsigned xb_add(unsigned* p, unsigned v) { return __hip_atomic_fetch_add(p, v, __ATOMIC_RELAXED, __HIP_MEMORY_SCOPE_AGENT); }
__device__ __forceinline__ unsigned xb_xcc_id() { return (unsigned)__builtin_amdgcn_s_getreg((3 << 11) | 20) & 0xFu; }
#define XB_SPIN(cond, bar) do { unsigned _sp = 0; while (cond) { __builtin_amdgcn_s_sleep(1); \
    if ((++_sp & 255u) == 0u) { if (xb_ld(&(bar)[XB_TMO])) break; if (_sp > XB_SPIN_CAP) { atomicAdd(&(bar)[XB_TMO], 1u); break; } } } } while (0)
struct XcdBarrier { unsigned* bar; unsigned x; volatile LAS unsigned* st; };
__device__ __forceinline__ XcdBarrier xcd_barrier_post(unsigned* bar, volatile LAS unsigned* st) {
    XcdBarrier b; b.bar = bar; b.x = xb_xcc_id(); b.st = st;
    if (threadIdx.x == 0) (void)xb_add(&bar[XB_XCNT(b.x)], 1u);
    return b;
}
__device__ __forceinline__ void xcd_barrier_complete(unsigned* bar, unsigned x, unsigned& nloc, unsigned& nx) {
    const unsigned G = gridDim.x * gridDim.y * gridDim.z;
    unsigned sum, cnt, mine, sp = 0u;
    for (;;) {
        sum = 0u; cnt = 0u; mine = 0u;
#pragma unroll
        for (unsigned j = 0; j < 16; ++j) { const unsigned c = xb_ld(&bar[XB_XCNT(j)]); sum += c; cnt += (c > 0u) ? 1u : 0u; mine = (j == x) ? c : mine; }
        if (sum == G) break;
        __builtin_amdgcn_s_sleep(1);
        if ((++sp & 255u) == 0u) { if (xb_ld(&bar[XB_TMO])) break; if (sp > XB_SPIN_CAP) { atomicAdd(&bar[XB_TMO], 1u); break; } }
    }
    nloc = mine > 0u ? mine : 1u; nx = cnt > 0u ? cnt : 1u;
}
__device__ __forceinline__ void xcd_barrier(const XcdBarrier& b) {
    asm volatile("s_waitcnt vmcnt(0)" ::: "memory");
    __syncthreads();
    if (threadIdx.x == 0) {
        unsigned* bar = b.bar;
        __builtin_amdgcn_s_waitcnt(0);
        unsigned nloc = b.st[0], nx = b.st[1];
        if (nloc == 0u) { xcd_barrier_complete(bar, b.x, nloc, nx); b.st[0] = nloc; b.st[1] = nx; }
        const unsigned old = xb_add(&bar[XB_XSUB(b.x)], 1u);
        const unsigned gen = old / nloc;
        if (old + 1u == (gen + 1u) * nloc) {
            __builtin_amdgcn_fence(__ATOMIC_RELEASE, "agent");
            asm volatile("s_waitcnt vmcnt(0)" ::: "memory");
            const unsigned og = xb_add(&bar[XB_TOP], 1u);
            const unsigned tg = og / nx;
            if (og + 1u == (tg + 1u) * nx) xb_add(&bar[XB_TOPGEN], 1u);
            else XB_SPIN(xb_ld(&bar[XB_TOPGEN]) == tg, bar);
            __builtin_amdgcn_fence(__ATOMIC_ACQUIRE, "agent");
            xb_add(&bar[XB_XGEN(b.x)], 1u);
            asm volatile("s_waitcnt vmcnt(0)" ::: "memory");
        } else {
            XB_SPIN(xb_ld(&bar[XB_XGEN(b.x)]) == gen, bar);
            __builtin_amdgcn_fence(__ATOMIC_ACQUIRE, "agent");
            asm volatile("s_waitcnt vmcnt(0)" ::: "memory");
        }
    }
    __syncthreads();
}

namespace pg8 {
constexpr int BM = 256, BK = 64, HALF = 128, HTB = HALF * BK * 2, STAGE_BYTES = 8 * HTB, NXCD = 8, WGM = 8;
__host__ __device__ __forceinline__ int lds_byte(int r, int c) { const int st = (r >> 4) * 2 + (c >> 5), rr = r & 15, cc = c & 31, ob = rr * 64 + cc * 2; return st * 1024 + (ob ^ (((ob >> 9) & 1) << 5)); }
__host__ __device__ __forceinline__ void stage_rc(int b, int& R, int& C) { const int st = b / 1024, sb = b % 1024, swz = sb ^ (((sb >> 9) & 1) << 5); R = (st >> 1) * 16 + swz / 64; C = (st & 1) * 32 + (swz % 64) / 2; }
__host__ __device__ __forceinline__ int perm32(int rho) { const int n = rho >> 4, i = rho & 15; return 8 * (i >> 2) + 4 * n + (i & 3); }

struct Unit { int pm, pn, e, cnt, par; };

struct DenseSched {
    const char* A; const char* Bt; int nM, nN, nwg, G, c, K, rep;
    __device__ __forceinline__ void init(const void* A_, const void* Bt_, int M, int N, int K_, int G_, int c_) { rep = 1; A = (const char*)A_; Bt = (const char*)Bt_; nM = M / BM; nN = N / BM; nwg = nM * nN; G = G_; c = c_; K = K_; }
    __device__ __forceinline__ bool next(int i, Unit& u) const {
        long L = (long)i * G + c; if (L >= (long)nwg * rep) return false; L %= nwg;
        int wgid = (int)L; { const int q = nwg / NXCD, r = nwg % NXCD, xcd = wgid % NXCD, off = wgid / NXCD; wgid = (xcd < r ? xcd * (q + 1) : r * (q + 1) + (xcd - r) * q) + off; }
        const int nig = WGM * nN, gid = wgid / nig, fm = gid * WGM, gsz = (nM - fm) < WGM ? (nM - fm) : WGM;
        u.pm = fm + ((wgid % nig) % gsz); u.pn = (wgid % nig) / gsz; u.e = 0; u.cnt = 0; return true;
    }
    __device__ __forceinline__ const char* a_base() const { return A; }
    __device__ __forceinline__ unsigned a_off(const Unit& u, int h, int R) const { return (unsigned)(u.pm * BM + h * HALF + R) * (unsigned)K; }
    __device__ __forceinline__ const char* b_tile(const Unit& u) const { return Bt + (size_t)u.pn * BM * K; }
};

struct ProjSched {
    const char* A; const char* Bt; int K, mode, G, c;
    __device__ __forceinline__ bool next(int i, Unit& u) const {
        int L;
        if (mode == 0) { L = i * G + c; if (L >= 640) return false; u.pm = L / 10; const int pt = L % 10; u.pn = (pt < 5) ? 4 + pt : (pt == 9 ? 25 : 8 + pt); }
        else { if (G == 256) { if (c < 128) { if (i >= 3) return false; L = 3 * c + i; } else { if (i >= 5) return false; L = 384 + 5 * (c - 128) + i; } } else { L = i * G + c; if (L >= 1024) return false; }
            u.pm = L / 16; const int pt = L % 16; u.pn = (pt < 4) ? pt : (pt < 8 ? pt + 5 : pt + 9); }
        u.e = 0; u.cnt = 0; return true;
    }
    __device__ __forceinline__ const char* a_base() const { return A; }
    __device__ __forceinline__ unsigned a_off(const Unit& u, int h, int R) const { return (unsigned)(u.pm * BM + h * HALF + R) * (unsigned)K; }
    __device__ __forceinline__ const char* b_tile(const Unit& u) const { return Bt + (size_t)u.pn * BM * K; }
};
typedef int i32x8 __attribute__((ext_vector_type(8)));
template <class Epi, class Sched, bool ALIGN_EPI, bool SP2, bool F8 = false>
__device__ __forceinline__ void gemm_phase(LAS unsigned char* lds, const int KB, const Sched& S, const Epi& E) {
    const int tid = threadIdx.x, wid = __builtin_amdgcn_readfirstlane(tid >> 6), lane = tid & 63, wr = wid >> 2, wc = wid & 3, fr = lane & 15, fq = lane >> 4;
    const int nt = KB / (BK * 2);
    int Rr[2], Cc[2]; unsigned voffB[2];
#pragma unroll
    for (int i = 0; i < 2; ++i) { int R, C; stage_rc(tid * 16 + i * 8192, R, C); const int Rb = Epi::PERM ? ((R & ~31) + perm32(R & 31)) : R;
        Rr[i] = R; Cc[i] = C * 2; voffB[i] = (unsigned)(Rb * KB + C * 2); }
    const size_t kstep = (size_t)(BK * 2);
    const size_t hstep = (size_t)HALF * KB;
    const unsigned ldsw = (unsigned)wid * 1024u;
    const int aoff = lds_byte(wr * 64 + fr, fq * 8), boff = lds_byte(wc * 32 + fr, fq * 8);
    constexpr int aof1 = 1024, bof1 = aof1;
    const int f8one = 0x7F7F7F7F;
#define PG8_SA(b, h) (((b) * 2 + (h)) * HTB)
#define PG8_SB(b, h) ((4 + (b) * 2 + (h)) * HTB)
#define PG8_STAGE2(bufoff, gbase, v0, v1) do { \
        __builtin_amdgcn_global_load_lds((const unsigned*)((const char*)(gbase) + (v0)), (LAS unsigned*)(lds + (bufoff) + ldsw), 16, 0, 0); \
        __builtin_amdgcn_global_load_lds((const unsigned*)((const char*)(gbase) + (v1)), (LAS unsigned*)(lds + (bufoff) + ldsw + 8192), 16, 0, 0); } while (0)
#define PG8_STAGEB(bufoff, gbase) PG8_STAGE2(bufoff, gbase, voffB[0], voffB[1])
#define PG8_LDA(dst, b, h) do { _Pragma("unroll") for (int m = 0; m < 4; ++m) _Pragma("unroll") for (int k = 0; k < 2; ++k) dst[m][k] = *(const LAS bf16x8*)(lds + PG8_SA(b, h) + aoff + m * 2048 + k * aof1); } while (0)
#define PG8_LDB(dst, b, h) do { _Pragma("unroll") for (int n = 0; n < 2; ++n) _Pragma("unroll") for (int k = 0; k < 2; ++k) dst[n][k] = *(const LAS bf16x8*)(lds + PG8_SB(b, h) + boff + n * 2048 + k * bof1); } while (0)
#define PG8_CAT(X) __builtin_bit_cast(i32x8, __builtin_shufflevector(X[0], X[1], 0, 1, 2, 3, 4, 5, 6, 7, 8, 9, 10, 11, 12, 13, 14, 15))
#define PG8_MMA(ai, bj, At, Bt) do { __builtin_amdgcn_s_setprio(1); _Pragma("unroll") for (int m = 0; m < 4; ++m) _Pragma("unroll") for (int n = 0; n < 2; ++n) { \
        if constexpr (F8) { asm volatile("v_mfma_scale_f32_16x16x128_f8f6f4 %0, %1, %2, %0, %3, %3 op_sel_hi:[0,0,0]" : "+v"(acc[ai][bj][m][n]) : "v"(PG8_CAT(Bt[n])), "v"(PG8_CAT(At[m])), "v"(f8one)); } \
          \
        else { _Pragma("unroll") for (int k = 0; k < 2; ++k) acc[ai][bj][m][n] = __builtin_amdgcn_mfma_f32_16x16x32_bf16(Bt[n][k], At[m][k], acc[ai][bj][m][n], 0, 0, 0); } } \
        __builtin_amdgcn_s_setprio(0); } while (0)
#define PG8_WAIT_V(n) asm volatile("s_waitcnt vmcnt(" #n ")" ::: "memory")
#define PG8_WAIT_L(n) asm volatile("s_waitcnt lgkmcnt(" #n ")" ::: "memory")
#define PG8_BAR __builtin_amdgcn_s_barrier()
#define PG8_SCHED __builtin_amdgcn_sched_barrier(0)
    Unit cur, nxt; int ui = 0;
    if (!S.next(0, cur)) return;
    cur.par = 0;
    f32x4 acc[2][2][4][2];
#pragma unroll
    for (int a = 0; a < 2; ++a)
#pragma unroll
        for (int b = 0; b < 2; ++b)
#pragma unroll
            for (int m = 0; m < 4; ++m)
#pragma unroll
                for (int n = 0; n < 2; ++n) acc[a][b][m][n] = (f32x4){0.f, 0.f, 0.f, 0.f};
    bf16x8 At[4][2], B0[2][2], B1[2][2];
    const char* const A0 = S.a_base();
    const char* cB = S.b_tile(cur);
    unsigned c00 = S.a_off(cur, 0, Rr[0]) + Cc[0], c01 = S.a_off(cur, 0, Rr[1]) + Cc[1], c10 = S.a_off(cur, 1, Rr[0]) + Cc[0], c11 = S.a_off(cur, 1, Rr[1]) + Cc[1];
    if constexpr (Epi::PRE) E.pre(lds, cur, wid);
    PG8_STAGEB(PG8_SB(0, 0), cB); PG8_STAGEB(PG8_SB(0, 1), cB + hstep); PG8_STAGE2(PG8_SA(0, 0), A0, c00, c01); PG8_STAGE2(PG8_SA(0, 1), A0, c10, c11);
    if (wr == 1) PG8_BAR;
    PG8_WAIT_V(2); PG8_BAR;
    PG8_STAGEB(PG8_SB(1, 0), cB + kstep); PG8_STAGE2(PG8_SA(1, 0), A0 + kstep, c00, c01); PG8_STAGEB(PG8_SB(1, 1), cB + hstep + kstep);
    PG8_WAIT_V(6); PG8_BAR;
    for (;;) {
        const bool has_next = S.next(ui + 1, nxt);
        nxt.par = (ui + 1) & 1;
        if (!has_next) nxt = cur;
        const char* nB = has_next ? S.b_tile(nxt) : cB;
        unsigned n00 = c00, n01 = c01, n10 = c10, n11 = c11;
        if (has_next) { n00 = S.a_off(nxt, 0, Rr[0]) + Cc[0]; n01 = S.a_off(nxt, 0, Rr[1]) + Cc[1]; n10 = S.a_off(nxt, 1, Rr[0]) + Cc[0]; n11 = S.a_off(nxt, 1, Rr[1]) + Cc[1]; }
#pragma nounroll
        for (int t = 0; t < nt; t += 2) {
            const bool last = (t == nt - 2);
            const char* a1 = A0 + (size_t)(t + 1) * kstep;
            const char* a2 = last ? A0 : A0 + (size_t)(t + 2) * kstep; const char* b2 = last ? nB : cB + (size_t)(t + 2) * kstep;
            const char* a3 = a2 + kstep; const char* b3 = b2 + kstep;
            unsigned x00 = c00, x01 = c01, x10 = c10, x11 = c11;
            if (last) { x00 = n00; x01 = n01; x10 = n10; x11 = n11; }
            PG8_LDB(B0, 0, 0); PG8_LDB(B1, 0, 1); PG8_SCHED; PG8_LDA(At, 0, 0); PG8_STAGE2(PG8_SA(1, 1), a1, c10, c11);
            PG8_WAIT_V(8); PG8_WAIT_L(0); PG8_BAR; PG8_MMA(0, 0, At, B0); PG8_MMA(0, 1, At, B1); PG8_BAR; PG8_SCHED;
            PG8_LDA(At, 0, 1); PG8_STAGEB(PG8_SB(0, 0), b2); PG8_STAGEB(PG8_SB(0, 1), b2 + hstep); PG8_STAGE2(PG8_SA(0, 0), a2, x00, x01);
            PG8_WAIT_V(8); PG8_WAIT_L(0); PG8_BAR; PG8_MMA(1, 0, At, B0); PG8_MMA(1, 1, At, B1); PG8_BAR; PG8_SCHED;
            PG8_LDB(B0, 1, 0); PG8_LDB(B1, 1, 1); PG8_SCHED; PG8_LDA(At, 1, 0); PG8_STAGE2(PG8_SA(0, 1), a2, x10, x11);
            PG8_WAIT_V(8); PG8_WAIT_L(0); PG8_BAR; PG8_MMA(0, 0, At, B0); PG8_MMA(0, 1, At, B1); PG8_BAR; PG8_SCHED;
            PG8_LDA(At, 1, 1); PG8_STAGEB(PG8_SB(1, 0), b3); PG8_STAGEB(PG8_SB(1, 1), b3 + hstep); PG8_STAGE2(PG8_SA(1, 0), a3, x00, x01);
            PG8_WAIT_V(8); PG8_WAIT_L(0); PG8_BAR; PG8_MMA(1, 0, At, B0); PG8_MMA(1, 1, At, B1); PG8_BAR; PG8_SCHED;
        }
        if constexpr (ALIGN_EPI) { if (wr == 0) PG8_BAR; }
        if constexpr (F8) asm volatile("s_nop 15\n\ts_nop 15" ::: "memory");
        E(acc, cur, wr, wc, opaque(fr), opaque(fq));
        if (!has_next) break;
#pragma unroll
        for (int a = 0; a < 2; ++a)
#pragma unroll
            for (int b = 0; b < 2; ++b)
#pragma unroll
                for (int m = 0; m < 4; ++m)
#pragma unroll
                    for (int n = 0; n < 2; ++n) acc[a][b][m][n] = (f32x4){0.f, 0.f, 0.f, 0.f};
        cur = nxt; cB = nB; c00 = n00; c01 = n01; c10 = n10; c11 = n11; ++ui;
        if constexpr (Epi::PRE) E.pre(lds, cur, wid);
        if constexpr (ALIGN_EPI) { if (wr == 1) PG8_BAR; }
    }
    PG8_WAIT_V(0);
    if constexpr (!ALIGN_EPI) { if (wr == 0) PG8_BAR; }
    PG8_BAR;
#undef PG8_SA
#undef PG8_SB
#undef PG8_STAGE2
#undef PG8_STAGEB
#undef PG8_LDA
#undef PG8_LDB
#undef PG8_MMA
#undef PG8_CAT
#undef PG8_WAIT_V
#undef PG8_WAIT_L
#undef PG8_BAR
#undef PG8_SCHED
}
}

struct Args { const float* in[25]; float* out; unsigned char* ws; int ph_lo, ph_hi; };
constexpr int NWAVES = 8, NTHR = 512;
struct Frame {
    LAS unsigned char* lds;
    volatile LAS unsigned* MISC;
    unsigned* ctl;
    unsigned char* ws;
    const float* const* in;
    float* out;
    int tid, lane, wave, G, bx;
};
enum { I_X = 0, I_C, I_WADA, I_BADA, I_N1G, I_WIN, I_CKVG, I_IKG, I_WUK, I_WUV, I_RELB, I_LBL, I_AOG, I_HOG, I_WOUT, I_N2G, I_WROUT, I_RBIAS, I_EG, I_EU, I_ED, I_SG, I_SU, I_SD, I_FNG };
#define WSP(T_, off) ((T_*)(F.ws + (off)))

struct SrcWin { const float* W; __device__ __forceinline__ float operator()(int k, int p) const {
    int o; if (p < 2304) o = p; else if (p < 6400) o = p + 80; else if (p < 6480) o = p - 4096; else return 0.f;
    return W[(size_t)k * 6480 + o]; } };
struct SrcPlain { const float* W; int N; __device__ __forceinline__ float operator()(int k, int n) const { return W[(size_t)k * N + n]; } };
struct SrcWkv { const float* W; const float* g; __device__ __forceinline__ float operator()(int k, int n) const { return W[(size_t)k * 128 + n] * g[k]; } };
struct SrcW1 { const float* Wg; const float* Wu; __device__ __forceinline__ float operator()(int k, int n) const {
    const int j = (n >> 3) * 4 + (n & 3); const unsigned long long a = (unsigned long long)Wg, bb = (unsigned long long)Wu, msk = 0ull - (unsigned long long)((n >> 2) & 1);
    const float* p = (const float*)(a ^ ((a ^ bb) & msk)); return p[(size_t)k * 512 + j]; } };
template <class Src> __device__ __forceinline__ void p0_tr_item(const Src& src, int K, int nblk, bf16_t* WT, int row_off, LAS float* scr, int item, int lane) {
    const int kb = item / nblk, nb = item % nblk, k0 = 64 * kb, n0 = 32 * nb;
    float tv[32];
#pragma unroll
    for (int i = 0; i < 32; ++i) tv[i] = src(k0 + 2 * i + (lane >> 5), n0 + (lane & 31));
#pragma unroll
    for (int i = 0; i < 32; ++i) scr[(2 * i + (lane >> 5)) * 33 + (lane & 31)] = tv[i];
    LDS_WAIT(); asm volatile("" ::: "memory");
    const int c = lane & 7;
#pragma unroll
    for (int j = 0; j < 4; ++j) { const int n = (lane >> 3) + 8 * j; const LAS float* s = scr + (8 * c) * 33 + n;
        u32x4 o; o.x = pk2(s[0 * 33], s[1 * 33]); o.y = pk2(s[2 * 33], s[3 * 33]); o.z = pk2(s[4 * 33], s[5 * 33]); o.w = pk2(s[6 * 33], s[7 * 33]);
        *(u32x4*)(WT + (size_t)(row_off + n0 + n) * K + k0 + 8 * c) = o; }
    LDS_WAIT(); asm volatile("" ::: "memory");
}
template <class Src> __device__ __forceinline__ void p0_tr_item_both(const Src& src, int K, int nblk, bf16_t* WT, unsigned char* WT8, float sc, LAS float* scr, int item, int lane) {
    const int kb = item / nblk, nb = item % nblk, k0 = 64 * kb, n0 = 32 * nb;
    float tv[32];
#pragma unroll
    for (int i = 0; i < 32; ++i) tv[i] = src(k0 + 2 * i + (lane >> 5), n0 + (lane & 31));
#pragma unroll
    for (int i = 0; i < 32; ++i) scr[(2 * i + (lane >> 5)) * 33 + (lane & 31)] = tv[i];
    LDS_WAIT(); asm volatile("" ::: "memory");
    const int c = lane & 7;
#pragma unroll
    for (int j = 0; j < 4; ++j) { const int n = (lane >> 3) + 8 * j; const LAS float* s = scr + (8 * c) * 33 + n;
        const float v0 = s[0 * 33], v1 = s[1 * 33], v2 = s[2 * 33], v3 = s[3 * 33], v4 = s[4 * 33], v5 = s[5 * 33], v6 = s[6 * 33], v7 = s[7 * 33];
        *(u32x4*)(WT + (size_t)(n0 + n) * K + k0 + 8 * c) = (u32x4){pk2(v0, v1), pk2(v2, v3), pk2(v4, v5), pk2(v6, v7)};
        *(u32x2*)(WT8 + (size_t)(n0 + n) * K + k0 + 8 * c) = (u32x2){pk4_f8(v0 * sc, v1 * sc, v2 * sc, v3 * sc), pk4_f8(v4 * sc, v5 * sc, v6 * sc, v7 * sc)}; }
    LDS_WAIT(); asm volatile("" ::: "memory");
}
template <class Src> __device__ __forceinline__ void p0_tr_item_f8(const Src& src, int K, int nblk, unsigned char* WT, float sc, LAS float* scr, int item, int lane) {
    const int kb = item / nblk, nb = item % nblk, k0 = 64 * kb, n0 = 32 * nb;
    float tv[32];
#pragma unroll
    for (int i = 0; i < 32; ++i) tv[i] = src(k0 + 2 * i + (lane >> 5), n0 + (lane & 31));
#pragma unroll
    for (int i = 0; i < 32; ++i) scr[(2 * i + (lane >> 5)) * 33 + (lane & 31)] = tv[i] * sc;
    LDS_WAIT(); asm volatile("" ::: "memory");
    const int c = lane & 7;
#pragma unroll
    for (int j = 0; j < 4; ++j) { const int n = (lane >> 3) + 8 * j; const LAS float* s = scr + (8 * c) * 33 + n;
        *(u32x2*)(WT + (size_t)(n0 + n) * K + k0 + 8 * c) = (u32x2){pk4_f8(s[0 * 33], s[1 * 33], s[2 * 33], s[3 * 33]), pk4_f8(s[4 * 33], s[5 * 33], s[6 * 33], s[7 * 33])}; }
    LDS_WAIT(); asm volatile("" ::: "memory");
}
constexpr int EXP_ITEMS = 65 * 512 + 65 * 256, EXP_LATE = 31000, EXP_LATE_H = 3328;
constexpr int NCONV = 48;
struct ExpItem { const float* Wg; const float* Wu; unsigned char* WT; int K, nblk, item, kind; float sc; };
__device__ __forceinline__ bool exp_item(Frame& F, int it, ExpItem& x) {
    constexpr int I_W1 = 65 * 512, I_W2 = 65 * 256;
    if (it >= I_W1 + I_W2) return false;
    if (it < I_W1) { const int e = it >> 9; x.item = it & 511; x.kind = 0; x.K = 2048; x.nblk = 16; x.sc = W1_SCALE; x.WT = WSP(unsigned char, WS_W1) + (size_t)e * 1024 * 2048;
        if (e < 64) { x.Wg = F.in[I_EG] + (size_t)e * 2048 * 512; x.Wu = F.in[I_EU] + (size_t)e * 2048 * 512; } else { x.Wg = F.in[I_SG]; x.Wu = F.in[I_SU]; } }
    else { const int r = it - I_W1, e = r >> 8; x.item = r & 255; x.kind = 1; x.K = 512; x.nblk = 32; x.sc = W2_SCALE; x.WT = WSP(unsigned char, WS_W2) + (size_t)e * 2048 * 512;
        x.Wg = (e < 64) ? F.in[I_ED] + (size_t)e * 512 * 2048 : F.in[I_SD]; x.Wu = x.Wg; }
    return true;
}
__device__ __forceinline__ void exp_load(const ExpItem& x, float (&tv)[64], int lane) {
    const int kb = x.item / x.nblk, nb = x.item % x.nblk, k0 = 64 * kb, n = 64 * nb + lane;
    const float* p; size_t pitch;
    if (x.kind == 0) { const int j = (n >> 3) * 4 + (n & 3); const unsigned long long a = (unsigned long long)x.Wg, bb = (unsigned long long)x.Wu, msk = 0ull - (unsigned long long)((n >> 2) & 1);
        p = (const float*)(a ^ ((a ^ bb) & msk)) + j; pitch = 512; }
    else { p = x.Wg + n; pitch = 2048; }
    p += (size_t)k0 * pitch;
#pragma unroll
    for (int i = 0; i < 64; ++i) tv[i] = p[(size_t)i * pitch];
}
__device__ __forceinline__ void exp_store(const ExpItem& x, const float (&tv)[64], LAS float* scr, int lane) {
    const int kb = x.item / x.nblk, nb = x.item % x.nblk, k0 = 64 * kb, n0 = 64 * nb;
#pragma unroll
    for (int i = 0; i < 64; ++i) scr[i * 65 + lane] = tv[i] * x.sc;
    LDS_WAIT(); asm volatile("" ::: "memory");
    const int c = lane & 7;
#pragma unroll
    for (int j = 0; j < 8; ++j) { const int n = (lane >> 3) + 8 * j; const LAS float* s = scr + (8 * c) * 65 + n;
        *(u32x2*)(x.WT + (size_t)(n0 + n) * x.K + k0 + 8 * c) = (u32x2){pk4_f8(s[0 * 65], s[1 * 65], s[2 * 65], s[3 * 65]), pk4_f8(s[4 * 65], s[5 * 65], s[6 * 65], s[7 * 65])}; }
    LDS_WAIT(); asm volatile("" ::: "memory");
}
__device__ __forceinline__ void p0_experts(Frame& F, int cb, int ncb, int it_lo, int it_hi) {
    LAS float* scr = (LAS float*)(F.lds + F.wave * 16640);
    const int gw = cb * NWAVES + F.wave, NGW = ncb * NWAVES, lane = F.lane;
    ExpItem xa, xb; float ta[64], tb[64];
    int it = it_lo + gw; bool va = it < it_hi && exp_item(F, it, xa); if (va) exp_load(xa, ta, lane);
#pragma nounroll
    for (;;) {
        if (!va) break;
        const bool vb = it + NGW < it_hi && exp_item(F, it + NGW, xb); if (vb) exp_load(xb, tb, lane);
        exp_store(xa, ta, scr, lane);
        if (!vb) break;
        it += 2 * NGW; va = it < it_hi && exp_item(F, it, xa); if (va) exp_load(xa, ta, lane);
        exp_store(xb, tb, scr, lane);
    }
    __syncthreads();
}
__device__ __forceinline__ void p0_prologue(Frame& F) {
    LAS float* scr = (LAS float*)(F.lds + F.wave * 16384);
    const int gw = F.bx * NWAVES + F.wave, NGW = F.G * NWAVES, lane = F.lane;
    constexpr int I_WINI = 32 * 208, I_WO = 32 * 64, I_KV = 256, I_ADA = 64 * 48, I_RT = 256;
    constexpr int NITEMS = I_WINI + I_WO + I_KV + I_ADA + I_RT;
    for (int it = gw; it < NITEMS; it += NGW) {
        int r = it;
        if (r < I_WINI) { SrcWin s; s.W = F.in[I_WIN]; p0_tr_item_both(s, 2048, 208, WSP(bf16_t, WS_WIN), WSP(unsigned char, WS_WIN8), WIN_SCALE, scr, r, lane); continue; } r -= I_WINI;
        if (r < I_WO) { SrcPlain s; s.W = F.in[I_WOUT]; s.N = 2048; p0_tr_item_f8(s, 2048, 64, WSP(unsigned char, WS_WOUT), WO_SCALE, scr, r, lane); continue; } r -= I_WO;
        if (r < I_KV) { const int kv = r >> 7, h = (r >> 4) & 7, rr = r & 15;
            SrcWkv s; s.W = F.in[kv ? I_WUV : I_WUK] + (size_t)h * 256 * 128; s.g = F.in[I_CKVG];
            p0_tr_item(s, 256, 4, WSP(bf16_t, WS_WKV), kv * 1024 + h * 128, scr, rr, lane); continue; } r -= I_KV;
        if (r < I_ADA) { const int ks = r / 48, cb = r % 48;
            const float* cc = F.in[I_C];
#pragma unroll
            for (int j = 0; j < 4; ++j) { const int b = lane >> 3, kk = (lane & 7) + 8 * j; const float v = cc[b * 2048 + ks * 32 + kk]; scr[b * 32 + kk] = v * sigmoidf_(v); }
            LDS_WAIT(); asm volatile("" ::: "memory");
            f32x4 acc[8];
#pragma unroll
            for (int b = 0; b < 8; ++b) acc[b] = (f32x4){0.f, 0.f, 0.f, 0.f};
            const float* wp = F.in[I_WADA] + (size_t)(ks * 32) * 12288 + cb * 256 + lane * 4;
#pragma unroll 16
            for (int k = 0; k < 32; ++k) { const f32x4 w = *(const f32x4*)(wp + (size_t)k * 12288);
#pragma unroll
                for (int b = 0; b < 8; ++b) acc[b] += w * scr[b * 32 + k]; }
            float* mp = WSP(float, WS_MODP) + (size_t)ks * 8 * 12288 + cb * 256 + lane * 4;
#pragma unroll
            for (int b = 0; b < 8; ++b) *(f32x4*)(mp + (size_t)b * 12288) = acc[b];
            LDS_WAIT(); asm volatile("" ::: "memory"); continue; } r -= I_ADA;
        if (r < I_RT) { const int s = r >> 2, nt = r & 3, n = lane & 15, g = lane >> 4; const float* wr_ = F.in[I_WROUT];
            float v[8]; unsigned hi[4], lo[4];
#pragma unroll
            for (int j = 0; j < 8; ++j) v[j] = wr_[(size_t)(32 * s + 8 * g + j) * 64 + 16 * nt + n];
#pragma unroll
            for (int j = 0; j < 4; ++j) { const unsigned h0 = f2bf(v[2 * j]), h1 = f2bf(v[2 * j + 1]); hi[j] = h0 | (h1 << 16);
                lo[j] = f2bf(v[2 * j] - bf1((bf16_t)h0)) | (f2bf(v[2 * j + 1] - bf1((bf16_t)h1)) << 16); }
            u32x4* o = WSP(u32x4, WS_WR) + (size_t)((s * 4 + nt) * 2) * 64 + lane;
            o[0] = (u32x4){hi[0], hi[1], hi[2], hi[3]}; o[64] = (u32x4){lo[0], lo[1], lo[2], lo[3]}; continue; }
    }
}
__device__ __forceinline__ void p0b_mod(Frame& F) {
    const float* mp = WSP(float, WS_MODP); float* mod = WSP(float, WS_MOD); const float* ba = F.in[I_BADA];
    for (int i = F.bx * NTHR + F.tid; i < 8 * 12288; i += F.G * NTHR) { float s = ba[i % 12288];
#pragma unroll
        for (int ks = 0; ks < 64; ++ks) s += mp[(size_t)ks * 8 * 12288 + i];
        mod[i] = s; }
}
__device__ __forceinline__ void p1_h1(Frame& F) {
    const int gw = F.bx * NWAVES + F.wave, NGW = F.G * NWAVES, lane = F.lane;
    const float* mod = WSP(float, WS_MOD); const float* g = F.in[I_N1G]; bf16_t* H1 = WSP(bf16_t, WS_H1);
#pragma nounroll
    for (int m = gw; m < T; m += NGW) { const int b = m >> 11;
        const f32x4* xr = (const f32x4*)(F.in[I_X] + (size_t)m * D) + lane;
        f32x4 v[8]; float s = 0.f;
#pragma unroll
        for (int j = 0; j < 8; ++j) { v[j] = xr[64 * j]; s += (v[j].x * v[j].x + v[j].y * v[j].y) + (v[j].z * v[j].z + v[j].w * v[j].w); }
        const float rstd = 1.f / sqrtf(wave_sum(s) * (1.f / D) + EPS);
        u32x2* o = (u32x2*)(H1 + (size_t)m * D) + lane; unsigned* o8 = (unsigned*)(WSP(unsigned char, WS_H1F8) + (size_t)m * D) + lane;
#pragma unroll
        for (int j = 0; j < 8; ++j) { const int c = 4 * lane + 256 * j;
            const f32x4 gg = *(const f32x4*)(g + c), sc = *(const f32x4*)(mod + b * 12288 + 2048 + c), sh = *(const f32x4*)(mod + b * 12288 + c);
            const f32x4 h = v[j] * rstd * gg * (sc + 1.f) + sh;
            o[64 * j] = (u32x2){pk2(h.x, h.y), pk2(h.z, h.w)}; o8[64 * j] = pk4_f8(h.x * H1_SCALE, h.y * H1_SCALE, h.z * H1_SCALE, h.w * H1_SCALE); }
    }
}

struct EpiProj {
    static constexpr bool PERM = true, PRE = false;
    unsigned char* ws; const float* lbl; float sc;
    __device__ __forceinline__ void operator()(const f32x4 (&acc_)[2][2][4][2], const pg8::Unit& u, int wr, int wc, int fr, int fq) const {
        const int pn = u.pn, row0 = u.pm * 256 + wr * 64 + fr, ct = 32 * wc + 8 * fq;
        f32x4 acc[2][2][4][2];
#pragma unroll
        for (int a = 0; a < 2; ++a)
#pragma unroll
            for (int b = 0; b < 2; ++b)
#pragma unroll
                for (int m = 0; m < 4; ++m)
#pragma unroll
                    for (int n = 0; n < 2; ++n) acc[a][b][m][n] = acc_[a][b][m][n] * sc;
        if (pn < 4) {
            bf16_t* QA = (bf16_t*)(ws + WS_QA);
#pragma unroll
            for (int ai = 0; ai < 2; ++ai)
#pragma unroll
                for (int m = 0; m < 4; ++m) { const int row = row0 + ai * 128 + m * 16, b = row >> 11, s = row & 2047;
#pragma unroll
                    for (int bj = 0; bj < 2; ++bj) { const f32x4 v0 = acc[ai][bj][m][0], v1 = acc[ai][bj][m][1];
                        *(u32x4*)(QA + ((size_t)(b * 8 + 2 * pn + bj) * 2048 + s) * 128 + ct) = (u32x4){pk2(v0[0], v0[1]), pk2(v0[2], v0[3]), pk2(v1[0], v1[1]), pk2(v1[2], v1[3])}; } }
        } else if (pn == 4) {
            bf16_t* O = (bf16_t*)(ws + WS_CKV); float* SS = (float*)(ws + WS_CKVSS);
#pragma unroll
            for (int ai = 0; ai < 2; ++ai)
#pragma unroll
                for (int m = 0; m < 4; ++m) { const int row = row0 + ai * 128 + m * 16; float ss = 0.f;
#pragma unroll
                    for (int bj = 0; bj < 2; ++bj) { const f32x4 v0 = acc[ai][bj][m][0], v1 = acc[ai][bj][m][1];
                        ss += (v0[0] * v0[0] + v0[1] * v0[1]) + (v0[2] * v0[2] + v0[3] * v0[3]) + (v1[0] * v1[0] + v1[1] * v1[1]) + (v1[2] * v1[2] + v1[3] * v1[3]);
                        *(u32x4*)(O + (size_t)row * 256 + bj * 128 + ct) = (u32x4){pk2(v0[0], v0[1]), pk2(v0[2], v0[3]), pk2(v1[0], v1[1]), pk2(v1[2], v1[3])}; }
                    ss += __shfl_xor(ss, 16); ss += __shfl_xor(ss, 32);
                    if (fq == 0) SS[(size_t)row * 4 + wc] = ss; }
        } else if (pn >= 13 && pn < 17) {
            float* LF = (float*)(ws + WS_LOGF); bf16_t* KB = (bf16_t*)(ws + WS_KB); const int cb = (pn - 13) * 256 + ct;
            float lb[2][8];
#pragma unroll
            for (int bj = 0; bj < 2; ++bj)
#pragma unroll
                for (int i = 0; i < 8; ++i) { const int c = cb + bj * 128 + i; lb[bj][i] = sigmoidf_(lbl[c] - lbl[1024 + c]); }
#pragma unroll
            for (int ai = 0; ai < 2; ++ai)
#pragma unroll
                for (int m = 0; m < 4; ++m) { const int row = row0 + ai * 128 + m * 16;
#pragma unroll
                    for (int bj = 0; bj < 2; ++bj) { float f[8], lg[8];
#pragma unroll
                        for (int i = 0; i < 8; ++i) { const float a = acc[ai][bj][m][i >> 2][i & 3]; f[i] = lb[bj][i] + (1.f - lb[bj][i]) * sigmoidf_(a); lg[i] = __logf(f[i]); }
                        float* lp = LF + (size_t)row * 1024 + cb + bj * 128;
                        *(f32x4*)lp = (f32x4){lg[0], lg[1], lg[2], lg[3]}; *(f32x4*)(lp + 4) = (f32x4){lg[4], lg[5], lg[6], lg[7]};
                        *(u32x4*)(KB + (size_t)row * 1024 + cb + bj * 128) = (u32x4){pk2(1.f - f[0], 1.f - f[1]), pk2(1.f - f[2], 1.f - f[3]), pk2(1.f - f[4], 1.f - f[5]), pk2(1.f - f[6], 1.f - f[7])}; } }
        } else if (pn == 25) {
            bf16_t* IK = (bf16_t*)(ws + WS_IK); float* IW = (float*)(ws + WS_IW);
#pragma unroll
            for (int ai = 0; ai < 2; ++ai)
#pragma unroll
                for (int m = 0; m < 4; ++m) { const int row = row0 + ai * 128 + m * 16; const f32x4 v0 = acc[ai][0][m][0], v1 = acc[ai][0][m][1];
                    if (wc < 2) { *(u32x4*)(IK + (size_t)row * 64 + ct) = (u32x4){pk2(v0[0], v0[1]), pk2(v0[2], v0[3]), pk2(v1[0], v1[1]), pk2(v1[2], v1[3])};
                        float ss = (v0[0] * v0[0] + v0[1] * v0[1]) + (v0[2] * v0[2] + v0[3] * v0[3]) + (v1[0] * v1[0] + v1[1] * v1[1]) + (v1[2] * v1[2] + v1[3] * v1[3]);
                        ss += __shfl_xor(ss, 16); ss += __shfl_xor(ss, 32);
                        if (fq == 0) ((float*)(ws + WS_IKSS))[(size_t)row * 2 + wc] = ss; }
                    else if (wc == 2 && fq < 2) { float* p = IW + (size_t)row * 16 + 8 * fq; *(f32x4*)p = v0 * 0.03125f; *(f32x4*)(p + 4) = v1 * 0.03125f; } }
        } else {
            size_t off; int t0; bool gate = false;
            if (pn < 9) { off = WS_IQ; t0 = 5; } else if (pn < 13) { off = WS_QB; t0 = 9; } else if (pn < 21) { off = WS_IB; t0 = 17; } else { off = WS_GB; t0 = 21; gate = true; }
            bf16_t* O = (bf16_t*)(ws + off); const int cb = (pn - t0) * 256 + ct;
            f32x4 kg0, kg1;
            { const float* ikg = (const float*)(ws + WS_IKGC); const f32x4 t0_ = *(const f32x4*)(ikg + 32 * (wc & 1) + 8 * fq), t1_ = *(const f32x4*)(ikg + 32 * (wc & 1) + 8 * fq + 4);
#pragma unroll
              for (int i = 0; i < 4; ++i) { kg0[i] = (pn < 9) ? t0_[i] : 1.f; kg1[i] = (pn < 9) ? t1_[i] : 1.f; } }
#pragma unroll
            for (int ai = 0; ai < 2; ++ai)
#pragma unroll
                for (int m = 0; m < 4; ++m) { const int row = row0 + ai * 128 + m * 16;
#pragma unroll
                    for (int bj = 0; bj < 2; ++bj) { f32x4 v0 = acc[ai][bj][m][0] * kg0, v1 = acc[ai][bj][m][1] * kg1;
                        if (gate) {
#pragma unroll
                            for (int i = 0; i < 4; ++i) { v0[i] = v0[i] * sigmoidf_(v0[i]); v1[i] = v1[i] * sigmoidf_(v1[i]); } }
                        *(u32x4*)(O + (size_t)row * 1024 + cb + bj * 128) = (u32x4){pk2(v0[0], v0[1]), pk2(v0[2], v0[3]), pk2(v1[0], v1[1]), pk2(v1[2], v1[3])}; } }
        }
    }
};
struct EpiKV {
    static constexpr bool PERM = true, PRE = false;
    unsigned char* ws;
    __device__ __forceinline__ void operator()(const f32x4 (&acc)[2][2][4][2], const pg8::Unit& u, int wr, int wc, int fr, int fq) const {
        const int pn = u.pn, row0 = u.pm * 256 + wr * 64 + fr, ct = 32 * wc + 8 * fq;
        bf16_t* O = (bf16_t*)(ws + (pn < 4 ? WS_K : WS_V)); const float* SS = (const float*)(ws + WS_CKVSS); const int hp = (pn & 3) * 2;
#pragma unroll
        for (int ai = 0; ai < 2; ++ai)
#pragma unroll
            for (int m = 0; m < 4; ++m) { const int row = row0 + ai * 128 + m * 16, b = row >> 11, s = row & 2047;
                const f32x4 q = *(const f32x4*)(SS + (size_t)row * 4); const float rstd = 1.f / sqrtf(((q[0] + q[1]) + (q[2] + q[3])) * (1.f / 256.f) + EPS);
#pragma unroll
                for (int bj = 0; bj < 2; ++bj) { const f32x4 v0 = acc[ai][bj][m][0] * rstd, v1 = acc[ai][bj][m][1] * rstd;
                    *(u32x4*)(O + ((size_t)(b * 8 + hp + bj) * 2048 + s) * 128 + ct) = (u32x4){pk2(v0[0], v0[1]), pk2(v0[2], v0[3]), pk2(v1[0], v1[1]), pk2(v1[2], v1[3])}; } }
    }
};
struct EpiOut {
    static constexpr bool PERM = true, PRE = false;
    const float* x; bf16_t* x1; const float* mod;
    __device__ __forceinline__ void operator()(const f32x4 (&acc)[2][2][4][2], const pg8::Unit& u, int wr, int wc, int fr, int fq) const {
        const int row0 = u.pm * 256 + wr * 64 + fr, col0 = u.pn * 256 + wc * 32 + 8 * fq, b = (u.pm * 256) >> 11;
        f32x4 g1[2][2];
#pragma unroll
        for (int bj = 0; bj < 2; ++bj)
#pragma unroll
            for (int n = 0; n < 2; ++n) g1[bj][n] = *(const f32x4*)(mod + b * 12288 + 4096 + col0 + bj * 128 + n * 4) * (1.f / (WO_SCALE * A2_SCALE));
#pragma unroll
        for (int ai = 0; ai < 2; ++ai)
#pragma unroll
            for (int m = 0; m < 4; ++m) { const size_t off = (size_t)(row0 + ai * 128 + m * 16) * 2048 + col0;
#pragma unroll
                for (int bj = 0; bj < 2; ++bj) { const f32x4 xa = *(const f32x4*)(x + off + bj * 128), xb = *(const f32x4*)(x + off + bj * 128 + 4);
                    const f32x4 v0 = xa + g1[bj][0] * acc[ai][bj][m][0], v1 = xb + g1[bj][1] * acc[ai][bj][m][1];
                    *(u32x4*)(x1 + off + bj * 128) = (u32x4){pk2(v0[0], v0[1]), pk2(v0[2], v0[3]), pk2(v1[0], v1[1]), pk2(v1[2], v1[3])}; }
                if (m == 3) asm volatile("" ::: "memory"); }
    }
};
__device__ __forceinline__ void p3_indexer(Frame& F, int qoff) {
    const int tid = F.tid, lane = F.lane, w = F.wave, c = lane & 31, half = lane >> 5;
    const bf16_t* IQ = WSP(bf16_t, WS_IQ); const bf16_t* IK = WSP(bf16_t, WS_IK); const float* IW = WSP(float, WS_IW); unsigned* MASK = WSP(unsigned, WS_MASK);
    const float NEG = -__builtin_inff();
    const float* IKSS = WSP(float, WS_IKSS); LAS float* RK = (LAS float*)(F.lds + 131072);
    const int sw = (c >> 1) & 7;
    int boff[4];
#pragma unroll
    for (int s = 0; s < 4; ++s) boff[s] = c * 128 + (((2 * s + half) ^ sw) * 16);
    for (;;) {
        __syncthreads();
        if (tid == 0) F.MISC[16] = __hip_atomic_fetch_add(F.ctl + CW_IDXQ + qoff, 1u, RLX_AGENT);
        __syncthreads();
        const int uid = (int)F.MISC[16];
        if (uid >= 1024) break;
        const int b = uid & 7, q0 = (127 - (uid >> 3)) * 16, nkeys = q0 + 16, qmax = q0 + 15;
        const int myq = q0 + 2 * w + half;
        bf16x8 Af[4];
        { const int sel = (c >> 2) & 1, head = (c & 3) + 4 * (c >> 3);
          const bf16_t* p = IQ + (size_t)(b * 2048 + q0 + 2 * w + sel) * 1024 + head * 64 + 8 * half;
#pragma unroll
          for (int s = 0; s < 4; ++s) Af[s] = *(const bf16x8*)(p + 16 * s); }
        float wv[16];
        { const f32x4* p = (const f32x4*)(IW + (size_t)(b * 2048 + myq) * 16);
#pragma unroll
          for (int i = 0; i < 4; ++i) { const f32x4 t = p[i]; wv[4 * i] = t[0]; wv[4 * i + 1] = t[1]; wv[4 * i + 2] = t[2]; wv[4 * i + 3] = t[3]; } }
        float v[64];
#pragma unroll
        for (int kt = 0; kt < 64; ++kt) v[kt] = NEG;
#pragma unroll
        for (int pass = 0; pass < 2; ++pass) {
            if (pass * 1024 < nkeys) {
                if (pass) __syncthreads();
                const int klo = pass * 1024, n = (nkeys - klo) < 1024 ? (nkeys - klo) : 1024;
                for (int it = 0; it * 64 < n; ++it) { const int kk = it * 64 + 8 * w + (lane >> 3), chs = (lane & 7) ^ ((kk >> 1) & 7);
                    __builtin_amdgcn_global_load_lds((const unsigned*)(IK + (size_t)(b * 2048 + klo + kk) * 64 + 8 * chs), (LAS unsigned*)(F.lds + (it * 64 + 8 * w) * 128), 16, 0, 0); }
#pragma unroll
                for (int i = 0; i < 2; ++i) { const int kk = tid + 512 * i;
                    if (kk < ((n + 63) & ~63)) { const f32x2 q = *(const f32x2*)(IKSS + (size_t)(b * 2048 + klo + kk) * 2); RK[kk] = 1.f / sqrtf((q[0] + q[1]) * (1.f / 64.f) + EPS); } }
                __syncthreads();
#pragma unroll
                for (int kl = 0; kl < 32; ++kl) { const int kt = pass * 32 + kl;
                    if (32 * kt <= qmax) {
                        f32x16 acc = {};
#pragma unroll
                        for (int s = 0; s < 4; ++s) { const bf16x8 bfr = *(const LAS bf16x8*)(F.lds + boff[s] + kl * 4096);
                            acc = __builtin_amdgcn_mfma_f32_32x32x16_bf16(Af[s], bfr, acc, 0, 0, 0); }
                        float sc = 0.f;
#pragma unroll
                        for (int i = 0; i < 16; ++i) sc = fmaf(wv[i], fmaxf(acc[i], 0.f), sc);
                        v[kt] = (32 * kt + c <= myq) ? sc * RK[32 * kl + c] : NEG;
                    }
                }
            }
        }
        float tau = -3.0e38f;
        if (qmax + 1 > TOPK) {
            float mx = NEG, mn = __builtin_inff();
#pragma unroll
            for (int kt = 0; kt < 64; ++kt) { mx = fmaxf(mx, v[kt]); mn = fminf(mn, v[kt] == NEG ? __builtin_inff() : v[kt]); }
#pragma unroll
            for (int o = 1; o < 32; o <<= 1) { mx = fmaxf(mx, __shfl_xor(mx, o)); mn = fminf(mn, __shfl_xor(mn, o)); }
            float lo = mn, hi = mx; bool done = (myq + 1 <= TOPK);
            for (int iter = 0; iter < 64; ++iter) {
                const float mid = 0.5f * lo + 0.5f * hi;
                if (!done && !(mid > lo && mid < hi)) { done = true; tau = lo; }
                if (__all(done)) break;
                int cnt = 0;
#pragma unroll
                for (int kt = 0; kt < 64; ++kt) cnt += (v[kt] >= mid) ? 1 : 0;
#pragma unroll
                for (int o = 1; o < 32; o <<= 1) cnt += __shfl_xor(cnt, o);
                if (!done) { if (cnt == TOPK) { done = true; tau = mid; } else if (cnt > TOPK) lo = mid; else hi = mid; }
            }
            if (!done) tau = lo;
        }
        int mA = 0, mB = 0;
#define IDX_WL(kt) { const unsigned long long m_ = __ballot(v[kt] >= tau); wlane<kt>(mA, (int)(unsigned)m_); wlane<kt>(mB, (int)(unsigned)(m_ >> 32)); }
#define IDX_WL8(k0) IDX_WL(k0) IDX_WL(k0 + 1) IDX_WL(k0 + 2) IDX_WL(k0 + 3) IDX_WL(k0 + 4) IDX_WL(k0 + 5) IDX_WL(k0 + 6) IDX_WL(k0 + 7) __builtin_amdgcn_sched_barrier(0);
        IDX_WL8(0) IDX_WL8(8) IDX_WL8(16) IDX_WL8(24) IDX_WL8(32) IDX_WL8(40) IDX_WL8(48) IDX_WL8(56)
#undef IDX_WL8
#undef IDX_WL
        MASK[(size_t)(b * 2048 + q0 + 2 * w) * 64 + lane] = (unsigned)mA;
        MASK[(size_t)(b * 2048 + q0 + 2 * w + 1) * 64 + lane] = (unsigned)mB;
    }
}

constexpr int HG_PITCH = 272, HG_QD = 0, HG_KI = 16 * HG_PITCH, HG_KDT = 2 * 16 * HG_PITCH, HG_VT = HG_KDT + 4096, HG_DL = HG_VT + 4096, HG_BUF = HG_DL + 512;
struct HgRaw { float lf[4]; bf16_t qq[4], kk[4]; u32x2 v; };
__device__ __forceinline__ void p3_hgrn(Frame& F, int bh) {
    const int tid = F.tid, lane = F.lane, w = F.wave, r = lane & 15, g = lane >> 4;
    const int b = bh >> 3, h = bh & 7;
    const float* LOGF = WSP(float, WS_LOGF); const bf16_t* QB = WSP(bf16_t, WS_QB); const bf16_t* KBp = WSP(bf16_t, WS_KB); const bf16_t* IB = WSP(bf16_t, WS_IB); bf16_t* HO = WSP(bf16_t, WS_HO);
    const int pc = 16 * w + r;
    const size_t colbase = (size_t)h * 128;
    f32x4 S[8];
#pragma unroll
    for (int m = 0; m < 8; ++m) S[m] = (f32x4){0.f, 0.f, 0.f, 0.f};
    HgRaw R0, R1, R2, R3;
#define HG_LOAD(R, ci) do { if ((ci) < 128) { const size_t row0 = (size_t)b * 2048 + (ci) * 16; \
        _Pragma("unroll") for (int j = 0; j < 4; ++j) { const size_t o = (row0 + 4 * g + j) * 1024 + colbase + pc; R.lf[j] = LOGF[o]; R.qq[j] = QB[o]; R.kk[j] = KBp[o]; } \
        R.v = *(const u32x2*)(IB + (row0 + (tid >> 5)) * 1024 + colbase + (tid & 31) * 4); } } while (0)
#define HG_WRITE(R, buf) do { LAS unsigned char* L = F.lds + (buf) * HG_BUF; \
        float c0 = R.lf[0], c1 = c0 + R.lf[1], c2 = c1 + R.lf[2], c3 = c2 + R.lf[3]; \
        const float t0_ = __shfl(c3, r), t1_ = __shfl(c3, r + 16), t2_ = __shfl(c3, r + 32), t3_ = __shfl(c3, r + 48); \
        const float pre = (g > 0 ? t0_ : 0.f) + (g > 1 ? t1_ : 0.f) + (g > 2 ? t2_ : 0.f); const float blast = (t0_ + t1_) + (t2_ + t3_); \
        const float dd = __expf(blast); float bc[4] = {pre + c0, pre + c1, pre + c2, pre + c3}; unsigned kd[4]; \
        _Pragma("unroll") for (int j = 0; j < 4; ++j) { const float e1 = __expf(bc[j]), e3 = __builtin_amdgcn_rcpf(e1); const float qv = bf1(R.qq[j]), kv = bf1(R.kk[j]); const int t = 4 * g + j; \
            *(LAS bf16_t*)(L + HG_QD + t * HG_PITCH + pc * 2) = (bf16_t)f2bf(qv * e1); *(LAS bf16_t*)(L + HG_KI + t * HG_PITCH + pc * 2) = (bf16_t)f2bf(kv * e3); kd[j] = f2bf(kv * dd * e3); } \
        *(LAS u32x2*)(L + HG_KDT + pc * 32 + g * 8) = (u32x2){kd[0] | (kd[1] << 16), kd[2] | (kd[3] << 16)}; \
        if (g == 0) *(LAS float*)(L + HG_DL + pc * 4) = dd; \
        { const int t = tid >> 5, v4 = (tid & 31) * 4; LAS bf16_t* vt = (LAS bf16_t*)(L + HG_VT); \
          vt[(v4 + 0) * 16 + t] = (bf16_t)(R.v.x & 0xffffu); vt[(v4 + 1) * 16 + t] = (bf16_t)(R.v.x >> 16); vt[(v4 + 2) * 16 + t] = (bf16_t)(R.v.y & 0xffffu); vt[(v4 + 3) * 16 + t] = (bf16_t)(R.v.y >> 16); } } while (0)
#define HG_STEP(ci, Rn) do { const int buf = (ci) & 1; LAS unsigned char* L = F.lds + buf * HG_BUF; \
        bf16x8 fa[4], fq[4]; u32x2 qp0[4], qp1[4]; f32x4 dv[4]; u32x4 ka[4]; u32x4 vb = {0u, 0u, 0u, 0u}; \
          \
        _Pragma("unroll") for (int i = 0; i < 4; ++i) { fa[i] = *(const LAS bf16x8*)(L + HG_KI + r * HG_PITCH + (32 * i + 8 * g) * 2); fq[i] = *(const LAS bf16x8*)(L + HG_QD + r * HG_PITCH + (32 * i + 8 * g) * 2); } \
        const u32x2 vi = *(const LAS u32x2*)(L + HG_VT + (16 * w + r) * 32 + g * 8); \
        _Pragma("unroll") for (int i = 0; i < 4; ++i) { qp0[i] = *(const LAS u32x2*)(L + HG_QD + r * HG_PITCH + (32 * i + 4 * g) * 2); qp1[i] = *(const LAS u32x2*)(L + HG_QD + r * HG_PITCH + (32 * i + 16 + 4 * g) * 2); } \
        if (g < 2) vb = *(const LAS u32x4*)(L + HG_VT + (16 * w + r) * 32 + g * 16); \
        _Pragma("unroll") for (int m = 0; m < 4; ++m) { dv[m] = *(const LAS f32x4*)(L + HG_DL + (16 * m + 4 * g) * 4); ka[m] = (u32x4){0u, 0u, 0u, 0u}; if (g < 2) ka[m] = *(const LAS u32x4*)(L + HG_KDT + (16 * m + r) * 32 + g * 16); } \
        f32x4 sT = (f32x4){0.f, 0.f, 0.f, 0.f}; \
        _Pragma("unroll") for (int i = 0; i < 4; ++i) sT = __builtin_amdgcn_mfma_f32_16x16x32_bf16(fa[i], fq[i], sT, 0, 0, 0); \
          \
        f32x4 oT = (f32x4){0.f, 0.f, 0.f, 0.f}; \
        _Pragma("unroll") for (int i = 0; i < 4; ++i) { const u32x4 sa = {pk2(S[2 * i][0], S[2 * i][1]), pk2(S[2 * i][2], S[2 * i][3]), pk2(S[2 * i + 1][0], S[2 * i + 1][1]), pk2(S[2 * i + 1][2], S[2 * i + 1][3])}; \
            const u32x4 qb = {qp0[i].x, qp0[i].y, qp1[i].x, qp1[i].y}; \
            oT = __builtin_amdgcn_mfma_f32_16x16x32_bf16(__builtin_bit_cast(bf16x8, sa), __builtin_bit_cast(bf16x8, qb), oT, 0, 0, 0); } \
          \
        _Pragma("unroll") for (int m = 0; m < 4; ++m) S[m] = __builtin_amdgcn_mfma_f32_16x16x32_bf16(__builtin_bit_cast(bf16x8, ka[m]), __builtin_bit_cast(bf16x8, vb), S[m] * dv[m], 0, 0, 0); \
        _Pragma("unroll") for (int m = 0; m < 4; ++m) { dv[m] = *(const LAS f32x4*)(L + HG_DL + (16 * (m + 4) + 4 * g) * 4); ka[m] = (u32x4){0u, 0u, 0u, 0u}; if (g < 2) ka[m] = *(const LAS u32x4*)(L + HG_KDT + (16 * (m + 4) + r) * 32 + g * 16); } \
        _Pragma("unroll") for (int m = 0; m < 4; ++m) S[m + 4] = __builtin_amdgcn_mfma_f32_16x16x32_bf16(__builtin_bit_cast(bf16x8, ka[m]), __builtin_bit_cast(bf16x8, vb), S[m + 4] * dv[m], 0, 0, 0); \
        _Pragma("unroll") for (int j = 0; j < 4; ++j) if (4 * g + j > r) sT[j] = 0.f; \
        const u32x4 pw = {pk2(sT[0], sT[1]), pk2(sT[2], sT[3]), 0u, 0u}; const u32x4 viw = {vi.x, vi.y, 0u, 0u}; \
        oT = __builtin_amdgcn_mfma_f32_16x16x32_bf16(__builtin_bit_cast(bf16x8, viw), __builtin_bit_cast(bf16x8, pw), oT, 0, 0, 0); \
        *(u32x2*)(HO + ((size_t)b * 2048 + (ci) * 16 + r) * 1024 + colbase + 16 * w + 4 * g) = (u32x2){pk2(oT[0], oT[1]), pk2(oT[2], oT[3])}; \
        if ((ci) + 1 < 128) { HG_WRITE(Rn, buf ^ 1); HG_LOAD(Rn, (ci) + 5); } \
        asm volatile("s_waitcnt lgkmcnt(0)" ::: "memory"); __builtin_amdgcn_s_barrier(); asm volatile("" ::: "memory"); } while (0)
    HG_LOAD(R0, 0); HG_LOAD(R1, 1); HG_LOAD(R2, 2); HG_LOAD(R3, 3);
    HG_WRITE(R0, 0); HG_LOAD(R0, 4);
    __syncthreads();
#pragma nounroll
    for (int ci = 0; ci < 128; ci += 4) { HG_STEP(ci, R1); HG_STEP(ci + 1, R2); HG_STEP(ci + 2, R3); HG_STEP(ci + 3, R0); }
    __syncthreads();
#undef HG_LOAD
#undef HG_WRITE
#undef HG_STEP
}

__device__ __forceinline__ int t5_bucket(int n) {
    if (n < 16) return n;
    int l = 16 + (int)(logf((float)n * (1.f / 16.f)) / logf(8.f) * 16.f);
    return l < 31 ? l : 31;
}
__device__ __forceinline__ void p4_attn_naive(Frame& F) {
    const int lane = F.lane, w = F.wave, gw = F.bx * NWAVES + w, NGW = F.G * NWAVES;
    LAS int* list = (LAS int*)(F.lds + w * 4096); LAS float* pl = (LAS float*)(F.lds + w * 4096 + 1024); LAS float* ql = (LAS float*)(F.lds + w * 4096 + 2048);
    const unsigned* MASK = WSP(unsigned, WS_MASK); const bf16_t* QA = WSP(bf16_t, WS_QA); const bf16_t* Kp = WSP(bf16_t, WS_K); const bf16_t* Vp = WSP(bf16_t, WS_V); bf16_t* AO = WSP(bf16_t, WS_AO);
    const float* relb = F.in[I_RELB];
#pragma nounroll
    for (int item = gw; item < T; item += NGW) { const int b = item >> 11, q = item & 2047;
        unsigned mw = MASK[(size_t)item * 64 + lane]; if (NOSEL) { const int k0_ = lane * 32; mw = (q >= k0_ + 31) ? 0xFFFFFFFFu : (q < k0_ ? 0u : ((2u << (q - k0_)) - 1u)); }
        const int cnt = __popc(mw); int pre = cnt;
#pragma unroll
        for (int o = 1; o < 64; o <<= 1) { const int t = __shfl_up(pre, o); if (lane >= o) pre += t; }
        int nsel = __shfl(pre, 63); int pos = pre - cnt; if (nsel > 256) nsel = 256;
        while (mw) { const int bit = __builtin_ctz(mw); if (pos < 256) list[pos] = lane * 32 + bit; ++pos; mw &= mw - 1; }
        LDS_WAIT(); asm volatile("" ::: "memory");
        for (int h = 0; h < 8; ++h) { const size_t hb = (size_t)(b * 8 + h) * 2048;
            { const unsigned qv = *(const unsigned*)(QA + (hb + q) * 128 + 2 * lane); ql[2 * lane] = bflo(qv); ql[2 * lane + 1] = bfhi(qv); }
            LDS_WAIT(); asm volatile("" ::: "memory");
            float sc[4]; float mx = -__builtin_inff();
#pragma unroll
            for (int jj = 0; jj < 4; ++jj) { const int idx = lane + 64 * jj; sc[jj] = -__builtin_inff();
                if (idx < nsel) { const int key = list[idx]; const u32x4* kp = (const u32x4*)(Kp + (hb + key) * 128); float s = 0.f;
#pragma unroll
                    for (int ch = 0; ch < 16; ++ch) { const u32x4 kv = kp[ch]; const f32x4 qa = *(const LAS f32x4*)(ql + 8 * ch), qb = *(const LAS f32x4*)(ql + 8 * ch + 4);
                        s += bflo(kv.x) * qa[0] + bfhi(kv.x) * qa[1] + bflo(kv.y) * qa[2] + bfhi(kv.y) * qa[3] + bflo(kv.z) * qb[0] + bfhi(kv.z) * qb[1] + bflo(kv.w) * qb[2] + bfhi(kv.w) * qb[3]; }
                    sc[jj] = s * ATT_SCALE + (NOBIAS ? 0.f : relb[t5_bucket(q - key > 0 ? q - key : 0) * 8 + h]); }
                mx = fmaxf(mx, sc[jj]); }
#pragma unroll
            for (int o = 1; o < 64; o <<= 1) mx = fmaxf(mx, __shfl_xor(mx, o));
            float ls = 0.f;
#pragma unroll
            for (int jj = 0; jj < 4; ++jj) { const int idx = lane + 64 * jj; const float p = (idx < nsel) ? __expf(sc[jj] - mx) : 0.f; ls += p; pl[idx] = p; }
            ls = wave_sum(ls);
            LDS_WAIT(); asm volatile("" ::: "memory");
            const int dg = lane & 15, kg = lane >> 4; float o[8];
#pragma unroll
            for (int i = 0; i < 8; ++i) o[i] = 0.f;
#pragma unroll 4
            for (int i0 = 0; i0 < nsel; i0 += 4) { const int i = i0 + kg;
                if (i < nsel) { const int key = list[i]; const float p = pl[i]; const u32x4 vv = *(const u32x4*)(Vp + (hb + key) * 128 + 8 * dg);
                    o[0] += p * bflo(vv.x); o[1] += p * bfhi(vv.x); o[2] += p * bflo(vv.y); o[3] += p * bfhi(vv.y); o[4] += p * bflo(vv.z); o[5] += p * bfhi(vv.z); o[6] += p * bflo(vv.w); o[7] += p * bfhi(vv.w); } }
            const float inv = 1.f / ls;
#pragma unroll
            for (int i = 0; i < 8; ++i) { o[i] += __shfl_xor(o[i], 16); o[i] += __shfl_xor(o[i], 32); o[i] *= inv; }
            if (kg == 0) *(u32x4*)(AO + (hb + q) * 128 + 8 * dg) = (u32x4){pk2(o[0], o[1]), pk2(o[2], o[3]), pk2(o[4], o[5]), pk2(o[6], o[7])};
            LDS_WAIT(); asm volatile("" ::: "memory");
        }
    }
}

namespace att {
constexpr int NW = 8, QBLK = 32, KVBLK = 64, QB = NW * QBLK, DH = 128;
constexpr int SHM_V = KVBLK * DH * 2, SHM_K = KVBLK * DH * 2;
constexpr int OFF_WS = 2 * SHM_V + 2 * SHM_K, OFF_TB = OFF_WS + NW * 64 * 4, TB_N = 384, OFF_MK = OFF_TB + 8 * TB_N * 4, OFF_Q = OFF_MK + 4096;
constexpr float SCALE = 0.08838834764831845f, THR = 8.f;
constexpr unsigned WBIG = 0x40000000u;
#define KSWZ(row, colB) ((row) * 256 + ((colB) ^ (((row) & 7) << 4)))
#define SBAR() __builtin_amdgcn_sched_barrier(0)
__device__ __forceinline__ int v_st(int k, int c) { const int kk = (k & ~0xC) | ((k & 4) << 1) | ((k & 8) >> 1); return ((kk >> 3) * 4 + (c >> 5)) * 512 + ((kk & 7) * 32 + (c & 31)) * 2; }
__device__ __forceinline__ int v_rd_base(int lane) { return ((lane & 3) << 3) | (((lane >> 2) & 3) << 6) | (((lane >> 4) & 1) << 5) | (((lane >> 5) & 1) << 8); }
constexpr int v_rd_off(int d0, int ks, int half) { return d0 * 512 + ks * 4096 + half * 2048; }
__device__ __forceinline__ int crow(int r, int hi) { return (r & 3) + 8 * (r >> 2) + 4 * hi; }
__device__ __forceinline__ void mask_tile(f32x16& p0, f32x16& p1, int dq, unsigned W) {
    const float NEG = -__builtin_inff();
#pragma unroll
    for (int r = 0; r < 16; ++r) { const int c = (r & 3) + 8 * (r >> 2);
        if ((unsigned)(dq - c) >= W) p0[r] = NEG;
        if ((unsigned)(dq - c - 32) >= W) p1[r] = NEG; }
}
__device__ __forceinline__ void swap32(unsigned& a, unsigned& b) { asm volatile("s_nop 1\n\tv_permlane32_swap_b32 %0, %1\n\ts_nop 1" : "+v"(a), "+v"(b)); }
__device__ __forceinline__ float selmask(float p, unsigned ws, int c) { if (NOSEL) return p; return __builtin_bit_cast(float, __builtin_bit_cast(unsigned, p) & (unsigned)__builtin_amdgcn_sbfe((int)ws, c, 1)); }
__device__ __forceinline__ void partialSM(f32x16& p0, f32x16& p1, float& m_reg, float& mn, float& alpha, unsigned w0s) {
    float pmax = p0[0]; for (int r = 1; r < 16; ++r) pmax = fmaxf(pmax, p0[r]); for (int r = 0; r < 16; ++r) pmax = fmaxf(pmax, p1[r]);
    { unsigned xa = __builtin_bit_cast(unsigned, pmax), xb = xa; swap32(xa, xb);
      pmax = fmaxf(__builtin_bit_cast(float, xa), __builtin_bit_cast(float, xb)); }
    constexpr float C2 = 1.4426950408889634f * SCALE;
    if (__builtin_expect(__all((pmax - m_reg) * SCALE <= THR), 1)) { mn = m_reg; alpha = 1.f; }
    else { mn = fmaxf(m_reg, pmax); alpha = __builtin_amdgcn_exp2f((m_reg - mn) * C2); m_reg = mn; }
    const float mnL = -mn * C2;
    for (int r = 0; r < 16; ++r) p0[r] = fmaf(p0[r], C2, mnL); for (int r = 0; r < 16; ++r) p1[r] = fmaf(p1[r], C2, mnL);
    for (int r = 0; r < 16; ++r) p0[r] = selmask(__builtin_amdgcn_exp2f(p0[r]), w0s, (r & 3) + 8 * (r >> 2));
}
__device__ __forceinline__ void finishSM(f32x16& p0, f32x16& p1, float alpha, float& l_reg, bf16x8& pa0, bf16x8& pa1, bf16x8& pa2, bf16x8& pa3, unsigned w1s) {
    for (int r = 0; r < 16; ++r) p1[r] = selmask(__builtin_amdgcn_exp2f(p1[r]), w1s, (r & 3) + 8 * (r >> 2));
    float ps = 0; for (int r = 0; r < 16; ++r) ps += p0[r]; for (int r = 0; r < 16; ++r) ps += p1[r];
    { unsigned xa = __builtin_bit_cast(unsigned, ps), xb = xa; swap32(xa, xb);
      ps = __builtin_bit_cast(float, xa) + __builtin_bit_cast(float, xb); }
    l_reg = l_reg * alpha + ps;
#define PK4(P, B_, OUT) do { unsigned a0 = pk2(P[B_+0], P[B_+1]), a1 = pk2(P[B_+2], P[B_+3]);                          \
        unsigned b0 = pk2(P[B_+4], P[B_+5]), b1 = pk2(P[B_+6], P[B_+7]);                                             \
        auto r0 = __builtin_amdgcn_permlane32_swap(a0, b0, false, false); auto r1 = __builtin_amdgcn_permlane32_swap(a1, b1, false, false); \
        u32x4 w = {r0[0], r1[0], r0[1], r1[1]}; OUT = __builtin_bit_cast(bf16x8, w); } while (0)
    PK4(p0, 0, pa0); PK4(p0, 8, pa1); PK4(p1, 0, pa2); PK4(p1, 8, pa3);
#undef PK4
}
template <int KB>
__device__ __forceinline__ void qkt(f32x16& p0, f32x16& p1, const char* K_lds, int r32, int hi, const char* qb, const bf16x8* qr_) {
    p0 = f32x16{}; p1 = f32x16{};
    const char* kb[4];
#pragma unroll
    for (int dd = 0; dd < 4; ++dd) kb[dd] = K_lds + KB * SHM_K + KSWZ(r32, (dd * 16 + hi * 8) * 2);
#pragma unroll
    for (int d0 = 0; d0 < 8; ++d0) { const char* a = kb[d0 & 3] + (d0 >> 2) * 128;
        bf16x8 b0 = *reinterpret_cast<const bf16x8*>(a);
        bf16x8 b1 = *reinterpret_cast<const bf16x8*>(a + 32 * 256);
        const bf16x8 qf = QREG ? qr_[d0] : *reinterpret_cast<const bf16x8*>(qb + d0 * 1024);
        p0 = __builtin_amdgcn_mfma_f32_32x32x16_bf16(b0, qf, p0, 0, 0, 0);
        p1 = __builtin_amdgcn_mfma_f32_32x32x16_bf16(b1, qf, p1, 0, 0, 0); }
}
template <int VB>
__device__ __forceinline__ void pv_tile(f32x16* o, int vb0, bf16x8 pa0, bf16x8 pa1, bf16x8 pa2, bf16x8 pa3) {
#define TRRD(dst, off) asm volatile("ds_read_b64_tr_b16 %0, %1 offset:%2" : "=&v"(dst) : "v"(vb0), "i"(off) : "memory")
#define PV_D0(d0) do { s16x4 l0, l1, l2, l3, h0, h1, h2, h3; constexpr int b_ = VB * SHM_V + v_rd_off(d0, 0, 0); \
        TRRD(l0, b_); TRRD(h0, b_ + 2048); TRRD(l1, b_ + 4096); TRRD(h1, b_ + 6144); TRRD(l2, b_ + 8192); TRRD(h2, b_ + 10240); TRRD(l3, b_ + 12288); TRRD(h3, b_ + 14336); \
        asm volatile("s_waitcnt lgkmcnt(0)" ::: "memory"); SBAR();   \
        o[d0] = __builtin_amdgcn_mfma_f32_32x32x16_bf16(pa0, (bf16x8){l0[0], l0[1], l0[2], l0[3], h0[0], h0[1], h0[2], h0[3]}, o[d0], 0, 0, 0);   \
        o[d0] = __builtin_amdgcn_mfma_f32_32x32x16_bf16(pa1, (bf16x8){l1[0], l1[1], l1[2], l1[3], h1[0], h1[1], h1[2], h1[3]}, o[d0], 0, 0, 0);   \
        o[d0] = __builtin_amdgcn_mfma_f32_32x32x16_bf16(pa2, (bf16x8){l2[0], l2[1], l2[2], l2[3], h2[0], h2[1], h2[2], h2[3]}, o[d0], 0, 0, 0);   \
        o[d0] = __builtin_amdgcn_mfma_f32_32x32x16_bf16(pa3, (bf16x8){l3[0], l3[1], l3[2], l3[3], h3[0], h3[1], h3[2], h3[3]}, o[d0], 0, 0, 0); } while (0)
    PV_D0(0); PV_D0(1); PV_D0(2); PV_D0(3);
#undef PV_D0
#undef TRRD
}
struct BlockRef { const bf16_t* Q; const bf16_t* K; const bf16_t* V; bf16_t* O; const unsigned* M; int P0; int h; };
struct Seam { bf16x8 st_v0, st_v1, st_k0, st_k1; unsigned st_m; };
#define ROW(p, k0, rr) ((p) + (size_t)((k0) + (rr)) * DH + sc)
#define VMW() asm volatile("s_waitcnt vmcnt(0)" ::: "memory")
#define VMWN(n) asm volatile("s_waitcnt vmcnt(%0)" :: "i"(n) : "memory")
#define LD8(p) (*reinterpret_cast<const bf16x8*>(p))
#define SLOAD_H(Kp, Vp, Mp, k0) do { S.st_v0 = LD8(ROW(Vp, k0, sr)); S.st_v1 = LD8(ROW(Vp, k0, 32 + sr)); S.st_k0 = LD8(ROW(Kp, k0, sr)); S.st_k1 = LD8(ROW(Kp, k0, 32 + sr)); \
        S.st_m = (Mp)[(tid >> 1) * 64 + ((k0) >> 5) + (tid & 1)]; } while (0)
#define SWRITE_HK(bf) do { *(bf16x8*)(K_lds + (bf) * SHM_K + kws) = S.st_k0; *(bf16x8*)(K_lds + (bf) * SHM_K + kws + 32 * 256) = S.st_k1; *(unsigned*)(lds + OFF_MK + (bf) * 2048 + tid * 4) = S.st_m; } while (0)
#define SWRITE_HV(bf) do { *(bf16x8*)(V_lds + (bf) * SHM_V + vst0) = S.st_v0; *(bf16x8*)(V_lds + (bf) * SHM_V + vst1) = S.st_v1; } while (0)
#define SWRITE_H(bf) do { SWRITE_HV(bf); SWRITE_HK(bf); } while (0)
__device__ __forceinline__ void prime(const BlockRef& cur, char* lds, Seam& S) {
    const int tid = threadIdx.x, wid = __builtin_amdgcn_readfirstlane(tid >> 6), lane = tid & 63, r32 = lane & 31, hi = lane >> 5;
    const int sr = tid >> 4, sc = (tid & 15) * 8, kws = KSWZ(sr, sc * 2); char* K_lds = lds + 2 * SHM_V;
    (void)wid; (void)lane; (void)r32; (void)hi;
    SLOAD_H(cur.K, cur.V, cur.M, 0); VMW(); SWRITE_HK(0);
    __syncthreads();
}
__device__ __forceinline__ void block(const BlockRef& cur, const BlockRef& nxt, char* lds, Seam& S) {
    const int tid = threadIdx.x, wid = __builtin_amdgcn_readfirstlane(tid >> 6), lane = tid & 63, r32 = lane & 31, hi = lane >> 5;
    const int NT = (cur.P0 + QB - 1) / KVBLK + 1;
    const int qlo = cur.P0 + wid * QBLK, qm = qlo + r32 - 4 * hi;
    char* V_lds = lds; char* K_lds = lds + 2 * SHM_V;
    float* ws = (float*)(lds + OFF_WS) + wid * 64; float* li_l = ws, * al_l = ws + 32;
    const char* tbh = lds + OFF_TB + cur.h * (TB_N * 4);
    float m_reg = -1e30f, l_reg = 0; f32x16 o[4] = {};
    const int sr = tid >> 4, sc = (tid & 15) * 8, vst0 = v_st(sr, sc), vst1 = v_st(32 + sr, sc), kws = KSWZ(sr, sc * 2);
    const int vb0 = (int)(uintptr_t)V_lds + v_rd_base(lane);
    const bf16_t* Kh = cur.K; const bf16_t* Vh = cur.V;
    const unsigned* Mh = cur.M;
    char* qb = lds + OFF_Q + wid * 8192 + lane * 16;
    bf16x8 qrr[8];
    { const bf16_t* qs2 = cur.Q + (size_t)(wid * QBLK + r32) * DH + hi * 8;
#pragma unroll
      for (int d0 = 0; d0 < 8; ++d0) qrr[d0] = QREG ? LD8(qs2 + d0 * 16) : bf16x8{}; }
    { bf16x8 qt[8]; const bf16_t* qsrc = cur.Q + (size_t)(wid * QBLK + opaque(r32)) * DH + opaque(hi) * 8;
#pragma unroll
      for (int d0 = 0; d0 < 8; ++d0) qt[d0] = LD8(qsrc + d0 * 16);
#pragma unroll
      for (int d0 = 0; d0 < 8; ++d0) *(bf16x8*)(qb + d0 * 1024) = qt[d0]; }
    const char* mkl = lds + OFF_MK + (wid * QBLK + r32) * 8;
#define MW0(bf) ((*(const unsigned*)(mkl + (bf) * 2048)) >> (4 * hi))
#define MW1(bf) ((*(const unsigned*)(mkl + (bf) * 2048 + 4)) >> (4 * hi))
#define RESC(a) do { if (__any((a) < 1.f)) { if (hi == 0) al_l[r32] = (a); asm volatile("s_waitcnt lgkmcnt(0)" ::: "memory");              \
                     for (int d_ = 0; d_ < 4; ++d_) for (int r = 0; r < 16; ++r) o[d_][r] *= al_l[crow(r, hi)]; } } while (0)
#define KBASE(t) ((t) * KVBLK)
#define MASKT(P0_, P1_, t) do { const int kb_ = KBASE(t); if (kb_ + KVBLK - 1 > qlo) mask_tile(P0_, P1_, qm - kb_, WBIG); } while (0)
#define BIAST(P0_, P1_, t) do { const int kb_ = KBASE(t); const int dmax_ = qlo + QBLK - 1 - kb_, dmin_ = qlo - kb_ - (KVBLK - 1);                     \
        if (!NOBIAS && dmax_ >= 0 && dmin_ < 113) { const char* tp_ = tbh + (287 - (qm - kb_)) * 4;                                                               \
            _Pragma("unroll") for (int r = 0; r < 16; ++r) { const int c_ = (r & 3) + 8 * (r >> 2);                                                    \
                P0_[r] += *(const float*)(tp_ + c_ * 4); P1_[r] += *(const float*)(tp_ + (c_ + 32) * 4); } } } while (0)
#define SEAM_K0() do { VMW(); SWRITE_HK(0); SBAR(); } while (0)
    f32x16 pA0, pA1, pB0, pB1; float mnA, mnB, alA, alB; bf16x8 pa0, pa1, pa2, pa3;
    SWRITE_HV(0); SBAR();
    if (NT > 1) { SLOAD_H(Kh, Vh, Mh, KBASE(1)); }
    SBAR(); qkt<0>(pA0, pA1, K_lds, r32, hi, qb, qrr);
    BIAST(pA0, pA1, 0); MASKT(pA0, pA1, 0); partialSM(pA0, pA1, m_reg, mnA, alA, MW0(0));
    if (NT > 1) { VMW(); SWRITE_H(1); }
    __syncthreads();
#define HALF_STEP(PX0, PX1, mnX, alX, PY0, PY1, alY, t, KB, VB, SB) do {                                                      \
        SBAR(); qkt<KB>(PX0, PX1, K_lds, r32, hi, qb, qrr);                                                                      \
        finishSM(PY0, PY1, alY, l_reg, pa0, pa1, pa2, pa3, MW1(VB)); SBAR();                                                  \
        if ((t) + 1 < NT) { SLOAD_H(Kh, Vh, Mh, KBASE((t) + 1)); SBAR(); }                                                    \
        pv_tile<VB>(o, vb0, pa0, pa1, pa2, pa3); BIAST(PX0, PX1, (t)); MASKT(PX0, PX1, (t)); partialSM(PX0, PX1, m_reg, mnX, alX, MW0(KB));  \
        __syncthreads();                                                                                                      \
        if ((t) + 1 < NT) { VMW(); SWRITE_H(SB); }                                                                            \
        RESC(alX); __syncthreads(); } while (0)
    for (int t = 1; t + 1 < NT; t += 2) {
        HALF_STEP(pB0, pB1, mnB, alB, pA0, pA1, alA, t, 1, 0, 0);
        HALF_STEP(pA0, pA1, mnA, alA, pB0, pB1, alB, t + 1, 0, 1, 1);
    }
    const bool even = (NT & 1) == 0;
    if (even) { SBAR(); qkt<1>(pB0, pB1, K_lds, r32, hi, qb, qrr); SBAR(); }
    SLOAD_H(nxt.K, nxt.V, nxt.M, 0); SBAR();
    finishSM(pA0, pA1, alA, l_reg, pa0, pa1, pa2, pa3, MW1(0)); SBAR();
    pv_tile<0>(o, vb0, pa0, pa1, pa2, pa3);
    if (even) { BIAST(pB0, pB1, NT - 1); MASKT(pB0, pB1, NT - 1); partialSM(pB0, pB1, m_reg, mnB, alB, MW0(1)); __syncthreads(); RESC(alB);
        finishSM(pB0, pB1, alB, l_reg, pa0, pa1, pa2, pa3, MW1(1)); SBAR(); pv_tile<1>(o, vb0, pa0, pa1, pa2, pa3); }
    else __syncthreads();
    SBAR(); SEAM_K0();
    if (hi == 0) li_l[r32] = l_reg; asm volatile("s_waitcnt lgkmcnt(0)" ::: "memory");
    { const int hie = opaque(hi), r32e = opaque(r32);
    float rli[16];
#pragma unroll
    for (int r = 0; r < 16; ++r) rli[r] = __builtin_amdgcn_rcpf(li_l[crow(r, hie)]);
    bf16_t* Ow = cur.O + (size_t)(wid * QBLK) * DH;
#pragma unroll
    for (int r = 0; r < 16; ++r) { const int orow = crow(r, hie);
#pragma unroll
        for (int d0 = 0; d0 < 4; ++d0) { const float v = o[d0][r] * rli[r]; const float vn = __shfl_xor(v, 1);
            if ((r32e & 1) == 0) *(unsigned*)(Ow + (size_t)orow * DH + d0 * 32 + r32e) = pk2(v, vn); } } }
    __syncthreads();
#undef RESC
#undef KBASE
#undef MASKT
#undef BIAST
#undef SEAM_K0
#undef HALF_STEP
#undef MW0
#undef MW1
}
#undef ROW
#undef VMW
#undef VMWN
#undef LD8
#undef SLOAD_H
#undef SWRITE_HK
#undef SWRITE_HV
#undef SWRITE_H
#undef KSWZ
#undef SBAR
}
__device__ __forceinline__ void p4_attn_dense(Frame& F, bf16_t* AO) {
    char* lds = (char*)F.lds;
    const bf16_t* QA = WSP(bf16_t, WS_QA); const bf16_t* Kp = WSP(bf16_t, WS_K); const bf16_t* Vp = WSP(bf16_t, WS_V); const unsigned* MASK = WSP(unsigned, WS_MASK);
    { const float* relb = F.in[I_RELB]; LAS float* tb = (LAS float*)(F.lds + att::OFF_TB);
      for (int i = F.tid; i < 8 * att::TB_N; i += NTHR) { const int h = i / att::TB_N, j = i % att::TB_N, d = 287 - j;
          tb[i] = (d >= 0 && d < 128) ? (relb[t5_bucket(d) * 8 + h] - relb[31 * 8 + h]) * (1.f / att::SCALE) : 0.f; } }
    __syncthreads();
    const int total = 64 * 4;
    int L = F.bx; if (L >= total) return;
    auto mkref = [&](int item, int pass) { const int bh = item >> 2, y = item & 3, qb = pass ? 7 - y : y; att::BlockRef r;
        r.Q = QA + ((size_t)bh * 2048 + qb * 256) * 128; r.O = AO + ((size_t)bh * 2048 + qb * 256) * 128; r.K = Kp + (size_t)bh * 2048 * 128; r.V = Vp + (size_t)bh * 2048 * 128;
        r.M = MASK + ((size_t)(bh >> 3) * 2048 + qb * 256) * 64; r.P0 = qb * 256; r.h = bh & 7; return r; };
    int pass = 0; att::BlockRef cur = mkref(L, 0); att::Seam S;
    att::prime(cur, lds, S);
    for (;;) {
        const bool more_pass = pass == 0, more_item = L + F.G < total, last = !more_pass && !more_item;
        int passn = pass + 1, Ln = L;
        if (!more_pass) { passn = 0; Ln = more_item ? L + F.G : L; }
        const att::BlockRef nxt = last ? cur : mkref(Ln, passn);
        att::block(cur, nxt, lds, S);
        if (last) break;
        cur = nxt; pass = passn; L = Ln;
    }
}

__device__ __forceinline__ void p5_finalize(Frame& F) {
    const int lane = F.lane, gw = F.bx * NWAVES + F.wave, NGW = F.G * NWAVES;
    const bf16_t* AO = WSP(bf16_t, WS_AO); const bf16_t* HO = WSP(bf16_t, WS_HO); const bf16_t* GB = WSP(bf16_t, WS_GB); unsigned char* A2 = WSP(unsigned char, WS_A2);
    const float* ag = F.in[I_AOG]; const float* hg = F.in[I_HOG];
#pragma nounroll
    for (int m = gw; m < T; m += NGW) { const int b = m >> 11, s = m & 2047;
        const int hh = lane >> 3, c0 = 16 * (lane & 7);
        const u32x4* ap = (const u32x4*)(AO + ((size_t)(b * 8 + hh) * 2048 + s) * 128 + c0);
        const u32x4 a0 = ap[0], a1 = ap[1]; float av[16];
        av[0] = bflo(a0.x); av[1] = bfhi(a0.x); av[2] = bflo(a0.y); av[3] = bfhi(a0.y); av[4] = bflo(a0.z); av[5] = bfhi(a0.z); av[6] = bflo(a0.w); av[7] = bfhi(a0.w);
        av[8] = bflo(a1.x); av[9] = bfhi(a1.x); av[10] = bflo(a1.y); av[11] = bfhi(a1.y); av[12] = bflo(a1.z); av[13] = bfhi(a1.z); av[14] = bflo(a1.w); av[15] = bfhi(a1.w);
        float ss = 0.f;
#pragma unroll
        for (int i = 0; i < 16; ++i) ss += av[i] * av[i];
        const float rstd = 1.f / sqrtf(wave_sum(ss) * (1.f / 1024.f) + EPS);
        unsigned ow[4];
#pragma unroll
        for (int i = 0; i < 4; ++i) ow[i] = pk4_f8(av[4 * i] * rstd * ag[16 * lane + 4 * i] * A2_SCALE, av[4 * i + 1] * rstd * ag[16 * lane + 4 * i + 1] * A2_SCALE, av[4 * i + 2] * rstd * ag[16 * lane + 4 * i + 2] * A2_SCALE, av[4 * i + 3] * rstd * ag[16 * lane + 4 * i + 3] * A2_SCALE);
        *(u32x4*)(A2 + (size_t)m * 2048 + 16 * lane) = (u32x4){ow[0], ow[1], ow[2], ow[3]};
        const u32x4* hp = (const u32x4*)(HO + (size_t)m * 1024 + 16 * lane); float hv[16];
#pragma unroll
        for (int i = 0; i < 2; ++i) { const u32x4 t = hp[i]; hv[8 * i] = bflo(t.x); hv[8 * i + 1] = bfhi(t.x); hv[8 * i + 2] = bflo(t.y); hv[8 * i + 3] = bfhi(t.y); hv[8 * i + 4] = bflo(t.z); hv[8 * i + 5] = bfhi(t.z); hv[8 * i + 6] = bflo(t.w); hv[8 * i + 7] = bfhi(t.w); }
        float s2 = 0.f;
#pragma unroll
        for (int i = 0; i < 16; ++i) s2 += hv[i] * hv[i];
        s2 += __shfl_xor(s2, 1); s2 += __shfl_xor(s2, 2); s2 += __shfl_xor(s2, 4);
        const float r2 = 1.f / sqrtf(s2 * (1.f / 128.f) + EPS);
        const u32x4* gp = (const u32x4*)(GB + (size_t)m * 1024 + 16 * lane); const u32x4 g0 = gp[0], g1 = gp[1]; float gv[16];
        gv[0] = bflo(g0.x); gv[1] = bfhi(g0.x); gv[2] = bflo(g0.y); gv[3] = bfhi(g0.y); gv[4] = bflo(g0.z); gv[5] = bfhi(g0.z); gv[6] = bflo(g0.w); gv[7] = bfhi(g0.w);
        gv[8] = bflo(g1.x); gv[9] = bfhi(g1.x); gv[10] = bflo(g1.y); gv[11] = bfhi(g1.y); gv[12] = bflo(g1.z); gv[13] = bfhi(g1.z); gv[14] = bflo(g1.w); gv[15] = bfhi(g1.w);
#pragma unroll
        for (int i = 0; i < 4; ++i) ow[i] = pk4_f8(hv[4 * i] * r2 * hg[16 * lane + 4 * i] * gv[4 * i] * A2_SCALE, hv[4 * i + 1] * r2 * hg[16 * lane + 4 * i + 1] * gv[4 * i + 1] * A2_SCALE, hv[4 * i + 2] * r2 * hg[16 * lane + 4 * i + 2] * gv[4 * i + 2] * A2_SCALE, hv[4 * i + 3] * r2 * hg[16 * lane + 4 * i + 3] * gv[4 * i + 3] * A2_SCALE);
        *(u32x4*)(A2 + (size_t)m * 2048 + 1024 + 16 * lane) = (u32x4){ow[0], ow[1], ow[2], ow[3]};
    }
}

constexpr int R_GM = 0, R_SH = 8192, R_LG = 16384, R_SC = 32768, R_HIST = 49152, R_BASE = 49408;
__device__ __forceinline__ void p7_router(Frame& F, int coff) {
    const int tid = F.tid, lane = F.lane, w = F.wave, r = lane & 15, g = lane >> 4;
    const bf16_t* X1 = WSP(bf16_t, WS_X1); const float* mod = WSP(float, WS_MOD); const float* n2g = F.in[I_N2G]; const float* rbias = F.in[I_RBIAS];
    unsigned char* H2 = WSP(unsigned char, WS_H2); const u32x4* WR = WSP(u32x4, WS_WR);
    int* LTOK = WSP(int, WS_LTOK); int* LDSTp = WSP(int, WS_LDST); float* LWp = WSP(float, WS_LW);
    LAS float* GM = (LAS float*)(F.lds + R_GM); LAS float* SH = (LAS float*)(F.lds + R_SH); LAS float* LG = (LAS float*)(F.lds + R_LG); LAS float* SC = (LAS float*)(F.lds + R_SC);
    LAS int* HIST = (LAS int*)(F.lds + R_HIST); LAS int* BASE = (LAS int*)(F.lds + R_BASE);
    if (F.bx == 0 && tid < 128) WSP(u32x4, WS_H2 + (size_t)T * 2048)[tid] = (u32x4){0u, 0u, 0u, 0u};
    for (int unit = F.bx; unit < T / 64; unit += F.G) {
        const int tok0 = unit * 64, b = tok0 >> 11;
        __syncthreads();
        for (int i = tid; i < 2048; i += NTHR) { GM[i] = n2g[i] * (1.f + mod[b * 12288 + 8192 + i]); SH[i] = mod[b * 12288 + 6144 + i]; }
        if (tid < 64) HIST[tid] = 0;
        __syncthreads();
        DSTAMP(F, 0);
        const bf16_t* xr8 = X1 + (size_t)(tok0 + 8 * w + (r & 7)) * 2048 + 8 * g;
        float ss = 0.f;
        const int rot = (unit * 8 + w) * 5;
#pragma unroll 16
        for (int s_ = 0; s_ < 64; ++s_) { const int s = (s_ + rot) & 63; const u32x4 t = *(const u32x4*)(xr8 + 32 * s);
            const f32x4 a = {bflo(t.x), bfhi(t.x), bflo(t.y), bfhi(t.y)}, c = {bflo(t.z), bfhi(t.z), bflo(t.w), bfhi(t.w)};
            ss += (a[0] * a[0] + a[1] * a[1]) + (a[2] * a[2] + a[3] * a[3]) + (c[0] * c[0] + c[1] * c[1]) + (c[2] * c[2] + c[3] * c[3]); }
        ss += __shfl_xor(ss, 16); ss += __shfl_xor(ss, 32);
        if (lane < 8) SC[8 * w + lane] = 1.f / sqrtf(ss * (1.f / 2048.f) + EPS);
        __syncthreads();
        const bool act = w < 4; const int row = tok0 + 16 * (w & 3) + r; const float rstd = SC[16 * (w & 3) + r];
        const bf16_t* xr = X1 + (size_t)row * 2048 + 8 * g;
        DSTAMP(F, 1);
        f32x4 acc[4];
#pragma unroll
        for (int nt = 0; nt < 4; ++nt) acc[nt] = (f32x4){0.f, 0.f, 0.f, 0.f};
        LAS u32x4* WL = (LAS u32x4*)(F.lds + 65536);
        const int rotb = unit * 5;
        u32x4 xraw[4];
#define RT_XLOAD(j, s_) do { const int s = ((s_) + rotb) & 63; xraw[j] = *(const u32x4*)(xr + 32 * s); } while (0)
#define RT_WSTAGE(buf, c_) do { _Pragma("unroll") for (int q = 0; q < 4; ++q) { const int s = ((c_) * 4 + q + rotb) & 63; \
            wst[q] = WR[(size_t)(s * 8 + w) * 64 + lane]; } } while (0)
#define RT_WWRITE(buf) do { _Pragma("unroll") for (int q = 0; q < 4; ++q) WL[((buf) * 4 + q) * 512 + w * 64 + lane] = wst[q]; } while (0)
#define RT_STEP(j, buf, q, s_) do { const int s = ((s_) + rotb) & 63; const int k0 = 32 * s + 8 * g; \
        const f32x4 g0 = *(const LAS f32x4*)(GM + k0), g1 = *(const LAS f32x4*)(GM + k0 + 4), s0 = *(const LAS f32x4*)(SH + k0), s1 = *(const LAS f32x4*)(SH + k0 + 4); \
        const f32x4 xa_ = {bflo(xraw[j].x), bfhi(xraw[j].x), bflo(xraw[j].y), bfhi(xraw[j].y)}, xc_ = {bflo(xraw[j].z), bfhi(xraw[j].z), bflo(xraw[j].w), bfhi(xraw[j].w)}; \
        const f32x4 h0 = xa_ * rstd * g0 + s0, h1 = xc_ * rstd * g1 + s1; unsigned hi[4], lo[4]; \
        _Pragma("unroll") for (int jj = 0; jj < 2; ++jj) { const unsigned p0 = f2bf(h0[2 * jj]), p1 = f2bf(h0[2 * jj + 1]); hi[jj] = p0 | (p1 << 16); lo[jj] = pk2(h0[2 * jj] - bf1((bf16_t)p0), h0[2 * jj + 1] - bf1((bf16_t)p1)); } \
        _Pragma("unroll") for (int jj = 0; jj < 2; ++jj) { const unsigned p0 = f2bf(h1[2 * jj]), p1 = f2bf(h1[2 * jj + 1]); hi[2 + jj] = p0 | (p1 << 16); lo[2 + jj] = pk2(h1[2 * jj] - bf1((bf16_t)p0), h1[2 * jj + 1] - bf1((bf16_t)p1)); } \
        const u32x4 hiw = {hi[0], hi[1], hi[2], hi[3]}, low = {lo[0], lo[1], lo[2], lo[3]}; \
        *(u32x2*)(H2 + (size_t)row * 2048 + k0) = (u32x2){pk4_f8(h0[0], h0[1], h0[2], h0[3]), pk4_f8(h1[0], h1[1], h1[2], h1[3])}; \
        const bf16x8 ah = __builtin_bit_cast(bf16x8, hiw), al = __builtin_bit_cast(bf16x8, low); \
        _Pragma("unroll") for (int nt = 0; nt < 4; ++nt) { const bf16x8 bh = __builtin_bit_cast(bf16x8, WL[((buf) * 4 + (q)) * 512 + (2 * nt) * 64 + lane]), bl = __builtin_bit_cast(bf16x8, WL[((buf) * 4 + (q)) * 512 + (2 * nt + 1) * 64 + lane]); \
            acc[nt] = __builtin_amdgcn_mfma_f32_16x16x32_bf16(ah, bh, acc[nt], 0, 0, 0); acc[nt] = __builtin_amdgcn_mfma_f32_16x16x32_bf16(al, bh, acc[nt], 0, 0, 0); acc[nt] = __builtin_amdgcn_mfma_f32_16x16x32_bf16(ah, bl, acc[nt], 0, 0, 0); } } while (0)
        u32x4 wst[4];
        RT_WSTAGE(0, 0); if (act) { RT_XLOAD(0, 0); RT_XLOAD(1, 1); RT_XLOAD(2, 2); RT_XLOAD(3, 3); }
        RT_WWRITE(0);
        __syncthreads();
#pragma nounroll
        for (int c = 0; c < 16; ++c) { const int buf = c & 1;
            if (c + 1 < 16) RT_WSTAGE(buf ^ 1, c + 1);
            if (act) {
            RT_STEP(0, buf, 0, 4 * c);     if (c + 1 < 16) RT_XLOAD(0, 4 * c + 4);
            RT_STEP(1, buf, 1, 4 * c + 1); if (c + 1 < 16) RT_XLOAD(1, 4 * c + 5);
            RT_STEP(2, buf, 2, 4 * c + 2); if (c + 1 < 16) RT_XLOAD(2, 4 * c + 6);
            RT_STEP(3, buf, 3, 4 * c + 3); if (c + 1 < 16) RT_XLOAD(3, 4 * c + 7); }
            if (c + 1 < 16) RT_WWRITE(buf ^ 1);
            asm volatile("s_waitcnt lgkmcnt(0)" ::: "memory"); __builtin_amdgcn_s_barrier(); asm volatile("" ::: "memory"); }
        __syncthreads();
#undef RT_XLOAD
#undef RT_WSTAGE
#undef RT_WWRITE
#undef RT_STEP
        DSTAMP(F, 2);
        if (act) {
#pragma unroll
            for (int nt = 0; nt < 4; ++nt)
#pragma unroll
                for (int j = 0; j < 4; ++j) LG[(w * 16 + 4 * g + j) * 64 + 16 * nt + r] = acc[nt][j]; }
        __syncthreads();
        int rk[8], lp[8]; float ww[8];
        const float rb = rbias[lane]; const float NEGI = -__builtin_inff();
#pragma unroll
        for (int tk = 0; tk < 8; ++tk) {
            const float sg = sigmoidf_(LG[(w * 8 + tk) * 64 + lane]), ch = sg + rb;
            float m1 = ch; m1 = fmaxf(m1, swz_xor<1>(m1)); m1 = fmaxf(m1, swz_xor<2>(m1)); m1 = fmaxf(m1, swz_xor<4>(m1));
            float fi = (ch == m1) ? (float)(lane & 7) : 8.f; fi = fminf(fi, swz_xor<1>(fi)); fi = fminf(fi, swz_xor<2>(fi)); fi = fminf(fi, swz_xor<4>(fi));
            float m2 = ((float)(lane & 7) == fi) ? NEGI : ch; m2 = fmaxf(m2, swz_xor<1>(m2)); m2 = fmaxf(m2, swz_xor<2>(m2)); m2 = fmaxf(m2, swz_xor<4>(m2));
            const float gs = m1 + m2; int grank = 0;
#pragma unroll
            for (int j = 0; j < 8; ++j) { const float gj = __builtin_bit_cast(float, __builtin_amdgcn_readlane(__builtin_bit_cast(int, gs), 8 * j)); grank += (gj > gs || (gj == gs && j < (lane >> 3))) ? 1 : 0; }
            const float val = (grank < 4) ? ch : NEGI; int rank = 0;
#pragma unroll
            for (int e = 0; e < 64; ++e) { const float ve = __builtin_bit_cast(float, __builtin_amdgcn_readlane(__builtin_bit_cast(int, val), e)); rank += (ve > val || (ve == val && e < lane)) ? 1 : 0; }
            const bool sel = (grank < 4) && rank < 8;
            const float wsum = wave_sum(sel ? sg : 0.f);
            rk[tk] = sel ? rank : -1; ww[tk] = sg * 2.5f / wsum; lp[tk] = 0;
            if (sel) lp[tk] = __hip_atomic_fetch_add(HIST + lane, 1, __ATOMIC_RELAXED, __HIP_MEMORY_SCOPE_WORKGROUP);
        }
        DSTAMP(F, 3);
        __syncthreads();
        if (tid < 64) BASE[tid] = (int)__hip_atomic_fetch_add(F.ctl + CW_CNT + coff + tid, (unsigned)HIST[tid], RLX_AGENT);
        __syncthreads();
        { const int bs = BASE[lane];
#pragma unroll
          for (int tk = 0; tk < 8; ++tk) if (rk[tk] >= 0) { const int tok = tok0 + 8 * w + tk; const size_t o = (size_t)lane * 16384 + bs + lp[tk]; LTOK[o] = tok; LDSTp[o] = tok * 9 + rk[tk]; LWp[o] = ww[tk]; } }
        DSTAMP(F, 4);
    }
}

struct MoeSched {
    const char* A; const char* Bt; const int* ltok; LAS const int* tab;
    int K, ncol, nexp, G, c, gather, rep;
    __device__ __forceinline__ bool next(int i, pg8::Unit& u) const {
        if (i >= 120) return false;
        LAS const int* q = tab + 256 + 4 * i; const int pm = q[0]; if (pm < 0) return false;
        u.pm = pm; u.pn = q[1]; u.e = q[2]; u.cnt = q[3]; return true;
    }
    __device__ __forceinline__ bool slow_next(int i, pg8::Unit& u) const {
        int L = i * G + c; if (G == 256) L = ((i * 8 + (c & 7)) << 5) + (c >> 3);
        const int tot = tab[160 + 65] * ncol; if (L >= tot * rep) return false; L %= tot;
        int e = 0;
#pragma unroll
        for (int st = 64; st >= 1; st >>= 1) { const int t = e + st; if (t <= 64 && tab[160 + t] * ncol <= L) e = t; }
        const int rem = L - tab[160 + e] * ncol, nb = tab[80 + e];
        u.pn = rem % ncol; u.pm = rem / ncol; u.e = e | (tab[160 + e] << 8); u.cnt = tab[e]; (void)nb; return true;
    }
    __device__ __forceinline__ const char* a_base() const { return A; }
    __device__ __forceinline__ unsigned a_off(const pg8::Unit& u, int h, int R) const {
        const int e = u.e & 255, pos = u.pm * 256 + h * 128 + R;
        if (gather) { const int tok = (e == 64) ? pos : (pos < u.cnt ? ltok[(size_t)e * 16384 + pos] : T); return (unsigned)tok * (unsigned)K; }
        return (unsigned)((u.e >> 8) * 256 + pos) * (unsigned)K;
    }
    __device__ __forceinline__ const char* b_tile(const pg8::Unit& u) const { return Bt + ((size_t)(u.e & 255) * nexp + (size_t)u.pn * 256) * K; }
};
__device__ __forceinline__ void moe_units(Frame& F, const MoeSched& S) {
    __syncthreads();
    if (F.tid < 120) { pg8::Unit u; u.pm = u.pn = u.e = u.cnt = 0; const bool ok = S.slow_next(F.tid, u); LAS int* q = (LAS int*)(F.lds + SCHED_OFF) + 256 + 4 * F.tid; q[0] = ok ? u.pm : -1; q[1] = u.pn; q[2] = u.e; q[3] = u.cnt; }
    __syncthreads();
}
__device__ __forceinline__ void moe_tables(Frame& F) {
    LAS int* tab = (LAS int*)(F.lds + SCHED_OFF);
    __syncthreads();
    if (F.tid < 65) { const int c = (F.tid < 64) ? (int)__hip_atomic_load(F.ctl + CW_CNT + F.tid, RLX_AGENT) : T; tab[F.tid] = c; tab[80 + F.tid] = (c + 255) >> 8; }
    __syncthreads();
    if (F.wave == 0) { const int lane = F.lane, nb = tab[80 + lane]; int inc = nb;
#pragma unroll
        for (int o = 1; o < 64; o <<= 1) { const int t = __shfl_up(inc, o); if (lane >= o) inc += t; }
        tab[160 + lane] = inc - nb;
        if (lane == 63) { tab[160 + 64] = inc; tab[160 + 65] = inc + tab[80 + 64]; } }
    __syncthreads();
}
struct EpiMoe1 {
    static constexpr bool PERM = true, PRE = false;
    unsigned char* act;
    __device__ __forceinline__ void operator()(const f32x4 (&acc)[2][2][4][2], const pg8::Unit& u, int wr, int wc, int fr, int fq) const {
        const int row0 = (u.e >> 8) * 256 + u.pm * 256 + wr * 64 + fr, col0 = 128 * u.pn + 16 * wc + 4 * fq;
#pragma unroll
        for (int ai = 0; ai < 2; ++ai)
#pragma unroll
            for (int m = 0; m < 4; ++m) { unsigned char* rp = act + (size_t)(row0 + ai * 128 + m * 16) * 512 + col0;
#pragma unroll
                for (int bj = 0; bj < 2; ++bj) { const f32x4 gt = acc[ai][bj][m][0] * (1.f / W1_SCALE), up = acc[ai][bj][m][1] * (ACT_SCALE / W1_SCALE); float a[4];
#pragma unroll
                    for (int i = 0; i < 4; ++i) a[i] = gt[i] * sigmoidf_(gt[i]) * up[i];
                    *(unsigned*)(rp + 64 * bj) = pk4_f8(a[0], a[1], a[2], a[3]); } }
    }
};
struct EpiMoe2 {
    static constexpr bool PERM = true, PRE = true;
    static constexpr int TAB = 133120;
    unsigned char* y; const int* ldst; const float* lw; LAS unsigned char* lds;
    __device__ __forceinline__ void pre(LAS unsigned char* l, const pg8::Unit& u, int wid) const {
        const int lane = (int)__builtin_amdgcn_mbcnt_hi(~0u, __builtin_amdgcn_mbcnt_lo(~0u, 0u));
        const unsigned* src = (const unsigned*)ldst + ((size_t)(wid >> 2) << 20) + (size_t)(u.e & 255) * 16384 + u.pm * 256 + (wid & 3) * 64 + lane;
        __builtin_amdgcn_global_load_lds(src, (LAS unsigned*)(l + TAB + u.par * 2048 + wid * 256), 4, 0, 0);
    }
    __device__ __forceinline__ void operator()(const f32x4 (&acc)[2][2][4][2], const pg8::Unit& u, int wr, int wc, int fr, int fq) const {
        const int e = u.e & 255, r0 = wr * 64 + fr, col0 = 256 * u.pn + 32 * wc + 8 * fq;
        const LAS int* tD = (const LAS int*)(lds + TAB + u.par * 2048); const LAS float* tW = (const LAS float*)(lds + TAB + u.par * 2048 + 1024);
#pragma unroll
        for (int ai = 0; ai < 2; ++ai)
#pragma unroll
            for (int m = 0; m < 4; ++m) { const int r = r0 + ai * 128 + m * 16, pos = u.pm * 256 + r; int dst; float wg;
                if (e == 64) { dst = pos * 9 + 8; wg = 1.f; } else if (pos < u.cnt) { dst = tD[r]; wg = tW[r]; } else { dst = -1; wg = 0.f; }
                if (dst >= 0) { unsigned char* rp = y + (size_t)dst * 2048 + col0;
#pragma unroll
                    for (int bj = 0; bj < 2; ++bj) { const float wq = wg * (Y_SCALE / (W2_SCALE * ACT_SCALE)); const f32x4 v0 = acc[ai][bj][m][0] * wq, v1 = acc[ai][bj][m][1] * wq;
                        *(u32x2*)(rp + 128 * bj) = (u32x2){pk4_f8(v0[0], v0[1], v0[2], v0[3]), pk4_f8(v1[0], v1[1], v1[2], v1[3])}; } } }
    }
};
static_assert(WS_LW - WS_LDST == 4 * MiB, "EpiMoe2::pre addresses lw as ldst + 2^20 words");
__device__ __forceinline__ void p11_final(Frame& F) {
    const int gw = F.bx * NWAVES + F.wave, NGW = F.G * NWAVES, lane = F.lane;
    const bf16_t* X1 = WSP(bf16_t, WS_X1); const unsigned char* Y = WSP(unsigned char, WS_Y); const float* mod = WSP(float, WS_MOD); const float* fg = F.in[I_FNG];
    LAS float* vb = (LAS float*)(F.lds + F.wave * 8192);
#pragma nounroll
    for (int m = gw; m < T; m += NGW) { const int b = m >> 11; float ss = 0.f;
        u32x2 yt[4][9]; u32x4 xq[4];
#pragma unroll
        for (int j = 0; j < 4; ++j) { const int c = 8 * lane + 512 * j;
#pragma unroll
            for (int k = 0; k < 9; ++k) yt[j][k] = *(const u32x2*)(Y + ((size_t)m * 9 + k) * 2048 + c);
            xq[j] = *(const u32x4*)(X1 + (size_t)m * 2048 + c); }
#pragma unroll
        for (int j = 0; j < 4; ++j) { const int c = 8 * lane + 512 * j; float a[8];
#pragma unroll
            for (int i = 0; i < 8; ++i) a[i] = 0.f;
#pragma unroll
            for (int k = 0; k < 9; ++k) { const u32x2 t = yt[j][k];
                const f32x2 p0 = __builtin_amdgcn_cvt_pk_f32_fp8((int)t.x, false), p1 = __builtin_amdgcn_cvt_pk_f32_fp8((int)t.x, true), p2 = __builtin_amdgcn_cvt_pk_f32_fp8((int)t.y, false), p3 = __builtin_amdgcn_cvt_pk_f32_fp8((int)t.y, true);
                a[0] += p0[0]; a[1] += p0[1]; a[2] += p1[0]; a[3] += p1[1]; a[4] += p2[0]; a[5] += p2[1]; a[6] += p3[0]; a[7] += p3[1]; }
            const u32x4 xt = xq[j]; const f32x4 x0 = {bflo(xt.x), bfhi(xt.x), bflo(xt.y), bfhi(xt.y)}, x1 = {bflo(xt.z), bfhi(xt.z), bflo(xt.w), bfhi(xt.w)};
            const f32x4 g0 = *(const f32x4*)(mod + b * 12288 + 10240 + c) * (1.f / Y_SCALE), g1 = *(const f32x4*)(mod + b * 12288 + 10240 + c + 4) * (1.f / Y_SCALE);
            const f32x4 v0 = {x0[0] + g0[0] * a[0], x0[1] + g0[1] * a[1], x0[2] + g0[2] * a[2], x0[3] + g0[3] * a[3]};
            const f32x4 v1 = {x1[0] + g1[0] * a[4], x1[1] + g1[1] * a[5], x1[2] + g1[2] * a[6], x1[3] + g1[3] * a[7]};
            ss += (v0[0] * v0[0] + v0[1] * v0[1]) + (v0[2] * v0[2] + v0[3] * v0[3]) + (v1[0] * v1[0] + v1[1] * v1[1]) + (v1[2] * v1[2] + v1[3] * v1[3]);
            *(LAS f32x4*)(vb + c) = v0; *(LAS f32x4*)(vb + c + 4) = v1; }
        const float rstd = 1.f / sqrtf(wave_sum(ss) * (1.f / 2048.f) + EPS);
#pragma nounroll
        for (int j = 0; j < 4; ++j) { const int c = 8 * lane + 512 * j;
            const f32x4 v0 = *(const LAS f32x4*)(vb + c), v1 = *(const LAS f32x4*)(vb + c + 4);
            const f32x4 f0 = *(const f32x4*)(fg + c), f1 = *(const f32x4*)(fg + c + 4);
            *(f32x4*)(F.out + (size_t)m * 2048 + c) = v0 * rstd * f0; *(f32x4*)(F.out + (size_t)m * 2048 + c + 4) = v1 * rstd * f1; }
    }
}

#define DIAG_PH 4
#define DIAG_S0 0
#define DIAG_S1 1
#if 1
#define DIAG_BH 0
#define DIAG_VSC 1.0f
#define DIAG_EMIT 0
#define DIAG_S 0
#define DIAG_VR 0
#define DIAG_CMP 2
#define DIAG_SEL (s_ == 0)
#endif
constexpr int CW_DIAG = 9000;
__device__ __forceinline__ void diag_compute(Frame& F) {
#if DIAG == 1
    const unsigned* MASK = WSP(unsigned, WS_MASK);
    for (int row = F.bx * NWAVES + F.wave; row < T; row += F.G * NWAVES) { const int q = row & 2047;
        const unsigned mw = MASK[(size_t)row * 64 + F.lane]; int c = __popc(mw);
        for (int o = 1; o < 64; o <<= 1) c += __shfl_xor(c, o);
        unsigned bad = 0; { const int k0 = F.lane * 32; for (int bb = 0; bb < 32; ++bb) if (((mw >> bb) & 1u) && (k0 + bb > q)) bad = 1; }
        bad = __any(bad) ? 1u : 0u;
        if (F.lane == 0) { atomicMax(F.ctl + CW_DIAG, (unsigned)c); if (c != (q + 1 < 256 ? q + 1 : 256)) atomicAdd(F.ctl + CW_DIAG + 1, 1u); if (bad) atomicAdd(F.ctl + CW_DIAG + 2, 1u); } }
#endif
#if DIAG == 3
    const bf16_t* A = WSP(bf16_t, WS_AO); const bf16_t* Bq = WSP(bf16_t, WS_H1);
    for (size_t i = (size_t)F.bx * NTHR + F.tid; i < (size_t)T * 1024; i += (size_t)F.G * NTHR) {
        const int d = (int)(i & 127), s_ = (int)((i >> 7) & 2047), bh = (int)(i >> 18); (void)d; (void)s_; (void)bh;
        if (!(DIAG_SEL)) continue;
        const bf16_t* Vv = WSP(bf16_t, WS_V); const float vref = DIAG_VSC * bf1(Vv[((size_t)bh * 2048 + DIAG_VR) * 128 + d]);
        const float df = (DIAG_CMP == 0) ? fabsf(bf1(A[i]) - bf1(Bq[i])) : (DIAG_CMP == 1) ? fabsf(bf1(A[i]) - vref) : fabsf(bf1(Bq[i]) - vref);
        const float bv = bf1(Bq[i]);
        atomicMax(F.ctl + CW_DIAG, (unsigned)(df * 4096.f)); if (DIAG_CMP == 3 ? (bv != bv) : DIAG_CMP == 4 ? (bv == 0.f) : (df > 0.05f)) atomicAdd(F.ctl + CW_DIAG + 1, 1u); }
#endif
#if DIAG == 4
    if (F.bx == 0 && F.wave == 0) { const bf16_t* Bq = WSP(bf16_t, WS_H1); const bf16_t* Vv = WSP(bf16_t, WS_V);
        float bv = 0.f, vv = 0.f, bb = 0.f;
        for (int d = F.lane; d < 128; d += 64) { const float x = bf1(Bq[((size_t)DIAG_BH * 2048 + DIAG_S) * 128 + d]), y = bf1(Vv[((size_t)DIAG_BH * 2048 + DIAG_VR) * 128 + d]); bv += x * y; vv += y * y; bb += x * x; }
        bv = wave_sum(bv); vv = wave_sum(vv); bb = wave_sum(bb);
        if (F.lane == 0) { F.ctl[CW_DIAG] = (unsigned)(int)(1000.f * bv / vv + 100000.f); F.ctl[CW_DIAG + 1] = (unsigned)(int)(1000.f * bb / vv); } }
#endif
#if DIAG == 2
    const unsigned* p = (const unsigned*)(F.ws + (size_t)DIAG_OFF); const size_t n = (size_t)DIAG_LEN / 4; unsigned acc = 0;
    for (size_t i = (size_t)F.bx * NTHR + F.tid; i < n; i += (size_t)F.G * NTHR) acc += p[i] * 2654435761u + (unsigned)i;
    for (int o = 1; o < 64; o <<= 1) acc += __shfl_xor(acc, o);
    if (F.lane == 0) atomicAdd(F.ctl + CW_DIAG, acc);
#endif
}
__device__ __forceinline__ void diag_emit(Frame& F) {
    if (F.bx == 0 && F.tid == 0) { const unsigned a = F.ctl[CW_DIAG], b = F.ctl[CW_DIAG + 1], c = F.ctl[CW_DIAG + 2];
        F.out[0] = (DIAG == 4) ? (float)((int)a - 100000) * (DIAG_EMIT == 0 ? 1.f : 0.f) + (float)b * (DIAG_EMIT == 1 ? 1.f : 0.f) : (DIAG_EMIT == 0 ? (float)b : (float)a * (100.f / 4096.f)) + 0.f * (float)(a + c); (void)a; (void)b; (void)c; }
}
constexpr int N_PHASES = (DIAG && DIAG != 5 && DIAG != 6) ? 14 : 12;
__global__ void __launch_bounds__(NTHR, 2) mk_fwd(Args args) {
    extern __shared__ __attribute__((aligned(16))) unsigned char lds[];
    Frame F;
    F.lds = (LAS unsigned char*)lds; F.MISC = (volatile LAS unsigned*)(F.lds + MISC_OFF);
    F.tid = threadIdx.x; F.lane = F.tid & 63; F.wave = __builtin_amdgcn_readfirstlane(F.tid >> 6);
    F.G = gridDim.x; F.bx = blockIdx.x; F.ws = args.ws; F.ctl = (unsigned*)(args.ws + WS_CTL); F.in = args.in; F.out = args.out;
    for (int u = F.tid; u < (LDS_BYTES - CTLZ_OFF) / 4; u += NTHR) ((LAS unsigned*)(F.lds + CTLZ_OFF))[u] = 0u;
    __syncthreads();
    const int lo = args.ph_lo, hi = args.ph_hi;
    XcdBarrier bar; bar.bar = F.ctl + CW_BAR; bar.x = 0; bar.st = nullptr;
    if (hi - lo > 1) bar = xcd_barrier_post(F.ctl + CW_BAR, F.MISC + 8);
#ifndef PH_MASK
#define PH_MASK 0xFFFFF
#endif
#define IN(k) (((PH_MASK >> (k)) & 1) && lo <= (k) && (k) < hi)
#define SEAM(k) do { if (IN(k) && IN((k) + 1)) xcd_barrier(bar); if (DIAG == 5 && F.bx == 0 && F.tid == 0) F.ctl[CW_DIAG + 16 + (k) + 1] = (unsigned)__builtin_amdgcn_s_memrealtime(); } while (0)
#ifndef REP_PHASE
#define REP_PHASE -1
#endif
#define REPEAT(k) (REP_PHASE == (k) && hi - lo > 1)
    if (DIAG == 5 && F.bx == 0 && F.tid == 0) F.ctl[CW_DIAG + 16] = (unsigned)__builtin_amdgcn_s_memrealtime();
    if (IN(0)) { if (F.bx == 0 && F.tid < 64) WSP(float, WS_IKGC)[F.tid] = F.in[I_IKG][F.tid];
        p0_experts(F, F.bx, F.G, 0, F.G > 128 ? EXP_ITEMS - EXP_LATE : EXP_ITEMS); p0_prologue(F); } SEAM(0);
    if (IN(1)) { p0b_mod(F); } SEAM(1);
    if (IN(2)) { p1_h1(F); if (REPEAT(2)) { xcd_barrier(bar); p1_h1(F); } } SEAM(2);
    if (IN(3)) {
        { pg8::ProjSched S{(const char*)WSP(bf16_t, WS_H1), (const char*)WSP(bf16_t, WS_WIN), 4096, 0, F.G, F.bx};
            EpiProj E{F.ws, F.in[I_LBL], 1.f}; pg8::gemm_phase<EpiProj, pg8::ProjSched, true, true, false>(F.lds, 4096, S, E); }
        __syncthreads();
        { pg8::ProjSched S{(const char*)WSP(unsigned char, WS_H1F8), (const char*)WSP(unsigned char, WS_WIN8), 2048, 1, F.G, F.bx};
            EpiProj E{F.ws, F.in[I_LBL], 1.f / (WIN_SCALE * H1_SCALE)}; pg8::gemm_phase<EpiProj, pg8::ProjSched, true, true, true>(F.lds, 2048, S, E); } } SEAM(3);
    if (IN(4)) { if (((PH_MASK >> 12) & 1) && (F.G <= 128 || F.bx >= 64)) { pg8::DenseSched S; if (F.G > 128) S.init(WSP(bf16_t, WS_CKV), WSP(bf16_t, WS_WKV), T, 2048, 512, F.G - 64, F.bx - 64); else S.init(WSP(bf16_t, WS_CKV), WSP(bf16_t, WS_WKV), T, 2048, 512, F.G, F.bx);
          EpiKV E{F.ws}; pg8::gemm_phase<EpiKV, pg8::DenseSched, true, true>(F.lds, 512, S, E); }
        __syncthreads();
        if (((PH_MASK >> 13) & 1) && F.bx < 64) { p3_hgrn(F, F.bx); }
        if ((PH_MASK >> 14) & 1) { p3_indexer(F, 0);
            if (F.G > 128) { __syncthreads(); if (F.bx >= 64) p0_experts(F, F.bx - 64, F.G - 64, EXP_ITEMS - EXP_LATE, EXP_ITEMS - EXP_LATE_H); else p0_experts(F, F.bx, 64, EXP_ITEMS - EXP_LATE_H, EXP_ITEMS); } if (REP_PHASE == 42) { xcd_barrier(bar); p3_indexer(F, 64); } } } SEAM(4);
    if (IN(5)) { if (DIAG >= 3) { p4_attn_naive(F); __syncthreads(); p4_attn_dense(F, WSP(bf16_t, WS_H1)); } else { p4_attn_dense(F, WSP(bf16_t, WS_AO)); if (REPEAT(5)) { xcd_barrier(bar); p4_attn_dense(F, WSP(bf16_t, WS_AO)); } } } SEAM(5);
    if (IN(6)) { p5_finalize(F); if (REPEAT(6)) { xcd_barrier(bar); p5_finalize(F); } } SEAM(6);
    if (IN(7)) { pg8::DenseSched S; S.init(WSP(bf16_t, WS_A2), WSP(bf16_t, WS_WOUT), T, 2048, 2048, F.G, F.bx); S.rep = (REP_PHASE == 7) ? 2 : 1;
        EpiOut E{F.in[I_X], WSP(bf16_t, WS_X1), WSP(float, WS_MOD)}; pg8::gemm_phase<EpiOut, pg8::DenseSched, true, true, true>(F.lds, 2048, S, E); } SEAM(7);
    if (IN(8)) { p7_router(F, 0); if (REPEAT(8)) { xcd_barrier(bar); p7_router(F, 128); } } SEAM(8);
    if (IN(9)) { moe_tables(F);
        MoeSched S; S.A = (const char*)WSP(bf16_t, WS_H2); S.Bt = (const char*)WSP(bf16_t, WS_W1); S.ltok = WSP(int, WS_LTOK); S.tab = (LAS const int*)(F.lds + SCHED_OFF); S.K = 2048; S.ncol = 4; S.nexp = 1024; S.G = F.G; S.c = F.bx; S.gather = 1; S.rep = (REP_PHASE == 9) ? 2 : 1; moe_units(F, S);
        EpiMoe1 E{WSP(unsigned char, WS_ACT)}; pg8::gemm_phase<EpiMoe1, MoeSched, true, true, true>(F.lds, 2048, S, E); } SEAM(9);
    if (IN(10)) { moe_tables(F);
        MoeSched S; S.A = (const char*)WSP(bf16_t, WS_ACT); S.Bt = (const char*)WSP(bf16_t, WS_W2); S.ltok = nullptr; S.tab = (LAS const int*)(F.lds + SCHED_OFF); S.K = 512; S.ncol = 8; S.nexp = 2048; S.G = F.G; S.c = F.bx; S.gather = 0; S.rep = (REP_PHASE == 10) ? 2 : 1; moe_units(F, S);
        EpiMoe2 E{WSP(unsigned char, WS_Y), WSP(int, WS_LDST), WSP(float, WS_LW), F.lds}; pg8::gemm_phase<EpiMoe2, MoeSched, true, true, true>(F.lds, 512, S, E); } SEAM(10);
    if (IN(11)) { p11_final(F); if (REPEAT(11)) { xcd_barrier(bar); p11_final(F); } }
    if (DIAG == 5) { __syncthreads(); if (F.bx == 0 && F.tid == 0) { F.ctl[CW_DIAG + 16 + 12] = (unsigned)__builtin_amdgcn_s_memrealtime();
            F.out[0] = 1000.f + (float)(F.ctl[CW_DIAG + 16 + DIAG_PH + 1] - F.ctl[CW_DIAG + 16 + DIAG_PH]) * 0.01f; } }
    if (DIAG == 6) { __syncthreads(); if (F.bx == 0 && F.tid == 0) { const float us_ = (float)(F.ctl[9100 + DIAG_S1] - F.ctl[9100 + DIAG_S0]) * 0.01f; const float q_ = us_ > 200.f ? 50.f : us_ > 60.f ? 20.f : 5.f;
            F.out[0] = 10.f * q_ * floorf(us_ / q_ + 0.5f); } }
    if (DIAG && DIAG != 5 && DIAG != 6 && lo <= 12 && 12 < hi) diag_compute(F);
    if (DIAG && DIAG != 5 && DIAG != 6 && lo <= 13 && 13 < hi) diag_emit(F);
#undef IN
#undef SEAM
}

extern "C" void kernel_launch(void* const* d_in, const int* in_sizes, int n_in, void* d_out, int out_size, void* d_ws, size_t ws_size, hipStream_t stream) {
    static int grid = 0;
    if (grid == 0) {
        if (n_in != 25 || in_sizes[0] != T * D || out_size != T * D || ws_size < WS_END) { fprintf(stderr, "kernel_launch: unexpected shapes (n_in %d, in0 %d, out %d, ws %zu < %zu)\n", n_in, n_in > 0 ? in_sizes[0] : -1, out_size, ws_size, (size_t)WS_END); grid = -1; return; }
        int dev = 0, cus = 0, per_cu = 0;
        if (hipGetDevice(&dev) != hipSuccess || hipDeviceGetAttribute(&cus, hipDeviceAttributeMultiprocessorCount, dev) != hipSuccess) { grid = -1; return; }
        if (hipFuncSetAttribute((const void*)mk_fwd, hipFuncAttributeMaxDynamicSharedMemorySize, LDS_BYTES) != hipSuccess) { fprintf(stderr, "kernel_launch: hipFuncSetAttribute failed\n"); grid = -1; return; }
        if (hipOccupancyMaxActiveBlocksPerMultiprocessor(&per_cu, (const void*)mk_fwd, NTHR, LDS_BYTES) != hipSuccess || per_cu < 1) { fprintf(stderr, "kernel_launch: occupancy query says %d\n", per_cu); }
        (void)hipGetLastError();
        grid = cus;
    }
    if (grid < 0) return;
    (void)hipMemsetAsync((char*)d_ws + WS_CTL, 0, CTL_ZERO_BYTES, stream);
    Args a{};
    for (int i = 0; i < 25; ++i) a.in[i] = (const float*)d_in[i];
    a.out = (float*)d_out; a.ws = (unsigned char*)d_ws;
    constexpr int NL = (DIAG && DIAG != 5 && DIAG != 6) ? 14 : MK_N_LAUNCHES;
    for (int li = 0; li < NL; ++li) {
        a.ph_lo = li * N_PHASES / NL; a.ph_hi = (li + 1) * N_PHASES / NL;
        hipLaunchKernelGGL(mk_fwd, dim3(grid), dim3(NTHR), LDS_BYTES, stream, a);
    }
}
```

```cpp
#include <hip/hip_runtime.h>
#include <cstdio>
#include <cstdint>

#define NOBIAS 0
#define QREG 0
#define NOSEL 0
#ifndef MK_N_LAUNCHES
#define MK_N_LAUNCHES 1
#endif

#ifndef DIAG
#define DIAG 0
#endif
#define DSTAMP(F, i) do { if (DIAG == 6 && (F).bx == 0 && (F).tid == 0) (F).ctl[9100 + (i)] = (unsigned)__builtin_amdgcn_s_memrealtime(); } while (0)
#define GAS __attribute__((address_space(1)))
#define LAS __attribute__((address_space(3)))
typedef unsigned short bf16_t;
typedef short bf16x8 __attribute__((ext_vector_type(8)));
typedef short s16x4 __attribute__((ext_vector_type(4)));
typedef float f32x4 __attribute__((ext_vector_type(4)));
typedef float f32x2 __attribute__((ext_vector_type(2)));
typedef float f32x16 __attribute__((ext_vector_type(16)));
typedef unsigned u32x4 __attribute__((ext_vector_type(4)));
typedef unsigned u32x2 __attribute__((ext_vector_type(2)));

constexpr int NB = 8, SEQ = 2048, T = NB * SEQ, D = 2048;
constexpr int NH = 8, HD = 128, CKV = 256, IH = 16, IDIM = 64, TOPK = 256;
constexpr int NPROJ = 6656;
constexpr int NE = 64, DE = 512, KSEL = 8, NSLOT = 9;
constexpr float EPS = 1e-6f;
constexpr float ATT_SCALE = 0.08838834764831845f;
constexpr float W1_SCALE = 64.f, W2_SCALE = 32.f, ACT_SCALE = 4.f, Y_SCALE = 8.f, WO_SCALE = 64.f, A2_SCALE = 4.f, WIN_SCALE = 64.f, H1_SCALE = 4.f;

constexpr size_t MiB = 1u << 20;
constexpr size_t WS_CTL = 0, CTL_ZERO_BYTES = 1 * MiB;
constexpr size_t WS_MOD = 1 * MiB;
constexpr size_t WS_CKVSS = 2 * MiB;
constexpr size_t WS_WR = 3 * MiB;
constexpr size_t WS_LTOK = 4 * MiB, WS_LDST = 8 * MiB, WS_LW = 12 * MiB;
constexpr size_t WS_MODP = 324 * MiB;
constexpr size_t WS_IKSS = 16 * MiB;
constexpr size_t WS_IKGC = 17 * MiB;
constexpr size_t WS_W2 = 32 * MiB;
constexpr size_t WS_X1 = 162 * MiB;
constexpr size_t WS_WIN = 162 * MiB;
constexpr size_t WS_WKV = 188 * MiB;
constexpr size_t WS_H1 = 190 * MiB;
constexpr size_t WS_H1F8 = 254 * MiB;
constexpr size_t WS_WIN8 = 290 * MiB;
constexpr size_t WS_ACT = 290 * MiB;
constexpr size_t WS_K = 290 * MiB, WS_V = 322 * MiB;
constexpr size_t WS_AO = 354 * MiB;
constexpr size_t WS_HO = 386 * MiB;
constexpr size_t WS_A2 = 290 * MiB;
constexpr size_t WS_Y = 450 * MiB;
constexpr size_t WS_W1 = 450 * MiB;
constexpr size_t WS_QA = 710 * MiB;
constexpr size_t WS_CKV = 742 * MiB;
constexpr size_t WS_IQ = 750 * MiB;
constexpr size_t WS_QB = 782 * MiB;
constexpr size_t WS_LOGF = 814 * MiB;
constexpr size_t WS_KB = 878 * MiB;
constexpr size_t WS_IB = 910 * MiB;
constexpr size_t WS_GB = 942 * MiB;
constexpr size_t WS_IK = 974 * MiB;
constexpr size_t WS_IW = 976 * MiB;
constexpr size_t WS_MASK = 977 * MiB;
constexpr size_t WS_WOUT = 981 * MiB;
constexpr size_t WS_H2 = 710 * MiB;
constexpr size_t WS_END = 1026 * MiB;
constexpr int CW_TMO = 0, CW_BAR = 4096, CW_CNT = 8192  , CW_IDXQ = 8448  ;

constexpr int RING_BYTES = 131072, LDS_BYTES = 163840, CTLZ_OFF = LDS_BYTES - 4096, MISC_OFF = CTLZ_OFF + 320;
constexpr int SCHED_OFF = CTLZ_OFF + 1024;

#define RLX_AGENT __ATOMIC_RELAXED, __HIP_MEMORY_SCOPE_AGENT
#define LDS_WAIT() asm volatile("s_waitcnt lgkmcnt(0)" ::: "memory")
#define VM_WAIT() asm volatile("s_waitcnt vmcnt(0)" ::: "memory")

__device__ __forceinline__ unsigned f2bf(float f) { unsigned u = __builtin_bit_cast(unsigned, f); return (u + 0x7fffu + ((u >> 16) & 1u)) >> 16; }
typedef __bf16 bf16x2_t __attribute__((ext_vector_type(2)));
__device__ __forceinline__ unsigned pk2(float lo, float hi) { const f32x2 v = {lo, hi}; const bf16x2_t b = __builtin_convertvector(v, bf16x2_t); return __builtin_bit_cast(unsigned, b); }
__device__ __forceinline__ unsigned pk4_f8(float a, float b, float c, float d) {
    a = __builtin_amdgcn_fmed3f(a, -448.f, 448.f); b = __builtin_amdgcn_fmed3f(b, -448.f, 448.f); c = __builtin_amdgcn_fmed3f(c, -448.f, 448.f); d = __builtin_amdgcn_fmed3f(d, -448.f, 448.f);
    int w = 0; w = __builtin_amdgcn_cvt_pk_fp8_f32(a, b, w, false); w = __builtin_amdgcn_cvt_pk_fp8_f32(c, d, w, true); return (unsigned)w; }
__device__ __forceinline__ float bflo(unsigned w) { return __builtin_bit_cast(float, w << 16); }
__device__ __forceinline__ float bfhi(unsigned w) { return __builtin_bit_cast(float, w & 0xffff0000u); }
__device__ __forceinline__ float bf1(bf16_t h) { return __builtin_bit_cast(float, ((unsigned)h) << 16); }
__device__ __forceinline__ float sigmoidf_(float x) { return 1.f / (1.f + __expf(-x)); }
template <int LN> __device__ __forceinline__ void wlane(int& vd, int sval) { asm volatile("s_nop 4\n\tv_writelane_b32 %0, %1, %2" : "+v"(vd) : "s"(sval), "n"(LN));   }
template <int XM> __device__ __forceinline__ float swz_xor(float v) { return __builtin_bit_cast(float, __builtin_amdgcn_ds_swizzle(__builtin_bit_cast(int, v), (XM << 10) | 0x1f)); }
__device__ __forceinline__ float wave_sum(float v) {
    v += swz_xor<1>(v); v += swz_xor<2>(v); v += swz_xor<4>(v); v += swz_xor<8>(v); v += swz_xor<16>(v);
    return __builtin_bit_cast(float, __builtin_amdgcn_readlane(__builtin_bit_cast(int, v), 0)) + __builtin_bit_cast(float, __builtin_amdgcn_readlane(__builtin_bit_cast(int, v), 32));
}
__device__ __forceinline__ int opaque(int x) { asm volatile("" : "+v"(x)); return x; }

#define XB_TMO      128
#define XB_XCNT(j)  (256  + 64 * (j))
#define XB_XSUB(j)  (1280 + 64 * (j))
#define XB_XGEN(j)  (2304 + 64 * (j))
#define XB_TOP      3328
#define XB_TOPGEN   3392
#define XCD_BAR_WORDS 3456
#define XB_SPIN_CAP (1u << 20)
__device__ __forceinline__ unsigned xb_ld(unsigned* p)              { return __hip_atomic_load(p, __ATOMIC_RELAXED, __HIP_MEMORY_SCOPE_AGENT); }
__device__ __forceinline__ unsigned xb_add(unsigned* p, unsigned v) { return __hip_atomic_fetch_add(p, v, __ATOMIC_RELAXED, __HIP_MEMORY_SCOPE_AGENT); }
__device__ __forceinline__ unsigned xb_xcc_id() { return (unsigned)__builtin_amdgcn_s_getreg((3 << 11) | 20) & 0xFu; }
#define XB_SPIN(cond, bar) do { unsigned _sp = 0; while (cond) { __builtin_amdgcn_s_sleep(1); \
    if ((++_sp & 255u) == 0u) { if (xb_ld(&(bar)[XB_TMO])) break; if (_sp > XB_SPIN_CAP) { atomicAdd(&(bar)[XB_TMO], 1u); break; } } } } while (0)
struct XcdBarrier { unsigned* bar; unsigned x; volatile LAS unsigned* st; };
__device__ __forceinline__ XcdBarrier xcd_barrier_post(unsigned* bar, volatile LAS unsigned* st) {
    XcdBarrier b; b.bar = bar; b.x = xb_xcc_id(); b.st = st;
    if (threadIdx.x == 0) (void)xb_add(&bar[XB_XCNT(b.x)], 1u);
    return b;
}
__device__ __forceinline__ void xcd_barrier_complete(unsigned* bar, unsigned x, unsigned& nloc, unsigned& nx) {
    const unsigned G = gridDim.x * gridDim.y * gridDim.z;
    unsigned sum, cnt, mine, sp = 0u;
    for (;;) {
        sum = 0u; cnt = 0u; mine = 0u;
#pragma unroll
        for (unsigned j = 0; j < 16; ++j) { const unsigned c = xb_ld(&bar[XB_XCNT(j)]); sum += c; cnt += (c > 0u) ? 1u : 0u; mine = (j == x) ? c : mine; }
        if (sum == G) break;
        __builtin_amdgcn_s_sleep(1);
        if ((++sp & 255u) == 0u) { if (xb_ld(&bar[XB_TMO])) break; if (sp > XB_SPIN_CAP) { atomicAdd(&bar[XB_TMO], 1u); break; } }
    }
    nloc = mine > 0u ? mine : 1u; nx = cnt > 0u ? cnt : 1u;
}
__device__ __forceinline__ void xcd_barrier(const XcdBarrier& b) {
    asm volatile("s_waitcnt vmcnt(0)" ::: "memory");
    __syncthreads();
    if (threadIdx.x == 0) {
        unsigned* bar = b.bar;
        __builtin_amdgcn_s_waitcnt(0);
        unsigned nloc = b.st[0], nx = b.st[1];
        if (nloc == 0u) { xcd_barrier_complete(bar, b.x, nloc, nx); b.st[0] = nloc; b.st[1] = nx; }
        const unsigned old = xb_add(&bar[XB_XSUB(b.x)], 1u);
        const unsigned gen = old / nloc;
        if (old + 1u == (gen + 1u) * nloc) {
            __builtin_amdgcn_fence(__ATOMIC_RELEASE, "agent");
            asm volatile("s_waitcnt vmcnt(0)" ::: "memory");
            const unsigned og = xb_add(&bar[XB_TOP], 1u);
            const unsigned tg = og / nx;
            if (og + 1u == (tg + 1u) * nx) xb_add(&bar[XB_TOPGEN], 1u);
            else XB_SPIN(xb_ld(&bar[XB_TOPGEN]) == tg, bar);
            __builtin_amdgcn_fence(__ATOMIC_ACQUIRE, "agent");
            xb_add(&bar[XB_XGEN(b.x)], 1u);
            asm volatile("s_waitcnt vmcnt(0)" ::: "memory");
        } else {
            XB_SPIN(xb_ld(&bar[XB_XGEN(b.x)]) == gen, bar);
            __builtin_amdgcn_fence(__ATOMIC_ACQUIRE, "agent");
            asm volatile("s_waitcnt vmcnt(0)" ::: "memory");
        }
    }
    __syncthreads();
}

namespace pg8 {
constexpr int BM = 256, BK = 64, HALF = 128, HTB = HALF * BK * 2, STAGE_BYTES = 8 * HTB, NXCD = 8, WGM = 8;
__host__ __device__ __forceinline__ int lds_byte(int r, int c) { const int st = (r >> 4) * 2 + (c >> 5), rr = r & 15, cc = c & 31, ob = rr * 64 + cc * 2; return st * 1024 + (ob ^ (((ob >> 9) & 1) << 5)); }
__host__ __device__ __forceinline__ void stage_rc(int b, int& R, int& C) { const int st = b / 1024, sb = b % 1024, swz = sb ^ (((sb >> 9) & 1) << 5); R = (st >> 1) * 16 + swz / 64; C = (st & 1) * 32 + (swz % 64) / 2; }
__host__ __device__ __forceinline__ int perm32(int rho) { const int n = rho >> 4, i = rho & 15; return 8 * (i >> 2) + 4 * n + (i & 3); }

struct Unit { int pm, pn, e, cnt, par; };

struct DenseSched {
    const char* A; const char* Bt; int nM, nN, nwg, G, c, K, rep;
    __device__ __forceinline__ void init(const void* A_, const void* Bt_, int M, int N, int K_, int G_, int c_) { rep = 1; A = (const char*)A_; Bt = (const char*)Bt_; nM = M / BM; nN = N / BM; nwg = nM * nN; G = G_; c = c_; K = K_; }
    __device__ __forceinline__ bool next(int i, Unit& u) const {
        long L = (long)i * G + c; if (L >= (long)nwg * rep) return false; L %= nwg;
        int wgid = (int)L; { const int q = nwg / NXCD, r = nwg % NXCD, xcd = wgid % NXCD, off = wgid / NXCD; wgid = (xcd < r ? xcd * (q + 1) : r * (q + 1) + (xcd - r) * q) + off; }
        const int nig = WGM * nN, gid = wgid / nig, fm = gid * WGM, gsz = (nM - fm) < WGM ? (nM - fm) : WGM;
        u.pm = fm + ((wgid % nig) % gsz); u.pn = (wgid % nig) / gsz; u.e = 0; u.cnt = 0; return true;
    }
    __device__ __forceinline__ const char* a_base() const { return A; }
    __device__ __forceinline__ unsigned a_off(const Unit& u, int h, int R) const { return (unsigned)(u.pm * BM + h * HALF + R) * (unsigned)K; }
    __device__ __forceinline__ const char* b_tile(const Unit& u) const { return Bt + (size_t)u.pn * BM * K; }
};

struct ProjSched {
    const char* A; const char* Bt; int K, mode, G, c;
    __device__ __forceinline__ bool next(int i, Unit& u) const {
        int L;
        if (mode == 0) { L = i * G + c; if (L >= 640) return false; u.pm = L / 10; const int pt = L % 10; u.pn = (pt < 5) ? 4 + pt : (pt == 9 ? 25 : 8 + pt); }
        else { if (G == 256) { if (c < 128) { if (i >= 3) return false; L = 3 * c + i; } else { if (i >= 5) return false; L = 384 + 5 * (c - 128) + i; } } else { L = i * G + c; if (L >= 1024) return false; }
            u.pm = L / 16; const int pt = L % 16; u.pn = (pt < 4) ? pt : (pt < 8 ? pt + 5 : pt + 9); }
        u.e = 0; u.cnt = 0; return true;
    }
    __device__ __forceinline__ const char* a_base() const { return A; }
    __device__ __forceinline__ unsigned a_off(const Unit& u, int h, int R) const { return (unsigned)(u.pm * BM + h * HALF + R) * (unsigned)K; }
    __device__ __forceinline__ const char* b_tile(const Unit& u) const { return Bt + (size_t)u.pn * BM * K; }
};
typedef int i32x8 __attribute__((ext_vector_type(8)));
template <class Epi, class Sched, bool ALIGN_EPI, bool SP2, bool F8 = false>
__device__ __forceinline__ void gemm_phase(LAS unsigned char* lds, const int KB, const Sched& S, const Epi& E) {
    const int tid = threadIdx.x, wid = __builtin_amdgcn_readfirstlane(tid >> 6), lane = tid & 63, wr = wid >> 2, wc = wid & 3, fr = lane & 15, fq = lane >> 4;
    const int nt = KB / (BK * 2);
    int Rr[2], Cc[2]; unsigned voffB[2];
#pragma unroll
    for (int i = 0; i < 2; ++i) { int R, C; stage_rc(tid * 16 + i * 8192, R, C); const int Rb = Epi::PERM ? ((R & ~31) + perm32(R & 31)) : R;
        Rr[i] = R; Cc[i] = C * 2; voffB[i] = (unsigned)(Rb * KB + C * 2); }
    const size_t kstep = (size_t)(BK * 2);
    const size_t hstep = (size_t)HALF * KB;
    const unsigned ldsw = (unsigned)wid * 1024u;
    const int aoff = lds_byte(wr * 64 + fr, fq * 8), boff = lds_byte(wc * 32 + fr, fq * 8);
    constexpr int aof1 = 1024, bof1 = aof1;
    const int f8one = 0x7F7F7F7F;
#define PG8_SA(b, h) (((b) * 2 + (h)) * HTB)
#define PG8_SB(b, h) ((4 + (b) * 2 + (h)) * HTB)
#define PG8_STAGE2(bufoff, gbase, v0, v1) do { \
        __builtin_amdgcn_global_load_lds((const unsigned*)((const char*)(gbase) + (v0)), (LAS unsigned*)(lds + (bufoff) + ldsw), 16, 0, 0); \
        __builtin_amdgcn_global_load_lds((const unsigned*)((const char*)(gbase) + (v1)), (LAS unsigned*)(lds + (bufoff) + ldsw + 8192), 16, 0, 0); } while (0)
#define PG8_STAGEB(bufoff, gbase) PG8_STAGE2(bufoff, gbase, voffB[0], voffB[1])
#define PG8_LDA(dst, b, h) do { _Pragma("unroll") for (int m = 0; m < 4; ++m) _Pragma("unroll") for (int k = 0; k < 2; ++k) dst[m][k] = *(const LAS bf16x8*)(lds + PG8_SA(b, h) + aoff + m * 2048 + k * aof1); } while (0)
#define PG8_LDB(dst, b, h) do { _Pragma("unroll") for (int n = 0; n < 2; ++n) _Pragma("unroll") for (int k = 0; k < 2; ++k) dst[n][k] = *(const LAS bf16x8*)(lds + PG8_SB(b, h) + boff + n * 2048 + k * bof1); } while (0)
#define PG8_CAT(X) __builtin_bit_cast(i32x8, __builtin_shufflevector(X[0], X[1], 0, 1, 2, 3, 4, 5, 6, 7, 8, 9, 10, 11, 12, 13, 14, 15))
#define PG8_MMA(ai, bj, At, Bt) do { __builtin_amdgcn_s_setprio(1); _Pragma("unroll") for (int m = 0; m < 4; ++m) _Pragma("unroll") for (int n = 0; n < 2; ++n) { \
        if constexpr (F8) { asm volatile("v_mfma_scale_f32_16x16x128_f8f6f4 %0, %1, %2, %0, %3, %3 op_sel_hi:[0,0,0]" : "+v"(acc[ai][bj][m][n]) : "v"(PG8_CAT(Bt[n])), "v"(PG8_CAT(At[m])), "v"(f8one)); } \
          \
        else { _Pragma("unroll") for (int k = 0; k < 2; ++k) acc[ai][bj][m][n] = __builtin_amdgcn_mfma_f32_16x16x32_bf16(Bt[n][k], At[m][k], acc[ai][bj][m][n], 0, 0, 0); } } \
        __builtin_amdgcn_s_setprio(0); } while (0)
#define PG8_WAIT_V(n) asm volatile("s_waitcnt vmcnt(" #n ")" ::: "memory")
#define PG8_WAIT_L(n) asm volatile("s_waitcnt lgkmcnt(" #n ")" ::: "memory")
#define PG8_BAR __builtin_amdgcn_s_barrier()
#define PG8_SCHED __builtin_amdgcn_sched_barrier(0)
    Unit cur, nxt; int ui = 0;
    if (!S.next(0, cur)) return;
    cur.par = 0;
    f32x4 acc[2][2][4][2];
#pragma unroll
    for (int a = 0; a < 2; ++a)
#pragma unroll
        for (int b = 0; b < 2; ++b)
#pragma unroll
            for (int m = 0; m < 4; ++m)
#pragma unroll
                for (int n = 0; n < 2; ++n) acc[a][b][m][n] = (f32x4){0.f, 0.f, 0.f, 0.f};
    bf16x8 At[4][2], B0[2][2], B1[2][2];
    const char* const A0 = S.a_base();
    const char* cB = S.b_tile(cur);
    unsigned c00 = S.a_off(cur, 0, Rr[0]) + Cc[0], c01 = S.a_off(cur, 0, Rr[1]) + Cc[1], c10 = S.a_off(cur, 1, Rr[0]) + Cc[0], c11 = S.a_off(cur, 1, Rr[1]) + Cc[1];
    if constexpr (Epi::PRE) E.pre(lds, cur, wid);
    PG8_STAGEB(PG8_SB(0, 0), cB); PG8_STAGEB(PG8_SB(0, 1), cB + hstep); PG8_STAGE2(PG8_SA(0, 0), A0, c00, c01); PG8_STAGE2(PG8_SA(0, 1), A0, c10, c11);
    if (wr == 1) PG8_BAR;
    PG8_WAIT_V(2); PG8_BAR;
    PG8_STAGEB(PG8_SB(1, 0), cB + kstep); PG8_STAGE2(PG8_SA(1, 0), A0 + kstep, c00, c01); PG8_STAGEB(PG8_SB(1, 1), cB + hstep + kstep);
    PG8_WAIT_V(6); PG8_BAR;
    for (;;) {
        const bool has_next = S.next(ui + 1, nxt);
        nxt.par = (ui + 1) & 1;
        if (!has_next) nxt = cur;
        const char* nB = has_next ? S.b_tile(nxt) : cB;
        unsigned n00 = c00, n01 = c01, n10 = c10, n11 = c11;
        if (has_next) { n00 = S.a_off(nxt, 0, Rr[0]) + Cc[0]; n01 = S.a_off(nxt, 0, Rr[1]) + Cc[1]; n10 = S.a_off(nxt, 1, Rr[0]) + Cc[0]; n11 = S.a_off(nxt, 1, Rr[1]) + Cc[1]; }
#pragma nounroll
        for (int t = 0; t < nt; t += 2) {
            const bool last = (t == nt - 2);
            const char* a1 = A0 + (size_t)(t + 1) * kstep;
            const char* a2 = last ? A0 : A0 + (size_t)(t + 2) * kstep; const char* b2 = last ? nB : cB + (size_t)(t + 2) * kstep;
            const char* a3 = a2 + kstep; const char* b3 = b2 + kstep;
            unsigned x00 = c00, x01 = c01, x10 = c10, x11 = c11;
            if (last) { x00 = n00; x01 = n01; x10 = n10; x11 = n11; }
            PG8_LDB(B0, 0, 0); PG8_LDB(B1, 0, 1); PG8_SCHED; PG8_LDA(At, 0, 0); PG8_STAGE2(PG8_SA(1, 1), a1, c10, c11);
            PG8_WAIT_V(8); PG8_WAIT_L(0); PG8_BAR; PG8_MMA(0, 0, At, B0); PG8_MMA(0, 1, At, B1); PG8_BAR; PG8_SCHED;
            PG8_LDA(At, 0, 1); PG8_STAGEB(PG8_SB(0, 0), b2); PG8_STAGEB(PG8_SB(0, 1), b2 + hstep); PG8_STAGE2(PG8_SA(0, 0), a2, x00, x01);
            PG8_WAIT_V(8); PG8_WAIT_L(0); PG8_BAR; PG8_MMA(1, 0, At, B0); PG8_MMA(1, 1, At, B1); PG8_BAR; PG8_SCHED;
            PG8_LDB(B0, 1, 0); PG8_LDB(B1, 1, 1); PG8_SCHED; PG8_LDA(At, 1, 0); PG8_STAGE2(PG8_SA(0, 1), a2, x10, x11);
            PG8_WAIT_V(8); PG8_WAIT_L(0); PG8_BAR; PG8_MMA(0, 0, At, B0); PG8_MMA(0, 1, At, B1); PG8_BAR; PG8_SCHED;
            PG8_LDA(At, 1, 1); PG8_STAGEB(PG8_SB(1, 0), b3); PG8_STAGEB(PG8_SB(1, 1), b3 + hstep); PG8_STAGE2(PG8_SA(1, 0), a3, x00, x01);
            PG8_WAIT_V(8); PG8_WAIT_L(0); PG8_BAR; PG8_MMA(1, 0, At, B0); PG8_MMA(1, 1, At, B1); PG8_BAR; PG8_SCHED;
        }
        if constexpr (ALIGN_EPI) { if (wr == 0) PG8_BAR; }
        if constexpr (F8) asm volatile("s_nop 15\n\ts_nop 15" ::: "memory");
        E(acc, cur, wr, wc, opaque(fr), opaque(fq));
        if (!has_next) break;
#pragma unroll
        for (int a = 0; a < 2; ++a)
#pragma unroll
            for (int b = 0; b < 2; ++b)
#pragma unroll
                for (int m = 0; m < 4; ++m)
#pragma unroll
                    for (int n = 0; n < 2; ++n) acc[a][b][m][n] = (f32x4){0.f, 0.f, 0.f, 0.f};
        cur = nxt; cB = nB; c00 = n00; c01 = n01; c10 = n10; c11 = n11; ++ui;
        if constexpr (Epi::PRE) E.pre(lds, cur, wid);
        if constexpr (ALIGN_EPI) { if (wr == 1) PG8_BAR; }
    }
    PG8_WAIT_V(0);
    if constexpr (!ALIGN_EPI) { if (wr == 0) PG8_BAR; }
    PG8_BAR;
#undef PG8_SA
#undef PG8_SB
#undef PG8_STAGE2
#undef PG8_STAGEB
#undef PG8_LDA
#undef PG8_LDB
#undef PG8_MMA
#undef PG8_CAT
#undef PG8_WAIT_V
#undef PG8_WAIT_L
#undef PG8_BAR
#undef PG8_SCHED
}
}

struct Args { const float* in[25]; float* out; unsigned char* ws; int ph_lo, ph_hi; };
constexpr int NWAVES = 8, NTHR = 512;
struct Frame {
    LAS unsigned char* lds;
    volatile LAS unsigned* MISC;
    unsigned* ctl;
    unsigned char* ws;
    const float* const* in;
    float* out;
    int tid, lane, wave, G, bx;
};
enum { I_X = 0, I_C, I_WADA, I_BADA, I_N1G, I_WIN, I_CKVG, I_IKG, I_WUK, I_WUV, I_RELB, I_LBL, I_AOG, I_HOG, I_WOUT, I_N2G, I_WROUT, I_RBIAS, I_EG, I_EU, I_ED, I_SG, I_SU, I_SD, I_FNG };
#define WSP(T_, off) ((T_*)(F.ws + (off)))

struct SrcWin { const float* W; __device__ __forceinline__ float operator()(int k, int p) const {
    int o; if (p < 2304) o = p; else if (p < 6400) o = p + 80; else if (p < 6480) o = p - 4096; else return 0.f;
    return W[(size_t)k * 6480 + o]; } };
struct SrcPlain { const float* W; int N; __device__ __forceinline__ float operator()(int k, int n) const { return W[(size_t)k * N + n]; } };
struct SrcWkv { const float* W; const float* g; __device__ __forceinline__ float operator()(int k, int n) const { return W[(size_t)k * 128 + n] * g[k]; } };
struct SrcW1 { const float* Wg; const float* Wu; __device__ __forceinline__ float operator()(int k, int n) const {
    const int j = (n >> 3) * 4 + (n & 3); const unsigned long long a = (unsigned long long)Wg, bb = (unsigned long long)Wu, msk = 0ull - (unsigned long long)((n >> 2) & 1);
    const float* p = (const float*)(a ^ ((a ^ bb) & msk)); return p[(size_t)k * 512 + j]; } };
template <class Src> __device__ __forceinline__ void p0_tr_item(const Src& src, int K, int nblk, bf16_t* WT, int row_off, LAS float* scr, int item, int lane) {
    const int kb = item / nblk, nb = item % nblk, k0 = 64 * kb, n0 = 32 * nb;
    float tv[32];
#pragma unroll
    for (int i = 0; i < 32; ++i) tv[i] = src(k0 + 2 * i + (lane >> 5), n0 + (lane & 31));
#pragma unroll
    for (int i = 0; i < 32; ++i) scr[(2 * i + (lane >> 5)) * 33 + (lane & 31)] = tv[i];
    LDS_WAIT(); asm volatile("" ::: "memory");
    const int c = lane & 7;
#pragma unroll
    for (int j = 0; j < 4; ++j) { const int n = (lane >> 3) + 8 * j; const LAS float* s = scr + (8 * c) * 33 + n;
        u32x4 o; o.x = pk2(s[0 * 33], s[1 * 33]); o.y = pk2(s[2 * 33], s[3 * 33]); o.z = pk2(s[4 * 33], s[5 * 33]); o.w = pk2(s[6 * 33], s[7 * 33]);
        *(u32x4*)(WT + (size_t)(row_off + n0 + n) * K + k0 + 8 * c) = o; }
    LDS_WAIT(); asm volatile("" ::: "memory");
}
template <class Src> __device__ __forceinline__ void p0_tr_item_both(const Src& src, int K, int nblk, bf16_t* WT, unsigned char* WT8, float sc, LAS float* scr, int item, int lane) {
    const int kb = item / nblk, nb = item % nblk, k0 = 64 * kb, n0 = 32 * nb;
    float tv[32];
#pragma unroll
    for (int i = 0; i < 32; ++i) tv[i] = src(k0 + 2 * i + (lane >> 5), n0 + (lane & 31));
#pragma unroll
    for (int i = 0; i < 32; ++i) scr[(2 * i + (lane >> 5)) * 33 + (lane & 31)] = tv[i];
    LDS_WAIT(); asm volatile("" ::: "memory");
    const int c = lane & 7;
#pragma unroll
    for (int j = 0; j < 4; ++j) { const int n = (lane >> 3) + 8 * j; const LAS float* s = scr + (8 * c) * 33 + n;
        const float v0 = s[0 * 33], v1 = s[1 * 33], v2 = s[2 * 33], v3 = s[3 * 33], v4 = s[4 * 33], v5 = s[5 * 33], v6 = s[6 * 33], v7 = s[7 * 33];
        *(u32x4*)(WT + (size_t)(n0 + n) * K + k0 + 8 * c) = (u32x4){pk2(v0, v1), pk2(v2, v3), pk2(v4, v5), pk2(v6, v7)};
        *(u32x2*)(WT8 + (size_t)(n0 + n) * K + k0 + 8 * c) = (u32x2){pk4_f8(v0 * sc, v1 * sc, v2 * sc, v3 * sc), pk4_f8(v4 * sc, v5 * sc, v6 * sc, v7 * sc)}; }
    LDS_WAIT(); asm volatile("" ::: "memory");
}
template <class Src> __device__ __forceinline__ void p0_tr_item_f8(const Src& src, int K, int nblk, unsigned char* WT, float sc, LAS float* scr, int item, int lane) {
    const int kb = item / nblk, nb = item % nblk, k0 = 64 * kb, n0 = 32 * nb;
    float tv[32];
#pragma unroll
    for (int i = 0; i < 32; ++i) tv[i] = src(k0 + 2 * i + (lane >> 5), n0 + (lane & 31));
#pragma unroll
    for (int i = 0; i < 32; ++i) scr[(2 * i + (lane >> 5)) * 33 + (lane & 31)] = tv[i] * sc;
    LDS_WAIT(); asm volatile("" ::: "memory");
    const int c = lane & 7;
#pragma unroll
    for (int j = 0; j < 4; ++j) { const int n = (lane >> 3) + 8 * j; const LAS float* s = scr + (8 * c) * 33 + n;
        *(u32x2*)(WT + (size_t)(n0 + n) * K + k0 + 8 * c) = (u32x2){pk4_f8(s[0 * 33], s[1 * 33], s[2 * 33], s[3 * 33]), pk4_f8(s[4 * 33], s[5 * 33], s[6 * 33], s[7 * 33])}; }
    LDS_WAIT(); asm volatile("" ::: "memory");
}
constexpr int EXP_ITEMS = 65 * 512 + 65 * 256, EXP_LATE = 31000, EXP_LATE_H = 3328;
constexpr int NCONV = 48;
struct ExpItem { const float* Wg; const float* Wu; unsigned char* WT; int K, nblk, item, kind; float sc; };
__device__ __forceinline__ bool exp_item(Frame& F, int it, ExpItem& x) {
    constexpr int I_W1 = 65 * 512, I_W2 = 65 * 256;
    if (it >= I_W1 + I_W2) return false;
    if (it < I_W1) { const int e = it >> 9; x.item = it & 511; x.kind = 0; x.K = 2048; x.nblk = 16; x.sc = W1_SCALE; x.WT = WSP(unsigned char, WS_W1) + (size_t)e * 1024 * 2048;
        if (e < 64) { x.Wg = F.in[I_EG] + (size_t)e * 2048 * 512; x.Wu = F.in[I_EU] + (size_t)e * 2048 * 512; } else { x.Wg = F.in[I_SG]; x.Wu = F.in[I_SU]; } }
    else { const int r = it - I_W1, e = r >> 8; x.item = r & 255; x.kind = 1; x.K = 512; x.nblk = 32; x.sc = W2_SCALE; x.WT = WSP(unsigned char, WS_W2) + (size_t)e * 2048 * 512;
        x.Wg = (e < 64) ? F.in[I_ED] + (size_t)e * 512 * 2048 : F.in[I_SD]; x.Wu = x.Wg; }
    return true;
}
__device__ __forceinline__ void exp_load(const ExpItem& x, float (&tv)[64], int lane) {
    const int kb = x.item / x.nblk, nb = x.item % x.nblk, k0 = 64 * kb, n = 64 * nb + lane;
    const float* p; size_t pitch;
    if (x.kind == 0) { const int j = (n >> 3) * 4 + (n & 3); const unsigned long long a = (unsigned long long)x.Wg, bb = (unsigned long long)x.Wu, msk = 0ull - (unsigned long long)((n >> 2) & 1);
        p = (const float*)(a ^ ((a ^ bb) & msk)) + j; pitch = 512; }
    else { p = x.Wg + n; pitch = 2048; }
    p += (size_t)k0 * pitch;
#pragma unroll
    for (int i = 0; i < 64; ++i) tv[i] = p[(size_t)i * pitch];
}
__device__ __forceinline__ void exp_store(const ExpItem& x, const float (&tv)[64], LAS float* scr, int lane) {
    const int kb = x.item / x.nblk, nb = x.item % x.nblk, k0 = 64 * kb, n0 = 64 * nb;
#pragma unroll
    for (int i = 0; i < 64; ++i) scr[i * 65 + lane] = tv[i] * x.sc;
    LDS_WAIT(); asm volatile("" ::: "memory");
    const int c = lane & 7;
#pragma unroll
    for (int j = 0; j < 8; ++j) { const int n = (lane >> 3) + 8 * j; const LAS float* s = scr + (8 * c) * 65 + n;
        *(u32x2*)(x.WT + (size_t)(n0 + n) * x.K + k0 + 8 * c) = (u32x2){pk4_f8(s[0 * 65], s[1 * 65], s[2 * 65], s[3 * 65]), pk4_f8(s[4 * 65], s[5 * 65], s[6 * 65], s[7 * 65])}; }
    LDS_WAIT(); asm volatile("" ::: "memory");
}
__device__ __forceinline__ void p0_experts(Frame& F, int cb, int ncb, int it_lo, int it_hi) {
    LAS float* scr = (LAS float*)(F.lds + F.wave * 16640);
    const int gw = cb * NWAVES + F.wave, NGW = ncb * NWAVES, lane = F.lane;
    ExpItem xa, xb; float ta[64], tb[64];
    int it = it_lo + gw; bool va = it < it_hi && exp_item(F, it, xa); if (va) exp_load(xa, ta, lane);
#pragma nounroll
    for (;;) {
        if (!va) break;
        const bool vb = it + NGW < it_hi && exp_item(F, it + NGW, xb); if (vb) exp_load(xb, tb, lane);
        exp_store(xa, ta, scr, lane);
        if (!vb) break;
        it += 2 * NGW; va = it < it_hi && exp_item(F, it, xa); if (va) exp_load(xa, ta, lane);
        exp_store(xb, tb, scr, lane);
    }
    __syncthreads();
}
__device__ __forceinline__ void p0_prologue(Frame& F) {
    LAS float* scr = (LAS float*)(F.lds + F.wave * 16384);
    const int gw = F.bx * NWAVES + F.wave, NGW = F.G * NWAVES, lane = F.lane;
    constexpr int I_WINI = 32 * 208, I_WO = 32 * 64, I_KV = 256, I_ADA = 64 * 48, I_RT = 256;
    constexpr int NITEMS = I_WINI + I_WO + I_KV + I_ADA + I_RT;
    for (int it = gw; it < NITEMS; it += NGW) {
        int r = it;
        if (r < I_WINI) { SrcWin s; s.W = F.in[I_WIN]; p0_tr_item_both(s, 2048, 208, WSP(bf16_t, WS_WIN), WSP(unsigned char, WS_WIN8), WIN_SCALE, scr, r, lane); continue; } r -= I_WINI;
        if (r < I_WO) { SrcPlain s; s.W = F.in[I_WOUT]; s.N = 2048; p0_tr_item_f8(s, 2048, 64, WSP(unsigned char, WS_WOUT), WO_SCALE, scr, r, lane); continue; } r -= I_WO;
        if (r < I_KV) { const int kv = r >> 7, h = (r >> 4) & 7, rr = r & 15;
            SrcWkv s; s.W = F.in[kv ? I_WUV : I_WUK] + (size_t)h * 256 * 128; s.g = F.in[I_CKVG];
            p0_tr_item(s, 256, 4, WSP(bf16_t, WS_WKV), kv * 1024 + h * 128, scr, rr, lane); continue; } r -= I_KV;
        if (r < I_ADA) { const int ks = r / 48, cb = r % 48;
            const float* cc = F.in[I_C];
#pragma unroll
            for (int j = 0; j < 4; ++j) { const int b = lane >> 3, kk = (lane & 7) + 8 * j; const float v = cc[b * 2048 + ks * 32 + kk]; scr[b * 32 + kk] = v * sigmoidf_(v); }
            LDS_WAIT(); asm volatile("" ::: "memory");
            f32x4 acc[8];
#pragma unroll
            for (int b = 0; b < 8; ++b) acc[b] = (f32x4){0.f, 0.f, 0.f, 0.f};
            const float* wp = F.in[I_WADA] + (size_t)(ks * 32) * 12288 + cb * 256 + lane * 4;
#pragma unroll 16
            for (int k = 0; k < 32; ++k) { const f32x4 w = *(const f32x4*)(wp + (size_t)k * 12288);
#pragma unroll
                for (int b = 0; b < 8; ++b) acc[b] += w * scr[b * 32 + k]; }
            float* mp = WSP(float, WS_MODP) + (size_t)ks * 8 * 12288 + cb * 256 + lane * 4;
#pragma unroll
            for (int b = 0; b < 8; ++b) *(f32x4*)(mp + (size_t)b * 12288) = acc[b];
            LDS_WAIT(); asm volatile("" ::: "memory"); continue; } r -= I_ADA;
        if (r < I_RT) { const int s = r >> 2, nt = r & 3, n = lane & 15, g = lane >> 4; const float* wr_ = F.in[I_WROUT];
            float v[8]; unsigned hi[4], lo[4];
#pragma unroll
            for (int j = 0; j < 8; ++j) v[j] = wr_[(size_t)(32 * s + 8 * g + j) * 64 + 16 * nt + n];
#pragma unroll
            for (int j = 0; j < 4; ++j) { const unsigned h0 = f2bf(v[2 * j]), h1 = f2bf(v[2 * j + 1]); hi[j] = h0 | (h1 << 16);
                lo[j] = f2bf(v[2 * j] - bf1((bf16_t)h0)) | (f2bf(v[2 * j + 1] - bf1((bf16_t)h1)) << 16); }
            u32x4* o = WSP(u32x4, WS_WR) + (size_t)((s * 4 + nt) * 2) * 64 + lane;
            o[0] = (u32x4){hi[0], hi[1], hi[2], hi[3]}; o[64] = (u32x4){lo[0], lo[1], lo[2], lo[3]}; continue; }
    }
}
__device__ __forceinline__ void p0b_mod(Frame& F) {
    const float* mp = WSP(float, WS_MODP); float* mod = WSP(float, WS_MOD); const float* ba = F.in[I_BADA];
    for (int i = F.bx * NTHR + F.tid; i < 8 * 12288; i += F.G * NTHR) { float s = ba[i % 12288];
#pragma unroll
        for (int ks = 0; ks < 64; ++ks) s += mp[(size_t)ks * 8 * 12288 + i];
        mod[i] = s; }
}
__device__ __forceinline__ void p1_h1(Frame& F) {
    const int gw = F.bx * NWAVES + F.wave, NGW = F.G * NWAVES, lane = F.lane;
    const float* mod = WSP(float, WS_MOD); const float* g = F.in[I_N1G]; bf16_t* H1 = WSP(bf16_t, WS_H1);
    const int RPW = (T + NGW - 1) / NGW, m0 = gw * RPW, m1 = (m0 + RPW < T) ? m0 + RPW : T;
    if (m0 >= T) return;
    f32x4 v[8], vn[8], ga[8], sh[8]; int bcur = -1;
    { const f32x4* xr = (const f32x4*)(F.in[I_X] + (size_t)m0 * D) + lane;
#pragma unroll
      for (int j = 0; j < 8; ++j) v[j] = xr[64 * j]; }
#pragma nounroll
    for (int m = m0; m < m1; ++m) { const int b = m >> 11;
        if (b != bcur) { bcur = b;
#pragma unroll
            for (int j = 0; j < 8; ++j) { const int c = 4 * lane + 256 * j; ga[j] = *(const f32x4*)(g + c) * (*(const f32x4*)(mod + b * 12288 + 2048 + c) + 1.f); sh[j] = *(const f32x4*)(mod + b * 12288 + c); } }
        if (m + 1 < m1) { const f32x4* xr = (const f32x4*)(F.in[I_X] + (size_t)(m + 1) * D) + lane;
#pragma unroll
            for (int j = 0; j < 8; ++j) vn[j] = xr[64 * j]; }
        float s = 0.f;
#pragma unroll
        for (int j = 0; j < 8; ++j) s += (v[j].x * v[j].x + v[j].y * v[j].y) + (v[j].z * v[j].z + v[j].w * v[j].w);
        const float rstd = 1.f / sqrtf(wave_sum(s) * (1.f / D) + EPS);
        u32x2* o = (u32x2*)(H1 + (size_t)m * D) + lane; unsigned* o8 = (unsigned*)(WSP(unsigned char, WS_H1F8) + (size_t)m * D) + lane;
#pragma unroll
        for (int j = 0; j < 8; ++j) { const f32x4 h = v[j] * rstd * ga[j] + sh[j];
            o[64 * j] = (u32x2){pk2(h.x, h.y), pk2(h.z, h.w)}; o8[64 * j] = pk4_f8(h.x * H1_SCALE, h.y * H1_SCALE, h.z * H1_SCALE, h.w * H1_SCALE); }
#pragma unroll
        for (int j = 0; j < 8; ++j) v[j] = vn[j];
    }
}

struct EpiProj {
    static constexpr bool PERM = true, PRE = false;
    unsigned char* ws; const float* lbl; float sc;
    __device__ __forceinline__ void operator()(const f32x4 (&acc_)[2][2][4][2], const pg8::Unit& u, int wr, int wc, int fr, int fq) const {
        const int pn = u.pn, row0 = u.pm * 256 + wr * 64 + fr, ct = 32 * wc + 8 * fq;
        f32x4 acc[2][2][4][2];
#pragma unroll
        for (int a = 0; a < 2; ++a)
#pragma unroll
            for (int b = 0; b < 2; ++b)
#pragma unroll
                for (int m = 0; m < 4; ++m)
#pragma unroll
                    for (int n = 0; n < 2; ++n) acc[a][b][m][n] = acc_[a][b][m][n] * sc;
        if (pn < 4) {
            bf16_t* QA = (bf16_t*)(ws + WS_QA);
#pragma unroll
            for (int ai = 0; ai < 2; ++ai)
#pragma unroll
                for (int m = 0; m < 4; ++m) { const int row = row0 + ai * 128 + m * 16, b = row >> 11, s = row & 2047;
#pragma unroll
                    for (int bj = 0; bj < 2; ++bj) { const f32x4 v0 = acc[ai][bj][m][0], v1 = acc[ai][bj][m][1];
                        *(u32x4*)(QA + ((size_t)(b * 8 + 2 * pn + bj) * 2048 + s) * 128 + ct) = (u32x4){pk2(v0[0], v0[1]), pk2(v0[2], v0[3]), pk2(v1[0], v1[1]), pk2(v1[2], v1[3])}; } }
        } else if (pn == 4) {
            bf16_t* O = (bf16_t*)(ws + WS_CKV); float* SS = (float*)(ws + WS_CKVSS);
#pragma unroll
            for (int ai = 0; ai < 2; ++ai)
#pragma unroll
                for (int m = 0; m < 4; ++m) { const int row = row0 + ai * 128 + m * 16; float ss = 0.f;
#pragma unroll
                    for (int bj = 0; bj < 2; ++bj) { const f32x4 v0 = acc[ai][bj][m][0], v1 = acc[ai][bj][m][1];
                        ss += (v0[0] * v0[0] + v0[1] * v0[1]) + (v0[2] * v0[2] + v0[3] * v0[3]) + (v1[0] * v1[0] + v1[1] * v1[1]) + (v1[2] * v1[2] + v1[3] * v1[3]);
                        *(u32x4*)(O + (size_t)row * 256 + bj * 128 + ct) = (u32x4){pk2(v0[0], v0[1]), pk2(v0[2], v0[3]), pk2(v1[0], v1[1]), pk2(v1[2], v1[3])}; }
                    ss += __shfl_xor(ss, 16); ss += __shfl_xor(ss, 32);
                    if (fq == 0) SS[(size_t)row * 4 + wc] = ss; }
        } else if (pn >= 13 && pn < 17) {
            float* LF = (float*)(ws + WS_LOGF); bf16_t* KB = (bf16_t*)(ws + WS_KB); const int cb = (pn - 13) * 256 + ct;
            float lb[2][8];
#pragma unroll
            for (int bj = 0; bj < 2; ++bj)
#pragma unroll
                for (int i = 0; i < 8; ++i) { const int c = cb + bj * 128 + i; lb[bj][i] = sigmoidf_(lbl[c] - lbl[1024 + c]); }
#pragma unroll
            for (int ai = 0; ai < 2; ++ai)
#pragma unroll
                for (int m = 0; m < 4; ++m) { const int row = row0 + ai * 128 + m * 16;
#pragma unroll
                    for (int bj = 0; bj < 2; ++bj) { float f[8], lg[8];
#pragma unroll
                        for (int i = 0; i < 8; ++i) { const float a = acc[ai][bj][m][i >> 2][i & 3]; f[i] = lb[bj][i] + (1.f - lb[bj][i]) * sigmoidf_(a); lg[i] = __logf(f[i]); }
                        float* lp = LF + (size_t)row * 1024 + cb + bj * 128;
                        *(f32x4*)lp = (f32x4){lg[0], lg[1], lg[2], lg[3]}; *(f32x4*)(lp + 4) = (f32x4){lg[4], lg[5], lg[6], lg[7]};
                        *(u32x4*)(KB + (size_t)row * 1024 + cb + bj * 128) = (u32x4){pk2(1.f - f[0], 1.f - f[1]), pk2(1.f - f[2], 1.f - f[3]), pk2(1.f - f[4], 1.f - f[5]), pk2(1.f - f[6], 1.f - f[7])}; } }
        } else if (pn == 25) {
            bf16_t* IK = (bf16_t*)(ws + WS_IK); float* IW = (float*)(ws + WS_IW);
#pragma unroll
            for (int ai = 0; ai < 2; ++ai)
#pragma unroll
                for (int m = 0; m < 4; ++m) { const int row = row0 + ai * 128 + m * 16; const f32x4 v0 = acc[ai][0][m][0], v1 = acc[ai][0][m][1];
                    if (wc < 2) { *(u32x4*)(IK + (size_t)row * 64 + ct) = (u32x4){pk2(v0[0], v0[1]), pk2(v0[2], v0[3]), pk2(v1[0], v1[1]), pk2(v1[2], v1[3])};
                        float ss = (v0[0] * v0[0] + v0[1] * v0[1]) + (v0[2] * v0[2] + v0[3] * v0[3]) + (v1[0] * v1[0] + v1[1] * v1[1]) + (v1[2] * v1[2] + v1[3] * v1[3]);
                        ss += __shfl_xor(ss, 16); ss += __shfl_xor(ss, 32);
                        if (fq == 0) ((float*)(ws + WS_IKSS))[(size_t)row * 2 + wc] = ss; }
                    else if (wc == 2 && fq < 2) { float* p = IW + (size_t)row * 16 + 8 * fq; *(f32x4*)p = v0 * 0.03125f; *(f32x4*)(p + 4) = v1 * 0.03125f; } }
        } else {
            size_t off; int t0; bool gate = false;
            if (pn < 9) { off = WS_IQ; t0 = 5; } else if (pn < 13) { off = WS_QB; t0 = 9; } else if (pn < 21) { off = WS_IB; t0 = 17; } else { off = WS_GB; t0 = 21; gate = true; }
            bf16_t* O = (bf16_t*)(ws + off); const int cb = (pn - t0) * 256 + ct;
            f32x4 kg0, kg1;
            { const float* ikg = (const float*)(ws + WS_IKGC); const f32x4 t0_ = *(const f32x4*)(ikg + 32 * (wc & 1) + 8 * fq), t1_ = *(const f32x4*)(ikg + 32 * (wc & 1) + 8 * fq + 4);
#pragma unroll
              for (int i = 0; i < 4; ++i) { kg0[i] = (pn < 9) ? t0_[i] : 1.f; kg1[i] = (pn < 9) ? t1_[i] : 1.f; } }
#pragma unroll
            for (int ai = 0; ai < 2; ++ai)
#pragma unroll
                for (int m = 0; m < 4; ++m) { const int row = row0 + ai * 128 + m * 16;
#pragma unroll
                    for (int bj = 0; bj < 2; ++bj) { f32x4 v0 = acc[ai][bj][m][0] * kg0, v1 = acc[ai][bj][m][1] * kg1;
                        if (gate) {
#pragma unroll
                            for (int i = 0; i < 4; ++i) { v0[i] = v0[i] * sigmoidf_(v0[i]); v1[i] = v1[i] * sigmoidf_(v1[i]); } }
                        *(u32x4*)(O + (size_t)row * 1024 + cb + bj * 128) = (u32x4){pk2(v0[0], v0[1]), pk2(v0[2], v0[3]), pk2(v1[0], v1[1]), pk2(v1[2], v1[3])}; } }
        }
    }
};
struct EpiKV {
    static constexpr bool PERM = true, PRE = false;
    unsigned char* ws;
    __device__ __forceinline__ void operator()(const f32x4 (&acc)[2][2][4][2], const pg8::Unit& u, int wr, int wc, int fr, int fq) const {
        const int pn = u.pn, row0 = u.pm * 256 + wr * 64 + fr, ct = 32 * wc + 8 * fq;
        bf16_t* O = (bf16_t*)(ws + (pn < 4 ? WS_K : WS_V)); const float* SS = (const float*)(ws + WS_CKVSS); const int hp = (pn & 3) * 2;
#pragma unroll
        for (int ai = 0; ai < 2; ++ai)
#pragma unroll
            for (int m = 0; m < 4; ++m) { const int row = row0 + ai * 128 + m * 16, b = row >> 11, s = row & 2047;
                const f32x4 q = *(const f32x4*)(SS + (size_t)row * 4); const float rstd = 1.f / sqrtf(((q[0] + q[1]) + (q[2] + q[3])) * (1.f / 256.f) + EPS);
#pragma unroll
                for (int bj = 0; bj < 2; ++bj) { const f32x4 v0 = acc[ai][bj][m][0] * rstd, v1 = acc[ai][bj][m][1] * rstd;
                    *(u32x4*)(O + ((size_t)(b * 8 + hp + bj) * 2048 + s) * 128 + ct) = (u32x4){pk2(v0[0], v0[1]), pk2(v0[2], v0[3]), pk2(v1[0], v1[1]), pk2(v1[2], v1[3])}; } }
    }
};
struct EpiOut {
    static constexpr bool PERM = true, PRE = false;
    const float* x; bf16_t* x1; const float* mod;
    __device__ __forceinline__ void operator()(const f32x4 (&acc)[2][2][4][2], const pg8::Unit& u, int wr, int wc, int fr, int fq) const {
        const int row0 = u.pm * 256 + wr * 64 + fr, col0 = u.pn * 256 + wc * 32 + 8 * fq, b = (u.pm * 256) >> 11;
        f32x4 g1[2][2];
#pragma unroll
        for (int bj = 0; bj < 2; ++bj)
#pragma unroll
            for (int n = 0; n < 2; ++n) g1[bj][n] = *(const f32x4*)(mod + b * 12288 + 4096 + col0 + bj * 128 + n * 4) * (1.f / (WO_SCALE * A2_SCALE));
#pragma unroll
        for (int ai = 0; ai < 2; ++ai)
#pragma unroll
            for (int m = 0; m < 4; ++m) { const size_t off = (size_t)(row0 + ai * 128 + m * 16) * 2048 + col0;
#pragma unroll
                for (int bj = 0; bj < 2; ++bj) { const f32x4 xa = *(const f32x4*)(x + off + bj * 128), xb = *(const f32x4*)(x + off + bj * 128 + 4);
                    const f32x4 v0 = xa + g1[bj][0] * acc[ai][bj][m][0], v1 = xb + g1[bj][1] * acc[ai][bj][m][1];
                    *(u32x4*)(x1 + off + bj * 128) = (u32x4){pk2(v0[0], v0[1]), pk2(v0[2], v0[3]), pk2(v1[0], v1[1]), pk2(v1[2], v1[3])}; }
                if (m == 3) asm volatile("" ::: "memory"); }
    }
};
__device__ __forceinline__ void p3_indexer(Frame& F, int qoff) {
    const int tid = F.tid, lane = F.lane, w = F.wave, c = lane & 31, half = lane >> 5;
    const bf16_t* IQ = WSP(bf16_t, WS_IQ); const bf16_t* IK = WSP(bf16_t, WS_IK); const float* IW = WSP(float, WS_IW); unsigned* MASK = WSP(unsigned, WS_MASK);
    const float NEG = -__builtin_inff();
    const float* IKSS = WSP(float, WS_IKSS); LAS float* RK = (LAS float*)(F.lds + 131072);
    const int sw = (c >> 1) & 7;
    int boff[4];
#pragma unroll
    for (int s = 0; s < 4; ++s) boff[s] = c * 128 + (((2 * s + half) ^ sw) * 16);
    for (;;) {
        __syncthreads();
        if (tid == 0) F.MISC[16] = __hip_atomic_fetch_add(F.ctl + CW_IDXQ + qoff, 1u, RLX_AGENT);
        __syncthreads();
        const int uid = (int)F.MISC[16];
        if (uid >= 1024) break;
        const int b = uid & 7, q0 = (127 - (uid >> 3)) * 16, nkeys = q0 + 16, qmax = q0 + 15;
        const int myq = q0 + 2 * w + half;
        bf16x8 Af[4];
        { const int sel = (c >> 2) & 1, head = (c & 3) + 4 * (c >> 3);
          const bf16_t* p = IQ + (size_t)(b * 2048 + q0 + 2 * w + sel) * 1024 + head * 64 + 8 * half;
#pragma unroll
          for (int s = 0; s < 4; ++s) Af[s] = *(const bf16x8*)(p + 16 * s); }
        float wv[16];
        { const f32x4* p = (const f32x4*)(IW + (size_t)(b * 2048 + myq) * 16);
#pragma unroll
          for (int i = 0; i < 4; ++i) { const f32x4 t = p[i]; wv[4 * i] = t[0]; wv[4 * i + 1] = t[1]; wv[4 * i + 2] = t[2]; wv[4 * i + 3] = t[3]; } }
        float v[64];
#pragma unroll
        for (int kt = 0; kt < 64; ++kt) v[kt] = NEG;
#pragma unroll
        for (int pass = 0; pass < 2; ++pass) {
            if (pass * 1024 < nkeys) {
                if (pass) __syncthreads();
                const int klo = pass * 1024, n = (nkeys - klo) < 1024 ? (nkeys - klo) : 1024;
                for (int it = 0; it * 64 < n; ++it) { const int kk = it * 64 + 8 * w + (lane >> 3), chs = (lane & 7) ^ ((kk >> 1) & 7);
                    __builtin_amdgcn_global_load_lds((const unsigned*)(IK + (size_t)(b * 2048 + klo + kk) * 64 + 8 * chs), (LAS unsigned*)(F.lds + (it * 64 + 8 * w) * 128), 16, 0, 0); }
#pragma unroll
                for (int i = 0; i < 2; ++i) { const int kk = tid + 512 * i;
                    if (kk < ((n + 63) & ~63)) { const f32x2 q = *(const f32x2*)(IKSS + (size_t)(b * 2048 + klo + kk) * 2); RK[kk] = 1.f / sqrtf((q[0] + q[1]) * (1.f / 64.f) + EPS); } }
                __syncthreads();
#pragma unroll
                for (int kl = 0; kl < 32; ++kl) { const int kt = pass * 32 + kl;
                    if (32 * kt <= qmax) {
                        f32x16 acc = {};
#pragma unroll
                        for (int s = 0; s < 4; ++s) { const bf16x8 bfr = *(const LAS bf16x8*)(F.lds + boff[s] + kl * 4096);
                            acc = __builtin_amdgcn_mfma_f32_32x32x16_bf16(Af[s], bfr, acc, 0, 0, 0); }
                        float sc = 0.f;
#pragma unroll
                        for (int i = 0; i < 16; ++i) sc = fmaf(wv[i], fmaxf(acc[i], 0.f), sc);
                        v[kt] = (32 * kt + c <= myq) ? sc * RK[32 * kl + c] : NEG;
                    }
                }
            }
        }
        float tau = -3.0e38f;
        if (qmax + 1 > TOPK) {
            float mx = NEG, mn = __builtin_inff();
#pragma unroll
            for (int kt = 0; kt < 64; ++kt) { mx = fmaxf(mx, v[kt]); mn = fminf(mn, v[kt] == NEG ? __builtin_inff() : v[kt]); }
#pragma unroll
            for (int o = 1; o < 32; o <<= 1) { mx = fmaxf(mx, __shfl_xor(mx, o)); mn = fminf(mn, __shfl_xor(mn, o)); }
            float lo = mn, hi = mx; bool done = (myq + 1 <= TOPK);
            for (int iter = 0; iter < 64; ++iter) {
                const float mid = 0.5f * lo + 0.5f * hi;
                if (!done && !(mid > lo && mid < hi)) { done = true; tau = lo; }
                if (__all(done)) break;
                int cnt = 0;
#pragma unroll
                for (int kt = 0; kt < 64; ++kt) cnt += (v[kt] >= mid) ? 1 : 0;
#pragma unroll
                for (int o = 1; o < 32; o <<= 1) cnt += __shfl_xor(cnt, o);
                if (!done) { if (cnt == TOPK) { done = true; tau = mid; } else if (cnt > TOPK) lo = mid; else hi = mid; }
            }
            if (!done) tau = lo;
        }
        int mA = 0, mB = 0;
#define IDX_WL(kt) { const unsigned long long m_ = __ballot(v[kt] >= tau); wlane<kt>(mA, (int)(unsigned)m_); wlane<kt>(mB, (int)(unsigned)(m_ >> 32)); }
#define IDX_WL8(k0) IDX_WL(k0) IDX_WL(k0 + 1) IDX_WL(k0 + 2) IDX_WL(k0 + 3) IDX_WL(k0 + 4) IDX_WL(k0 + 5) IDX_WL(k0 + 6) IDX_WL(k0 + 7) __builtin_amdgcn_sched_barrier(0);
        IDX_WL8(0) IDX_WL8(8) IDX_WL8(16) IDX_WL8(24) IDX_WL8(32) IDX_WL8(40) IDX_WL8(48) IDX_WL8(56)
#undef IDX_WL8
#undef IDX_WL
        MASK[(size_t)(b * 2048 + q0 + 2 * w) * 64 + lane] = (unsigned)mA;
        MASK[(size_t)(b * 2048 + q0 + 2 * w + 1) * 64 + lane] = (unsigned)mB;
    }
}

constexpr int HG_PITCH = 272, HG_QD = 0, HG_KI = 16 * HG_PITCH, HG_KDT = 2 * 16 * HG_PITCH, HG_VT = HG_KDT + 4096, HG_DL = HG_VT + 4096, HG_BUF = HG_DL + 512;
struct HgRaw { float lf[4]; bf16_t qq[4], kk[4]; u32x2 v; };
__device__ __forceinline__ void p3_hgrn(Frame& F, int bh) {
    const int tid = F.tid, lane = F.lane, w = F.wave, r = lane & 15, g = lane >> 4;
    const int b = bh >> 3, h = bh & 7;
    const float* LOGF = WSP(float, WS_LOGF); const bf16_t* QB = WSP(bf16_t, WS_QB); const bf16_t* KBp = WSP(bf16_t, WS_KB); const bf16_t* IB = WSP(bf16_t, WS_IB); bf16_t* HO = WSP(bf16_t, WS_HO);
    const int pc = 16 * w + r;
    const size_t colbase = (size_t)h * 128;
    f32x4 S[8];
#pragma unroll
    for (int m = 0; m < 8; ++m) S[m] = (f32x4){0.f, 0.f, 0.f, 0.f};
    HgRaw R0, R1, R2, R3;
#define HG_LOAD(R, ci) do { if ((ci) < 128) { const size_t row0 = (size_t)b * 2048 + (ci) * 16; \
        _Pragma("unroll") for (int j = 0; j < 4; ++j) { const size_t o = (row0 + 4 * g + j) * 1024 + colbase + pc; R.lf[j] = LOGF[o]; R.qq[j] = QB[o]; R.kk[j] = KBp[o]; } \
        R.v = *(const u32x2*)(IB + (row0 + (tid >> 5)) * 1024 + colbase + (tid & 31) * 4); } } while (0)
#define HG_WRITE(R, buf) do { LAS unsigned char* L = F.lds + (buf) * HG_BUF; \
        float c0 = R.lf[0], c1 = c0 + R.lf[1], c2 = c1 + R.lf[2], c3 = c2 + R.lf[3]; \
        const float t0_ = __shfl(c3, r), t1_ = __shfl(c3, r + 16), t2_ = __shfl(c3, r + 32), t3_ = __shfl(c3, r + 48); \
        const float pre = (g > 0 ? t0_ : 0.f) + (g > 1 ? t1_ : 0.f) + (g > 2 ? t2_ : 0.f); const float blast = (t0_ + t1_) + (t2_ + t3_); \
        const float dd = __expf(blast); float bc[4] = {pre + c0, pre + c1, pre + c2, pre + c3}; unsigned kd[4]; \
        _Pragma("unroll") for (int j = 0; j < 4; ++j) { const float e1 = __expf(bc[j]), e3 = __builtin_amdgcn_rcpf(e1); const float qv = bf1(R.qq[j]), kv = bf1(R.kk[j]); const int t = 4 * g + j; \
            *(LAS bf16_t*)(L + HG_QD + t * HG_PITCH + pc * 2) = (bf16_t)f2bf(qv * e1); *(LAS bf16_t*)(L + HG_KI + t * HG_PITCH + pc * 2) = (bf16_t)f2bf(kv * e3); kd[j] = f2bf(kv * dd * e3); } \
        *(LAS u32x2*)(L + HG_KDT + pc * 32 + g * 8) = (u32x2){kd[0] | (kd[1] << 16), kd[2] | (kd[3] << 16)}; \
        if (g == 0) *(LAS float*)(L + HG_DL + pc * 4) = dd; \
        { const int t = tid >> 5, v4 = (tid & 31) * 4; LAS bf16_t* vt = (LAS bf16_t*)(L + HG_VT); \
          vt[(v4 + 0) * 16 + t] = (bf16_t)(R.v.x & 0xffffu); vt[(v4 + 1) * 16 + t] = (bf16_t)(R.v.x >> 16); vt[(v4 + 2) * 16 + t] = (bf16_t)(R.v.y & 0xffffu); vt[(v4 + 3) * 16 + t] = (bf16_t)(R.v.y >> 16); } } while (0)
#define HG_STEP(ci, Rn) do { const int buf = (ci) & 1; LAS unsigned char* L = F.lds + buf * HG_BUF; \
        bf16x8 fa[4], fq[4]; u32x2 qp0[4], qp1[4]; f32x4 dv[4]; u32x4 ka[4]; u32x4 vb = {0u, 0u, 0u, 0u}; \
          \
        _Pragma("unroll") for (int i = 0; i < 4; ++i) { fa[i] = *(const LAS bf16x8*)(L + HG_KI + r * HG_PITCH + (32 * i + 8 * g) * 2); fq[i] = *(const LAS bf16x8*)(L + HG_QD + r * HG_PITCH + (32 * i + 8 * g) * 2); } \
        const u32x2 vi = *(const LAS u32x2*)(L + HG_VT + (16 * w + r) * 32 + g * 8); \
        _Pragma("unroll") for (int i = 0; i < 4; ++i) { qp0[i] = *(const LAS u32x2*)(L + HG_QD + r * HG_PITCH + (32 * i + 4 * g) * 2); qp1[i] = *(const LAS u32x2*)(L + HG_QD + r * HG_PITCH + (32 * i + 16 + 4 * g) * 2); } \
        if (g < 2) vb = *(const LAS u32x4*)(L + HG_VT + (16 * w + r) * 32 + g * 16); \
        _Pragma("unroll") for (int m = 0; m < 4; ++m) { dv[m] = *(const LAS f32x4*)(L + HG_DL + (16 * m + 4 * g) * 4); ka[m] = (u32x4){0u, 0u, 0u, 0u}; if (g < 2) ka[m] = *(const LAS u32x4*)(L + HG_KDT + (16 * m + r) * 32 + g * 16); } \
        f32x4 sT = (f32x4){0.f, 0.f, 0.f, 0.f}; \
        _Pragma("unroll") for (int i = 0; i < 4; ++i) sT = __builtin_amdgcn_mfma_f32_16x16x32_bf16(fa[i], fq[i], sT, 0, 0, 0); \
          \
        f32x4 oT = (f32x4){0.f, 0.f, 0.f, 0.f}; \
        _Pragma("unroll") for (int i = 0; i < 4; ++i) { const u32x4 sa = {pk2(S[2 * i][0], S[2 * i][1]), pk2(S[2 * i][2], S[2 * i][3]), pk2(S[2 * i + 1][0], S[2 * i + 1][1]), pk2(S[2 * i + 1][2], S[2 * i + 1][3])}; \
            const u32x4 qb = {qp0[i].x, qp0[i].y, qp1[i].x, qp1[i].y}; \
            oT = __builtin_amdgcn_mfma_f32_16x16x32_bf16(__builtin_bit_cast(bf16x8, sa), __builtin_bit_cast(bf16x8, qb), oT, 0, 0, 0); } \
          \
        _Pragma("unroll") for (int m = 0; m < 4; ++m) S[m] = __builtin_amdgcn_mfma_f32_16x16x32_bf16(__builtin_bit_cast(bf16x8, ka[m]), __builtin_bit_cast(bf16x8, vb), S[m] * dv[m], 0, 0, 0); \
        _Pragma("unroll") for (int m = 0; m < 4; ++m) { dv[m] = *(const LAS f32x4*)(L + HG_DL + (16 * (m + 4) + 4 * g) * 4); ka[m] = (u32x4){0u, 0u, 0u, 0u}; if (g < 2) ka[m] = *(const LAS u32x4*)(L + HG_KDT + (16 * (m + 4) + r) * 32 + g * 16); } \
        _Pragma("unroll") for (int m = 0; m < 4; ++m) S[m + 4] = __builtin_amdgcn_mfma_f32_16x16x32_bf16(__builtin_bit_cast(bf16x8, ka[m]), __builtin_bit_cast(bf16x8, vb), S[m + 4] * dv[m], 0, 0, 0); \
        _Pragma("unroll") for (int j = 0; j < 4; ++j) if (4 * g + j > r) sT[j] = 0.f; \
        const u32x4 pw = {pk2(sT[0], sT[1]), pk2(sT[2], sT[3]), 0u, 0u}; const u32x4 viw = {vi.x, vi.y, 0u, 0u}; \
        oT = __builtin_amdgcn_mfma_f32_16x16x32_bf16(__builtin_bit_cast(bf16x8, viw), __builtin_bit_cast(bf16x8, pw), oT, 0, 0, 0); \
        *(u32x2*)(HO + ((size_t)b * 2048 + (ci) * 16 + r) * 1024 + colbase + 16 * w + 4 * g) = (u32x2){pk2(oT[0], oT[1]), pk2(oT[2], oT[3])}; \
        if ((ci) + 1 < 128) { HG_WRITE(Rn, buf ^ 1); HG_LOAD(Rn, (ci) + 5); } \
        asm volatile("s_waitcnt lgkmcnt(0)" ::: "memory"); __builtin_amdgcn_s_barrier(); asm volatile("" ::: "memory"); } while (0)
    HG_LOAD(R0, 0); HG_LOAD(R1, 1); HG_LOAD(R2, 2); HG_LOAD(R3, 3);
    HG_WRITE(R0, 0); HG_LOAD(R0, 4);
    __syncthreads();
#pragma nounroll
    for (int ci = 0; ci < 128; ci += 4) { HG_STEP(ci, R1); HG_STEP(ci + 1, R2); HG_STEP(ci + 2, R3); HG_STEP(ci + 3, R0); }
    __syncthreads();
#undef HG_LOAD
#undef HG_WRITE
#undef HG_STEP
}

__device__ __forceinline__ int t5_bucket(int n) {
    if (n < 16) return n;
    int l = 16 + (int)(logf((float)n * (1.f / 16.f)) / logf(8.f) * 16.f);
    return l < 31 ? l : 31;
}
__device__ __forceinline__ void p4_attn_naive(Frame& F) {
    const int lane = F.lane, w = F.wave, gw = F.bx * NWAVES + w, NGW = F.G * NWAVES;
    LAS int* list = (LAS int*)(F.lds + w * 4096); LAS float* pl = (LAS float*)(F.lds + w * 4096 + 1024); LAS float* ql = (LAS float*)(F.lds + w * 4096 + 2048);
    const unsigned* MASK = WSP(unsigned, WS_MASK); const bf16_t* QA = WSP(bf16_t, WS_QA); const bf16_t* Kp = WSP(bf16_t, WS_K); const bf16_t* Vp = WSP(bf16_t, WS_V); bf16_t* AO = WSP(bf16_t, WS_AO);
    const float* relb = F.in[I_RELB];
#pragma nounroll
    for (int item = gw; item < T; item += NGW) { const int b = item >> 11, q = item & 2047;
        unsigned mw = MASK[(size_t)item * 64 + lane]; if (NOSEL) { const int k0_ = lane * 32; mw = (q >= k0_ + 31) ? 0xFFFFFFFFu : (q < k0_ ? 0u : ((2u << (q - k0_)) - 1u)); }
        const int cnt = __popc(mw); int pre = cnt;
#pragma unroll
        for (int o = 1; o < 64; o <<= 1) { const int t = __shfl_up(pre, o); if (lane >= o) pre += t; }
        int nsel = __shfl(pre, 63); int pos = pre - cnt; if (nsel > 256) nsel = 256;
        while (mw) { const int bit = __builtin_ctz(mw); if (pos < 256) list[pos] = lane * 32 + bit; ++pos; mw &= mw - 1; }
        LDS_WAIT(); asm volatile("" ::: "memory");
        for (int h = 0; h < 8; ++h) { const size_t hb = (size_t)(b * 8 + h) * 2048;
            { const unsigned qv = *(const unsigned*)(QA + (hb + q) * 128 + 2 * lane); ql[2 * lane] = bflo(qv); ql[2 * lane + 1] = bfhi(qv); }
            LDS_WAIT(); asm volatile("" ::: "memory");
            float sc[4]; float mx = -__builtin_inff();
#pragma unroll
            for (int jj = 0; jj < 4; ++jj) { const int idx = lane + 64 * jj; sc[jj] = -__builtin_inff();
                if (idx < nsel) { const int key = list[idx]; const u32x4* kp = (const u32x4*)(Kp + (hb + key) * 128); float s = 0.f;
#pragma unroll
                    for (int ch = 0; ch < 16; ++ch) { const u32x4 kv = kp[ch]; const f32x4 qa = *(const LAS f32x4*)(ql + 8 * ch), qb = *(const LAS f32x4*)(ql + 8 * ch + 4);
                        s += bflo(kv.x) * qa[0] + bfhi(kv.x) * qa[1] + bflo(kv.y) * qa[2] + bfhi(kv.y) * qa[3] + bflo(kv.z) * qb[0] + bfhi(kv.z) * qb[1] + bflo(kv.w) * qb[2] + bfhi(kv.w) * qb[3]; }
                    sc[jj] = s * ATT_SCALE + (NOBIAS ? 0.f : relb[t5_bucket(q - key > 0 ? q - key : 0) * 8 + h]); }
                mx = fmaxf(mx, sc[jj]); }
#pragma unroll
            for (int o = 1; o < 64; o <<= 1) mx = fmaxf(mx, __shfl_xor(mx, o));
            float ls = 0.f;
#pragma unroll
            for (int jj = 0; jj < 4; ++jj) { const int idx = lane + 64 * jj; const float p = (idx < nsel) ? __expf(sc[jj] - mx) : 0.f; ls += p; pl[idx] = p; }
            ls = wave_sum(ls);
            LDS_WAIT(); asm volatile("" ::: "memory");
            const int dg = lane & 15, kg = lane >> 4; float o[8];
#pragma unroll
            for (int i = 0; i < 8; ++i) o[i] = 0.f;
#pragma unroll 4
            for (int i0 = 0; i0 < nsel; i0 += 4) { const int i = i0 + kg;
                if (i < nsel) { const int key = list[i]; const float p = pl[i]; const u32x4 vv = *(const u32x4*)(Vp + (hb + key) * 128 + 8 * dg);
                    o[0] += p * bflo(vv.x); o[1] += p * bfhi(vv.x); o[2] += p * bflo(vv.y); o[3] += p * bfhi(vv.y); o[4] += p * bflo(vv.z); o[5] += p * bfhi(vv.z); o[6] += p * bflo(vv.w); o[7] += p * bfhi(vv.w); } }
            const float inv = 1.f / ls;
#pragma unroll
            for (int i = 0; i < 8; ++i) { o[i] += __shfl_xor(o[i], 16); o[i] += __shfl_xor(o[i], 32); o[i] *= inv; }
            if (kg == 0) *(u32x4*)(AO + (hb + q) * 128 + 8 * dg) = (u32x4){pk2(o[0], o[1]), pk2(o[2], o[3]), pk2(o[4], o[5]), pk2(o[6], o[7])};
            LDS_WAIT(); asm volatile("" ::: "memory");
        }
    }
}

namespace att {
constexpr int NW = 8, QBLK = 32, KVBLK = 64, QB = NW * QBLK, DH = 128;
constexpr int SHM_V = KVBLK * DH * 2, SHM_K = KVBLK * DH * 2;
constexpr int OFF_WS = 2 * SHM_V + 2 * SHM_K, OFF_TB = OFF_WS + NW * 64 * 4, TB_N = 384, OFF_MK = OFF_TB + 8 * TB_N * 4, OFF_Q = OFF_MK + 4096;
constexpr float SCALE = 0.08838834764831845f, THR = 8.f;
constexpr unsigned WBIG = 0x40000000u;
#define KSWZ(row, colB) ((row) * 256 + ((colB) ^ (((row) & 7) << 4)))
#define SBAR() __builtin_amdgcn_sched_barrier(0)
__device__ __forceinline__ int v_st(int k, int c) { const int kk = (k & ~0xC) | ((k & 4) << 1) | ((k & 8) >> 1); return ((kk >> 3) * 4 + (c >> 5)) * 512 + ((kk & 7) * 32 + (c & 31)) * 2; }
__device__ __forceinline__ int v_rd_base(int lane) { return ((lane & 3) << 3) | (((lane >> 2) & 3) << 6) | (((lane >> 4) & 1) << 5) | (((lane >> 5) & 1) << 8); }
constexpr int v_rd_off(int d0, int ks, int half) { return d0 * 512 + ks * 4096 + half * 2048; }
__device__ __forceinline__ int crow(int r, int hi) { return (r & 3) + 8 * (r >> 2) + 4 * hi; }
__device__ __forceinline__ void mask_tile(f32x16& p0, f32x16& p1, int dq, unsigned W) {
    const float NEG = -__builtin_inff();
#pragma unroll
    for (int r = 0; r < 16; ++r) { const int c = (r & 3) + 8 * (r >> 2);
        if ((unsigned)(dq - c) >= W) p0[r] = NEG;
        if ((unsigned)(dq - c - 32) >= W) p1[r] = NEG; }
}
__device__ __forceinline__ void swap32(unsigned& a, unsigned& b) { asm volatile("s_nop 1\n\tv_permlane32_swap_b32 %0, %1\n\ts_nop 1" : "+v"(a), "+v"(b)); }
__device__ __forceinline__ float selmask(float p, unsigned ws, int c) { if (NOSEL) return p; return __builtin_bit_cast(float, __builtin_bit_cast(unsigned, p) & (unsigned)__builtin_amdgcn_sbfe((int)ws, c, 1)); }
__device__ __forceinline__ void partialSM(f32x16& p0, f32x16& p1, float& m_reg, float& mn, float& alpha, unsigned w0s) {
    float pmax = p0[0]; for (int r = 1; r < 16; ++r) pmax = fmaxf(pmax, p0[r]); for (int r = 0; r < 16; ++r) pmax = fmaxf(pmax, p1[r]);
    { unsigned xa = __builtin_bit_cast(unsigned, pmax), xb = xa; swap32(xa, xb);
      pmax = fmaxf(__builtin_bit_cast(float, xa), __builtin_bit_cast(float, xb)); }
    constexpr float C2 = 1.4426950408889634f * SCALE;
    if (__builtin_expect(__all((pmax - m_reg) * SCALE <= THR), 1)) { mn = m_reg; alpha = 1.f; }
    else { mn = fmaxf(m_reg, pmax); alpha = __builtin_amdgcn_exp2f((m_reg - mn) * C2); m_reg = mn; }
    const float mnL = -mn * C2;
    for (int r = 0; r < 16; ++r) p0[r] = fmaf(p0[r], C2, mnL); for (int r = 0; r < 16; ++r) p1[r] = fmaf(p1[r], C2, mnL);
    for (int r = 0; r < 16; ++r) p0[r] = selmask(__builtin_amdgcn_exp2f(p0[r]), w0s, (r & 3) + 8 * (r >> 2));
}
__device__ __forceinline__ void finishSM(f32x16& p0, f32x16& p1, float alpha, float& l_reg, bf16x8& pa0, bf16x8& pa1, bf16x8& pa2, bf16x8& pa3, unsigned w1s) {
    for (int r = 0; r < 16; ++r) p1[r] = selmask(__builtin_amdgcn_exp2f(p1[r]), w1s, (r & 3) + 8 * (r >> 2));
    float ps = 0; for (int r = 0; r < 16; ++r) ps += p0[r]; for (int r = 0; r < 16; ++r) ps += p1[r];
    { unsigned xa = __builtin_bit_cast(unsigned, ps), xb = xa; swap32(xa, xb);
      ps = __builtin_bit_cast(float, xa) + __builtin_bit_cast(float, xb); }
    l_reg = l_reg * alpha + ps;
#define PK4(P, B_, OUT) do { unsigned a0 = pk2(P[B_+0], P[B_+1]), a1 = pk2(P[B_+2], P[B_+3]);                          \
        unsigned b0 = pk2(P[B_+4], P[B_+5]), b1 = pk2(P[B_+6], P[B_+7]);                                             \
        auto r0 = __builtin_amdgcn_permlane32_swap(a0, b0, false, false); auto r1 = __builtin_amdgcn_permlane32_swap(a1, b1, false, false); \
        u32x4 w = {r0[0], r1[0], r0[1], r1[1]}; OUT = __builtin_bit_cast(bf16x8, w); } while (0)
    PK4(p0, 0, pa0); PK4(p0, 8, pa1); PK4(p1, 0, pa2); PK4(p1, 8, pa3);
#undef PK4
}
template <int KB>
__device__ __forceinline__ void qkt(f32x16& p0, f32x16& p1, const char* K_lds, int r32, int hi, const char* qb, const bf16x8* qr_) {
    p0 = f32x16{}; p1 = f32x16{};
    const char* kb[4];
#pragma unroll
    for (int dd = 0; dd < 4; ++dd) kb[dd] = K_lds + KB * SHM_K + KSWZ(r32, (dd * 16 + hi * 8) * 2);
#pragma unroll
    for (int d0 = 0; d0 < 8; ++d0) { const char* a = kb[d0 & 3] + (d0 >> 2) * 128;
        bf16x8 b0 = *reinterpret_cast<const bf16x8*>(a);
        bf16x8 b1 = *reinterpret_cast<const bf16x8*>(a + 32 * 256);
        const bf16x8 qf = QREG ? qr_[d0] : *reinterpret_cast<const bf16x8*>(qb + d0 * 1024);
        p0 = __builtin_amdgcn_mfma_f32_32x32x16_bf16(b0, qf, p0, 0, 0, 0);
        p1 = __builtin_amdgcn_mfma_f32_32x32x16_bf16(b1, qf, p1, 0, 0, 0); }
}
template <int VB>
__device__ __forceinline__ void pv_tile(f32x16* o, int vb0, bf16x8 pa0, bf16x8 pa1, bf16x8 pa2, bf16x8 pa3) {
#define TRRD(dst, off) asm volatile("ds_read_b64_tr_b16 %0, %1 offset:%2" : "=&v"(dst) : "v"(vb0), "i"(off) : "memory")
#define PV_D0(d0) do { s16x4 l0, l1, l2, l3, h0, h1, h2, h3; constexpr int b_ = VB * SHM_V + v_rd_off(d0, 0, 0); \
        TRRD(l0, b_); TRRD(h0, b_ + 2048); TRRD(l1, b_ + 4096); TRRD(h1, b_ + 6144); TRRD(l2, b_ + 8192); TRRD(h2, b_ + 10240); TRRD(l3, b_ + 12288); TRRD(h3, b_ + 14336); \
        asm volatile("s_waitcnt lgkmcnt(0)" ::: "memory"); SBAR();   \
        o[d0] = __builtin_amdgcn_mfma_f32_32x32x16_bf16(pa0, (bf16x8){l0[0], l0[1], l0[2], l0[3], h0[0], h0[1], h0[2], h0[3]}, o[d0], 0, 0, 0);   \
        o[d0] = __builtin_amdgcn_mfma_f32_32x32x16_bf16(pa1, (bf16x8){l1[0], l1[1], l1[2], l1[3], h1[0], h1[1], h1[2], h1[3]}, o[d0], 0, 0, 0);   \
        o[d0] = __builtin_amdgcn_mfma_f32_32x32x16_bf16(pa2, (bf16x8){l2[0], l2[1], l2[2], l2[3], h2[0], h2[1], h2[2], h2[3]}, o[d0], 0, 0, 0);   \
        o[d0] = __builtin_amdgcn_mfma_f32_32x32x16_bf16(pa3, (bf16x8){l3[0], l3[1], l3[2], l3[3], h3[0], h3[1], h3[2], h3[3]}, o[d0], 0, 0, 0); } while (0)
    PV_D0(0); PV_D0(1); PV_D0(2); PV_D0(3);
#undef PV_D0
#undef TRRD
}
struct BlockRef { const bf16_t* Q; const bf16_t* K; const bf16_t* V; bf16_t* O; const unsigned* M; int P0; int h; };
struct Seam { bf16x8 st_v0, st_v1, st_k0, st_k1; unsigned st_m; };
#define ROW(p, k0, rr) ((p) + (size_t)((k0) + (rr)) * DH + sc)
#define VMW() asm volatile("s_waitcnt vmcnt(0)" ::: "memory")
#define VMWN(n) asm volatile("s_waitcnt vmcnt(%0)" :: "i"(n) : "memory")
#define LD8(p) (*reinterpret_cast<const bf16x8*>(p))
#define SLOAD_H(Kp, Vp, Mp, k0) do { S.st_v0 = LD8(ROW(Vp, k0, sr)); S.st_v1 = LD8(ROW(Vp, k0, 32 + sr)); S.st_k0 = LD8(ROW(Kp, k0, sr)); S.st_k1 = LD8(ROW(Kp, k0, 32 + sr)); \
        S.st_m = (Mp)[(tid >> 1) * 64 + ((k0) >> 5) + (tid & 1)]; } while (0)
#define SWRITE_HK(bf) do { *(bf16x8*)(K_lds + (bf) * SHM_K + kws) = S.st_k0; *(bf16x8*)(K_lds + (bf) * SHM_K + kws + 32 * 256) = S.st_k1; *(unsigned*)(lds + OFF_MK + (bf) * 2048 + tid * 4) = S.st_m; } while (0)
#define SWRITE_HV(bf) do { *(bf16x8*)(V_lds + (bf) * SHM_V + vst0) = S.st_v0; *(bf16x8*)(V_lds + (bf) * SHM_V + vst1) = S.st_v1; } while (0)
#define SWRITE_H(bf) do { SWRITE_HV(bf); SWRITE_HK(bf); } while (0)
__device__ __forceinline__ void prime(const BlockRef& cur, char* lds, Seam& S) {
    const int tid = threadIdx.x, wid = __builtin_amdgcn_readfirstlane(tid >> 6), lane = tid & 63, r32 = lane & 31, hi = lane >> 5;
    const int sr = tid >> 4, sc = (tid & 15) * 8, kws = KSWZ(sr, sc * 2); char* K_lds = lds + 2 * SHM_V;
    (void)wid; (void)lane; (void)r32; (void)hi;
    SLOAD_H(cur.K, cur.V, cur.M, 0); VMW(); SWRITE_HK(0);
    __syncthreads();
}
__device__ __forceinline__ void block(const BlockRef& cur, const BlockRef& nxt, char* lds, Seam& S) {
    const int tid = threadIdx.x, wid = __builtin_amdgcn_readfirstlane(tid >> 6), lane = tid & 63, r32 = lane & 31, hi = lane >> 5;
    const int NT = (cur.P0 + QB - 1) / KVBLK + 1;
    const int qlo = cur.P0 + wid * QBLK, qm = qlo + r32 - 4 * hi;
    char* V_lds = lds; char* K_lds = lds + 2 * SHM_V;
    float* ws = (float*)(lds + OFF_WS) + wid * 64; float* li_l = ws, * al_l = ws + 32;
    const char* tbh = lds + OFF_TB + cur.h * (TB_N * 4);
    float m_reg = -1e30f, l_reg = 0; f32x16 o[4] = {};
    const int sr = tid >> 4, sc = (tid & 15) * 8, vst0 = v_st(sr, sc), vst1 = v_st(32 + sr, sc), kws = KSWZ(sr, sc * 2);
    const int vb0 = (int)(uintptr_t)V_lds + v_rd_base(lane);
    const bf16_t* Kh = cur.K; const bf16_t* Vh = cur.V;
    const unsigned* Mh = cur.M;
    char* qb = lds + OFF_Q + wid * 8192 + lane * 16;
    bf16x8 qrr[8];
    { const bf16_t* qs2 = cur.Q + (size_t)(wid * QBLK + r32) * DH + hi * 8;
#pragma unroll
      for (int d0 = 0; d0 < 8; ++d0) qrr[d0] = QREG ? LD8(qs2 + d0 * 16) : bf16x8{}; }
    { bf16x8 qt[8]; const bf16_t* qsrc = cur.Q + (size_t)(wid * QBLK + opaque(r32)) * DH + opaque(hi) * 8;
#pragma unroll
      for (int d0 = 0; d0 < 8; ++d0) qt[d0] = LD8(qsrc + d0 * 16);
#pragma unroll
      for (int d0 = 0; d0 < 8; ++d0) *(bf16x8*)(qb + d0 * 1024) = qt[d0]; }
    const char* mkl = lds + OFF_MK + (wid * QBLK + r32) * 8;
#define MW0(bf) ((*(const unsigned*)(mkl + (bf) * 2048)) >> (4 * hi))
#define MW1(bf) ((*(const unsigned*)(mkl + (bf) * 2048 + 4)) >> (4 * hi))
#define RESC(a) do { if (__any((a) < 1.f)) { if (hi == 0) al_l[r32] = (a); asm volatile("s_waitcnt lgkmcnt(0)" ::: "memory");              \
                     for (int d_ = 0; d_ < 4; ++d_) for (int r = 0; r < 16; ++r) o[d_][r] *= al_l[crow(r, hi)]; } } while (0)
#define KBASE(t) ((t) * KVBLK)
#define MASKT(P0_, P1_, t) do { const int kb_ = KBASE(t); if (kb_ + KVBLK - 1 > qlo) mask_tile(P0_, P1_, qm - kb_, WBIG); } while (0)
#define BIAST(P0_, P1_, t) do { const int kb_ = KBASE(t); const int dmax_ = qlo + QBLK - 1 - kb_, dmin_ = qlo - kb_ - (KVBLK - 1);                     \
        if (!NOBIAS && dmax_ >= 0 && dmin_ < 113) { const char* tp_ = tbh + (287 - (qm - kb_)) * 4;                                                               \
            _Pragma("unroll") for (int r = 0; r < 16; ++r) { const int c_ = (r & 3) + 8 * (r >> 2);                                                    \
                P0_[r] += *(const float*)(tp_ + c_ * 4); P1_[r] += *(const float*)(tp_ + (c_ + 32) * 4); } } } while (0)
#define SEAM_K0() do { VMW(); SWRITE_HK(0); SBAR(); } while (0)
    f32x16 pA0, pA1, pB0, pB1; float mnA, mnB, alA, alB; bf16x8 pa0, pa1, pa2, pa3;
    SWRITE_HV(0); SBAR();
    if (NT > 1) { SLOAD_H(Kh, Vh, Mh, KBASE(1)); }
    SBAR(); qkt<0>(pA0, pA1, K_lds, r32, hi, qb, qrr);
    BIAST(pA0, pA1, 0); MASKT(pA0, pA1, 0); partialSM(pA0, pA1, m_reg, mnA, alA, MW0(0));
    if (NT > 1) { VMW(); SWRITE_H(1); }
    __syncthreads();
#define HALF_STEP(PX0, PX1, mnX, alX, PY0, PY1, alY, t, KB, VB, SB) do {                                                      \
        SBAR(); qkt<KB>(PX0, PX1, K_lds, r32, hi, qb, qrr);                                                                      \
        finishSM(PY0, PY1, alY, l_reg, pa0, pa1, pa2, pa3, MW1(VB)); SBAR();                                                  \
        if ((t) + 1 < NT) { SLOAD_H(Kh, Vh, Mh, KBASE((t) + 1)); SBAR(); }                                                    \
        pv_tile<VB>(o, vb0, pa0, pa1, pa2, pa3); BIAST(PX0, PX1, (t)); MASKT(PX0, PX1, (t)); partialSM(PX0, PX1, m_reg, mnX, alX, MW0(KB));  \
        __syncthreads();                                                                                                      \
        if ((t) + 1 < NT) { VMW(); SWRITE_H(SB); }                                                                            \
        RESC(alX); __syncthreads(); } while (0)
    for (int t = 1; t + 1 < NT; t += 2) {
        HALF_STEP(pB0, pB1, mnB, alB, pA0, pA1, alA, t, 1, 0, 0);
        HALF_STEP(pA0, pA1, mnA, alA, pB0, pB1, alB, t + 1, 0, 1, 1);
    }
    const bool even = (NT & 1) == 0;
    if (even) { SBAR(); qkt<1>(pB0, pB1, K_lds, r32, hi, qb, qrr); SBAR(); }
    SLOAD_H(nxt.K, nxt.V, nxt.M, 0); SBAR();
    finishSM(pA0, pA1, alA, l_reg, pa0, pa1, pa2, pa3, MW1(0)); SBAR();
    pv_tile<0>(o, vb0, pa0, pa1, pa2, pa3);
    if (even) { BIAST(pB0, pB1, NT - 1); MASKT(pB0, pB1, NT - 1); partialSM(pB0, pB1, m_reg, mnB, alB, MW0(1)); __syncthreads(); RESC(alB);
        finishSM(pB0, pB1, alB, l_reg, pa0, pa1, pa2, pa3, MW1(1)); SBAR(); pv_tile<1>(o, vb0, pa0, pa1, pa2, pa3); }
    else __syncthreads();
    SBAR(); SEAM_K0();
    if (hi == 0) li_l[r32] = l_reg; asm volatile("s_waitcnt lgkmcnt(0)" ::: "memory");
    { const int hie = opaque(hi), r32e = opaque(r32);
    float rli[16];
#pragma unroll
    for (int r = 0; r < 16; ++r) rli[r] = __builtin_amdgcn_rcpf(li_l[crow(r, hie)]);
    bf16_t* Ow = cur.O + (size_t)(wid * QBLK) * DH;
#pragma unroll
    for (int r = 0; r < 16; ++r) { const int orow = crow(r, hie);
#pragma unroll
        for (int d0 = 0; d0 < 4; ++d0) { const float v = o[d0][r] * rli[r]; const float vn = __shfl_xor(v, 1);
            if ((r32e & 1) == 0) *(unsigned*)(Ow + (size_t)orow * DH + d0 * 32 + r32e) = pk2(v, vn); } } }
    __syncthreads();
#undef RESC
#undef KBASE
#undef MASKT
#undef BIAST
#undef SEAM_K0
#undef HALF_STEP
#undef MW0
#undef MW1
}
#undef ROW
#undef VMW
#undef VMWN
#undef LD8
#undef SLOAD_H
#undef SWRITE_HK
#undef SWRITE_HV
#undef SWRITE_H
#undef KSWZ
#undef SBAR
}
__device__ __forceinline__ void p4_attn_dense(Frame& F, bf16_t* AO) {
    char* lds = (char*)F.lds;
    const bf16_t* QA = WSP(bf16_t, WS_QA); const bf16_t* Kp = WSP(bf16_t, WS_K); const bf16_t* Vp = WSP(bf16_t, WS_V); const unsigned* MASK = WSP(unsigned, WS_MASK);
    { const float* relb = F.in[I_RELB]; LAS float* tb = (LAS float*)(F.lds + att::OFF_TB);
      for (int i = F.tid; i < 8 * att::TB_N; i += NTHR) { const int h = i / att::TB_N, j = i % att::TB_N, d = 287 - j;
          tb[i] = (d >= 0 && d < 128) ? (relb[t5_bucket(d) * 8 + h] - relb[31 * 8 + h]) * (1.f / att::SCALE) : 0.f; } }
    __syncthreads();
    const int total = 64 * 4;
    int L = F.bx; if (L >= total) return;
    auto mkref = [&](int item, int pass) { const int bh = item >> 2, y = item & 3, qb = pass ? 7 - y : y; att::BlockRef r;
        r.Q = QA + ((size_t)bh * 2048 + qb * 256) * 128; r.O = AO + ((size_t)bh * 2048 + qb * 256) * 128; r.K = Kp + (size_t)bh * 2048 * 128; r.V = Vp + (size_t)bh * 2048 * 128;
        r.M = MASK + ((size_t)(bh >> 3) * 2048 + qb * 256) * 64; r.P0 = qb * 256; r.h = bh & 7; return r; };
    int pass = 0; att::BlockRef cur = mkref(L, 0); att::Seam S;
    att::prime(cur, lds, S);
    for (;;) {
        const bool more_pass = pass == 0, more_item = L + F.G < total, last = !more_pass && !more_item;
        int passn = pass + 1, Ln = L;
        if (!more_pass) { passn = 0; Ln = more_item ? L + F.G : L; }
        const att::BlockRef nxt = last ? cur : mkref(Ln, passn);
        att::block(cur, nxt, lds, S);
        if (last) break;
        cur = nxt; pass = passn; L = Ln;
    }
}

__device__ __forceinline__ void p5_finalize(Frame& F) {
    const int lane = F.lane, gw = F.bx * NWAVES + F.wave, NGW = F.G * NWAVES;
    const bf16_t* AO = WSP(bf16_t, WS_AO); const bf16_t* HO = WSP(bf16_t, WS_HO); const bf16_t* GB = WSP(bf16_t, WS_GB); unsigned char* A2 = WSP(unsigned char, WS_A2);
    const float* ag = F.in[I_AOG]; const float* hg = F.in[I_HOG];
#pragma nounroll
    for (int m = gw; m < T; m += NGW) { const int b = m >> 11, s = m & 2047;
        const int hh = lane >> 3, c0 = 16 * (lane & 7);
        const u32x4* ap = (const u32x4*)(AO + ((size_t)(b * 8 + hh) * 2048 + s) * 128 + c0);
        const u32x4 a0 = ap[0], a1 = ap[1]; float av[16];
        av[0] = bflo(a0.x); av[1] = bfhi(a0.x); av[2] = bflo(a0.y); av[3] = bfhi(a0.y); av[4] = bflo(a0.z); av[5] = bfhi(a0.z); av[6] = bflo(a0.w); av[7] = bfhi(a0.w);
        av[8] = bflo(a1.x); av[9] = bfhi(a1.x); av[10] = bflo(a1.y); av[11] = bfhi(a1.y); av[12] = bflo(a1.z); av[13] = bfhi(a1.z); av[14] = bflo(a1.w); av[15] = bfhi(a1.w);
        float ss = 0.f;
#pragma unroll
        for (int i = 0; i < 16; ++i) ss += av[i] * av[i];
        const float rstd = 1.f / sqrtf(wave_sum(ss) * (1.f / 1024.f) + EPS);
        unsigned ow[4];
#pragma unroll
        for (int i = 0; i < 4; ++i) ow[i] = pk4_f8(av[4 * i] * rstd * ag[16 * lane + 4 * i] * A2_SCALE, av[4 * i + 1] * rstd * ag[16 * lane + 4 * i + 1] * A2_SCALE, av[4 * i + 2] * rstd * ag[16 * lane + 4 * i + 2] * A2_SCALE, av[4 * i + 3] * rstd * ag[16 * lane + 4 * i + 3] * A2_SCALE);
        *(u32x4*)(A2 + (size_t)m * 2048 + 16 * lane) = (u32x4){ow[0], ow[1], ow[2], ow[3]};
        const u32x4* hp = (const u32x4*)(HO + (size_t)m * 1024 + 16 * lane); float hv[16];
#pragma unroll
        for (int i = 0; i < 2; ++i) { const u32x4 t = hp[i]; hv[8 * i] = bflo(t.x); hv[8 * i + 1] = bfhi(t.x); hv[8 * i + 2] = bflo(t.y); hv[8 * i + 3] = bfhi(t.y); hv[8 * i + 4] = bflo(t.z); hv[8 * i + 5] = bfhi(t.z); hv[8 * i + 6] = bflo(t.w); hv[8 * i + 7] = bfhi(t.w); }
        float s2 = 0.f;
#pragma unroll
        for (int i = 0; i < 16; ++i) s2 += hv[i] * hv[i];
        s2 += __shfl_xor(s2, 1); s2 += __shfl_xor(s2, 2); s2 += __shfl_xor(s2, 4);
        const float r2 = 1.f / sqrtf(s2 * (1.f / 128.f) + EPS);
        const u32x4* gp = (const u32x4*)(GB + (size_t)m * 1024 + 16 * lane); const u32x4 g0 = gp[0], g1 = gp[1]; float gv[16];
        gv[0] = bflo(g0.x); gv[1] = bfhi(g0.x); gv[2] = bflo(g0.y); gv[3] = bfhi(g0.y); gv[4] = bflo(g0.z); gv[5] = bfhi(g0.z); gv[6] = bflo(g0.w); gv[7] = bfhi(g0.w);
        gv[8] = bflo(g1.x); gv[9] = bfhi(g1.x); gv[10] = bflo(g1.y); gv[11] = bfhi(g1.y); gv[12] = bflo(g1.z); gv[13] = bfhi(g1.z); gv[14] = bflo(g1.w); gv[15] = bfhi(g1.w);
#pragma unroll
        for (int i = 0; i < 4; ++i) ow[i] = pk4_f8(hv[4 * i] * r2 * hg[16 * lane + 4 * i] * gv[4 * i] * A2_SCALE, hv[4 * i + 1] * r2 * hg[16 * lane + 4 * i + 1] * gv[4 * i + 1] * A2_SCALE, hv[4 * i + 2] * r2 * hg[16 * lane + 4 * i + 2] * gv[4 * i + 2] * A2_SCALE, hv[4 * i + 3] * r2 * hg[16 * lane + 4 * i + 3] * gv[4 * i + 3] * A2_SCALE);
        *(u32x4*)(A2 + (size_t)m * 2048 + 1024 + 16 * lane) = (u32x4){ow[0], ow[1], ow[2], ow[3]};
    }
}

constexpr int R_GM = 0, R_SH = 8192, R_LG = 16384, R_SC = 32768, R_HIST = 49152, R_BASE = 49408;
__device__ __forceinline__ void p7_router(Frame& F, int coff) {
    const int tid = F.tid, lane = F.lane, w = F.wave, r = lane & 15, g = lane >> 4;
    const bf16_t* X1 = WSP(bf16_t, WS_X1); const float* mod = WSP(float, WS_MOD); const float* n2g = F.in[I_N2G]; const float* rbias = F.in[I_RBIAS];
    unsigned char* H2 = WSP(unsigned char, WS_H2); const u32x4* WR = WSP(u32x4, WS_WR);
    int* LTOK = WSP(int, WS_LTOK); int* LDSTp = WSP(int, WS_LDST); float* LWp = WSP(float, WS_LW);
    LAS float* GM = (LAS float*)(F.lds + R_GM); LAS float* SH = (LAS float*)(F.lds + R_SH); LAS float* LG = (LAS float*)(F.lds + R_LG); LAS float* SC = (LAS float*)(F.lds + R_SC);
    LAS int* HIST = (LAS int*)(F.lds + R_HIST); LAS int* BASE = (LAS int*)(F.lds + R_BASE);
    if (F.bx == 0 && tid < 128) WSP(u32x4, WS_H2 + (size_t)T * 2048)[tid] = (u32x4){0u, 0u, 0u, 0u};
    for (int unit = F.bx; unit < T / 64; unit += F.G) {
        const int tok0 = unit * 64, b = tok0 >> 11;
        __syncthreads();
        for (int i = tid; i < 2048; i += NTHR) { GM[i] = n2g[i] * (1.f + mod[b * 12288 + 8192 + i]); SH[i] = mod[b * 12288 + 6144 + i]; }
        if (tid < 64) HIST[tid] = 0;
        __syncthreads();
        DSTAMP(F, 0);
        const bf16_t* xr8 = X1 + (size_t)(tok0 + 8 * w + (r & 7)) * 2048 + 8 * g;
        float ss = 0.f;
        const int rot = (unit * 8 + w) * 5;
#pragma unroll 16
        for (int s_ = 0; s_ < 64; ++s_) { const int s = (s_ + rot) & 63; const u32x4 t = *(const u32x4*)(xr8 + 32 * s);
            const f32x4 a = {bflo(t.x), bfhi(t.x), bflo(t.y), bfhi(t.y)}, c = {bflo(t.z), bfhi(t.z), bflo(t.w), bfhi(t.w)};
            ss += (a[0] * a[0] + a[1] * a[1]) + (a[2] * a[2] + a[3] * a[3]) + (c[0] * c[0] + c[1] * c[1]) + (c[2] * c[2] + c[3] * c[3]); }
        ss += __shfl_xor(ss, 16); ss += __shfl_xor(ss, 32);
        if (lane < 8) SC[8 * w + lane] = 1.f / sqrtf(ss * (1.f / 2048.f) + EPS);
        __syncthreads();
        const bool act = w < 4; const int row = tok0 + 16 * (w & 3) + r; const float rstd = SC[16 * (w & 3) + r];
        const bf16_t* xr = X1 + (size_t)row * 2048 + 8 * g;
        DSTAMP(F, 1);
        f32x4 acc[4];
#pragma unroll
        for (int nt = 0; nt < 4; ++nt) acc[nt] = (f32x4){0.f, 0.f, 0.f, 0.f};
        LAS u32x4* WL = (LAS u32x4*)(F.lds + 65536);
        const int rotb = unit * 5;
        u32x4 xraw[4];
#define RT_XLOAD(j, s_) do { const int s = ((s_) + rotb) & 63; xraw[j] = *(const u32x4*)(xr + 32 * s); } while (0)
#define RT_WSTAGE(buf, c_) do { _Pragma("unroll") for (int q = 0; q < 4; ++q) { const int s = ((c_) * 4 + q + rotb) & 63; \
            wst[q] = WR[(size_t)(s * 8 + w) * 64 + lane]; } } while (0)
#define RT_WWRITE(buf) do { _Pragma("unroll") for (int q = 0; q < 4; ++q) WL[((buf) * 4 + q) * 512 + w * 64 + lane] = wst[q]; } while (0)
#define RT_STEP(j, buf, q, s_) do { const int s = ((s_) + rotb) & 63; const int k0 = 32 * s + 8 * g; \
        const f32x4 g0 = *(const LAS f32x4*)(GM + k0), g1 = *(const LAS f32x4*)(GM + k0 + 4), s0 = *(const LAS f32x4*)(SH + k0), s1 = *(const LAS f32x4*)(SH + k0 + 4); \
        const f32x4 xa_ = {bflo(xraw[j].x), bfhi(xraw[j].x), bflo(xraw[j].y), bfhi(xraw[j].y)}, xc_ = {bflo(xraw[j].z), bfhi(xraw[j].z), bflo(xraw[j].w), bfhi(xraw[j].w)}; \
        const f32x4 h0 = xa_ * rstd * g0 + s0, h1 = xc_ * rstd * g1 + s1; unsigned hi[4], lo[4]; \
        _Pragma("unroll") for (int jj = 0; jj < 2; ++jj) { const unsigned p0 = f2bf(h0[2 * jj]), p1 = f2bf(h0[2 * jj + 1]); hi[jj] = p0 | (p1 << 16); lo[jj] = pk2(h0[2 * jj] - bf1((bf16_t)p0), h0[2 * jj + 1] - bf1((bf16_t)p1)); } \
        _Pragma("unroll") for (int jj = 0; jj < 2; ++jj) { const unsigned p0 = f2bf(h1[2 * jj]), p1 = f2bf(h1[2 * jj + 1]); hi[2 + jj] = p0 | (p1 << 16); lo[2 + jj] = pk2(h1[2 * jj] - bf1((bf16_t)p0), h1[2 * jj + 1] - bf1((bf16_t)p1)); } \
        const u32x4 hiw = {hi[0], hi[1], hi[2], hi[3]}, low = {lo[0], lo[1], lo[2], lo[3]}; \
        *(u32x2*)(H2 + (size_t)row * 2048 + k0) = (u32x2){pk4_f8(h0[0], h0[1], h0[2], h0[3]), pk4_f8(h1[0], h1[1], h1[2], h1[3])}; \
        const bf16x8 ah = __builtin_bit_cast(bf16x8, hiw), al = __builtin_bit_cast(bf16x8, low); \
        _Pragma("unroll") for (int nt = 0; nt < 4; ++nt) { const bf16x8 bh = __builtin_bit_cast(bf16x8, WL[((buf) * 4 + (q)) * 512 + (2 * nt) * 64 + lane]), bl = __builtin_bit_cast(bf16x8, WL[((buf) * 4 + (q)) * 512 + (2 * nt + 1) * 64 + lane]); \
            acc[nt] = __builtin_amdgcn_mfma_f32_16x16x32_bf16(ah, bh, acc[nt], 0, 0, 0); acc[nt] = __builtin_amdgcn_mfma_f32_16x16x32_bf16(al, bh, acc[nt], 0, 0, 0); acc[nt] = __builtin_amdgcn_mfma_f32_16x16x32_bf16(ah, bl, acc[nt], 0, 0, 0); } } while (0)
        u32x4 wst[4];
        RT_WSTAGE(0, 0); if (act) { RT_XLOAD(0, 0); RT_XLOAD(1, 1); RT_XLOAD(2, 2); RT_XLOAD(3, 3); }
        RT_WWRITE(0);
        __syncthreads();
#pragma nounroll
        for (int c = 0; c < 16; ++c) { const int buf = c & 1;
            if (c + 1 < 16) RT_WSTAGE(buf ^ 1, c + 1);
            if (act) {
            RT_STEP(0, buf, 0, 4 * c);     if (c + 1 < 16) RT_XLOAD(0, 4 * c + 4);
            RT_STEP(1, buf, 1, 4 * c + 1); if (c + 1 < 16) RT_XLOAD(1, 4 * c + 5);
            RT_STEP(2, buf, 2, 4 * c + 2); if (c + 1 < 16) RT_XLOAD(2, 4 * c + 6);
            RT_STEP(3, buf, 3, 4 * c + 3); if (c + 1 < 16) RT_XLOAD(3, 4 * c + 7); }
            if (c + 1 < 16) RT_WWRITE(buf ^ 1);
            asm volatile("s_waitcnt lgkmcnt(0)" ::: "memory"); __builtin_amdgcn_s_barrier(); asm volatile("" ::: "memory"); }
        __syncthreads();
#undef RT_XLOAD
#undef RT_WSTAGE
#undef RT_WWRITE
#undef RT_STEP
        DSTAMP(F, 2);
        if (act) {
#pragma unroll
            for (int nt = 0; nt < 4; ++nt)
#pragma unroll
                for (int j = 0; j < 4; ++j) LG[(w * 16 + 4 * g + j) * 64 + 16 * nt + r] = acc[nt][j]; }
        __syncthreads();
        int rk[8], lp[8]; float ww[8];
        const float rb = rbias[lane]; const float NEGI = -__builtin_inff();
#pragma unroll
        for (int tk = 0; tk < 8; ++tk) {
            const float sg = sigmoidf_(LG[(w * 8 + tk) * 64 + lane]), ch = sg + rb;
            float m1 = ch; m1 = fmaxf(m1, swz_xor<1>(m1)); m1 = fmaxf(m1, swz_xor<2>(m1)); m1 = fmaxf(m1, swz_xor<4>(m1));
            float fi = (ch == m1) ? (float)(lane & 7) : 8.f; fi = fminf(fi, swz_xor<1>(fi)); fi = fminf(fi, swz_xor<2>(fi)); fi = fminf(fi, swz_xor<4>(fi));
            float m2 = ((float)(lane & 7) == fi) ? NEGI : ch; m2 = fmaxf(m2, swz_xor<1>(m2)); m2 = fmaxf(m2, swz_xor<2>(m2)); m2 = fmaxf(m2, swz_xor<4>(m2));
            const float gs = m1 + m2; int grank = 0;
#pragma unroll
            for (int j = 0; j < 8; ++j) { const float gj = __builtin_bit_cast(float, __builtin_amdgcn_readlane(__builtin_bit_cast(int, gs), 8 * j)); grank += (gj > gs || (gj == gs && j < (lane >> 3))) ? 1 : 0; }
            const float val = (grank < 4) ? ch : NEGI; int rank = 0;
            const unsigned long long gm = __ballot(grank < 4);
#pragma unroll
            for (int j = 0; j < 8; ++j) { if ((gm >> (8 * j)) & 1ull) {
#pragma unroll
                for (int i = 0; i < 8; ++i) { const int e = 8 * j + i; const float ve = __builtin_bit_cast(float, __builtin_amdgcn_readlane(__builtin_bit_cast(int, val), e)); rank += (ve > val || (ve == val && e < lane)) ? 1 : 0; } } }
            const bool sel = (grank < 4) && rank < 8;
            const float wsum = wave_sum(sel ? sg : 0.f);
            rk[tk] = sel ? rank : -1; ww[tk] = sg * 2.5f / wsum; lp[tk] = 0;
            if (sel) lp[tk] = __hip_atomic_fetch_add(HIST + lane, 1, __ATOMIC_RELAXED, __HIP_MEMORY_SCOPE_WORKGROUP);
        }
        DSTAMP(F, 3);
        __syncthreads();
        if (tid < 64) BASE[tid] = (int)__hip_atomic_fetch_add(F.ctl + CW_CNT + coff + tid, (unsigned)HIST[tid], RLX_AGENT);
        __syncthreads();
        { const int bs = BASE[lane];
#pragma unroll
          for (int tk = 0; tk < 8; ++tk) if (rk[tk] >= 0) { const int tok = tok0 + 8 * w + tk; const size_t o = (size_t)lane * 16384 + bs + lp[tk]; LTOK[o] = tok; LDSTp[o] = tok * 9 + rk[tk]; LWp[o] = ww[tk]; } }
        DSTAMP(F, 4);
    }
}

struct MoeSched {
    const char* A; const char* Bt; const int* ltok; LAS const int* tab;
    int K, ncol, nexp, G, c, gather, rep;
    __device__ __forceinline__ bool next(int i, pg8::Unit& u) const {
        if (i >= 120) return false;
        LAS const int* q = tab + 256 + 4 * i; const int pm = q[0]; if (pm < 0) return false;
        u.pm = pm; u.pn = q[1]; u.e = q[2]; u.cnt = q[3]; return true;
    }
    __device__ __forceinline__ bool slow_next(int i, pg8::Unit& u) const {
        int L = i * G + c; if (G == 256) L = ((i * 8 + (c & 7)) << 5) + (c >> 3);
        const int tot = tab[160 + 65] * ncol; if (L >= tot * rep) return false; L %= tot;
        int e = 0;
#pragma unroll
        for (int st = 64; st >= 1; st >>= 1) { const int t = e + st; if (t <= 64 && tab[160 + t] * ncol <= L) e = t; }
        const int rem = L - tab[160 + e] * ncol, nb = tab[80 + e];
        u.pn = rem % ncol; u.pm = rem / ncol; u.e = e | (tab[160 + e] << 8); u.cnt = tab[e]; (void)nb; return true;
    }
    __device__ __forceinline__ const char* a_base() const { return A; }
    __device__ __forceinline__ unsigned a_off(const pg8::Unit& u, int h, int R) const {
        const int e = u.e & 255, pos = u.pm * 256 + h * 128 + R;
        if (gather) { const int tok = (e == 64) ? pos : (pos < u.cnt ? ltok[(size_t)e * 16384 + pos] : T); return (unsigned)tok * (unsigned)K; }
        return (unsigned)((u.e >> 8) * 256 + pos) * (unsigned)K;
    }
    __device__ __forceinline__ const char* b_tile(const pg8::Unit& u) const { return Bt + ((size_t)(u.e & 255) * nexp + (size_t)u.pn * 256) * K; }
};
__device__ __forceinline__ void moe_units(Frame& F, const MoeSched& S) {
    __syncthreads();
    if (F.tid < 120) { pg8::Unit u; u.pm = u.pn = u.e = u.cnt = 0; const bool ok = S.slow_next(F.tid, u); LAS int* q = (LAS int*)(F.lds + SCHED_OFF) + 256 + 4 * F.tid; q[0] = ok ? u.pm : -1; q[1] = u.pn; q[2] = u.e; q[3] = u.cnt; }
    __syncthreads();
}
__device__ __forceinline__ void moe_tables(Frame& F) {
    LAS int* tab = (LAS int*)(F.lds + SCHED_OFF);
    __syncthreads();
    if (F.tid < 65) { const int c = (F.tid < 64) ? (int)__hip_atomic_load(F.ctl + CW_CNT + F.tid, RLX_AGENT) : T; tab[F.tid] = c; tab[80 + F.tid] = (c + 255) >> 8; }
    __syncthreads();
    if (F.wave == 0) { const int lane = F.lane, nb = tab[80 + lane]; int inc = nb;
#pragma unroll
        for (int o = 1; o < 64; o <<= 1) { const int t = __shfl_up(inc, o); if (lane >= o) inc += t; }
        tab[160 + lane] = inc - nb;
        if (lane == 63) { tab[160 + 64] = inc; tab[160 + 65] = inc + tab[80 + 64]; } }
    __syncthreads();
}
struct EpiMoe1 {
    static constexpr bool PERM = true, PRE = false;
    unsigned char* act;
    __device__ __forceinline__ void operator()(const f32x4 (&acc)[2][2][4][2], const pg8::Unit& u, int wr, int wc, int fr, int fq) const {
        const int row0 = (u.e >> 8) * 256 + u.pm * 256 + wr * 64 + fr, col0 = 128 * u.pn + 16 * wc + 4 * fq;
#pragma unroll
        for (int ai = 0; ai < 2; ++ai)
#pragma unroll
            for (int m = 0; m < 4; ++m) { unsigned char* rp = act + (size_t)(row0 + ai * 128 + m * 16) * 512 + col0;
#pragma unroll
                for (int bj = 0; bj < 2; ++bj) { const f32x4 gt = acc[ai][bj][m][0] * (1.f / W1_SCALE), up = acc[ai][bj][m][1] * (ACT_SCALE / W1_SCALE); float a[4];
#pragma unroll
                    for (int i = 0; i < 4; ++i) a[i] = gt[i] * sigmoidf_(gt[i]) * up[i];
                    *(unsigned*)(rp + 64 * bj) = pk4_f8(a[0], a[1], a[2], a[3]); } }
    }
};
struct EpiMoe2 {
    static constexpr bool PERM = true, PRE = true;
    static constexpr int TAB = 133120;
    unsigned char* y; const int* ldst; const float* lw; LAS unsigned char* lds;
    __device__ __forceinline__ void pre(LAS unsigned char* l, const pg8::Unit& u, int wid) const {
        const int lane = (int)__builtin_amdgcn_mbcnt_hi(~0u, __builtin_amdgcn_mbcnt_lo(~0u, 0u));
        const unsigned* src = (const unsigned*)ldst + ((size_t)(wid >> 2) << 20) + (size_t)(u.e & 255) * 16384 + u.pm * 256 + (wid & 3) * 64 + lane;
        __builtin_amdgcn_global_load_lds(src, (LAS unsigned*)(l + TAB + u.par * 2048 + wid * 256), 4, 0, 0);
    }
    __device__ __forceinline__ void operator()(const f32x4 (&acc)[2][2][4][2], const pg8::Unit& u, int wr, int wc, int fr, int fq) const {
        const int e = u.e & 255, r0 = wr * 64 + fr, col0 = 256 * u.pn + 32 * wc + 8 * fq;
        const LAS int* tD = (const LAS int*)(lds + TAB + u.par * 2048); const LAS float* tW = (const LAS float*)(lds + TAB + u.par * 2048 + 1024);
#pragma unroll
        for (int ai = 0; ai < 2; ++ai)
#pragma unroll
            for (int m = 0; m < 4; ++m) { const int r = r0 + ai * 128 + m * 16, pos = u.pm * 256 + r; int dst; float wg;
                if (e == 64) { dst = pos * 9 + 8; wg = 1.f; } else if (pos < u.cnt) { dst = tD[r]; wg = tW[r]; } else { dst = -1; wg = 0.f; }
                if (dst >= 0) { unsigned char* rp = y + (size_t)dst * 2048 + col0;
#pragma unroll
                    for (int bj = 0; bj < 2; ++bj) { const float wq = wg * (Y_SCALE / (W2_SCALE * ACT_SCALE)); const f32x4 v0 = acc[ai][bj][m][0] * wq, v1 = acc[ai][bj][m][1] * wq;
                        *(u32x2*)(rp + 128 * bj) = (u32x2){pk4_f8(v0[0], v0[1], v0[2], v0[3]), pk4_f8(v1[0], v1[1], v1[2], v1[3])}; } } }
    }
};
static_assert(WS_LW - WS_LDST == 4 * MiB, "EpiMoe2::pre addresses lw as ldst + 2^20 words");
__device__ __forceinline__ void p11_final(Frame& F) {
    const int gw = F.bx * NWAVES + F.wave, NGW = F.G * NWAVES, lane = F.lane;
    const bf16_t* X1 = WSP(bf16_t, WS_X1); const unsigned char* Y = WSP(unsigned char, WS_Y); const float* mod = WSP(float, WS_MOD); const float* fg = F.in[I_FNG];
    LAS float* vb = (LAS float*)(F.lds + F.wave * 8192);
#pragma nounroll
    for (int m = gw; m < T; m += NGW) { const int b = m >> 11; float ss = 0.f;
        u32x2 yt[4][9]; u32x4 xq[4];
#pragma unroll
        for (int j = 0; j < 4; ++j) { const int c = 8 * lane + 512 * j;
#pragma unroll
            for (int k = 0; k < 9; ++k) yt[j][k] = *(const u32x2*)(Y + ((size_t)m * 9 + k) * 2048 + c);
            xq[j] = *(const u32x4*)(X1 + (size_t)m * 2048 + c); }
#pragma unroll
        for (int j = 0; j < 4; ++j) { const int c = 8 * lane + 512 * j; float a[8];
#pragma unroll
            for (int i = 0; i < 8; ++i) a[i] = 0.f;
#pragma unroll
            for (int k = 0; k < 9; ++k) { const u32x2 t = yt[j][k];
                const f32x2 p0 = __builtin_amdgcn_cvt_pk_f32_fp8((int)t.x, false), p1 = __builtin_amdgcn_cvt_pk_f32_fp8((int)t.x, true), p2 = __builtin_amdgcn_cvt_pk_f32_fp8((int)t.y, false), p3 = __builtin_amdgcn_cvt_pk_f32_fp8((int)t.y, true);
                a[0] += p0[0]; a[1] += p0[1]; a[2] += p1[0]; a[3] += p1[1]; a[4] += p2[0]; a[5] += p2[1]; a[6] += p3[0]; a[7] += p3[1]; }
            const u32x4 xt = xq[j]; const f32x4 x0 = {bflo(xt.x), bfhi(xt.x), bflo(xt.y), bfhi(xt.y)}, x1 = {bflo(xt.z), bfhi(xt.z), bflo(xt.w), bfhi(xt.w)};
            const f32x4 g0 = *(const f32x4*)(mod + b * 12288 + 10240 + c) * (1.f / Y_SCALE), g1 = *(const f32x4*)(mod + b * 12288 + 10240 + c + 4) * (1.f / Y_SCALE);
            const f32x4 v0 = {x0[0] + g0[0] * a[0], x0[1] + g0[1] * a[1], x0[2] + g0[2] * a[2], x0[3] + g0[3] * a[3]};
            const f32x4 v1 = {x1[0] + g1[0] * a[4], x1[1] + g1[1] * a[5], x1[2] + g1[2] * a[6], x1[3] + g1[3] * a[7]};
            ss += (v0[0] * v0[0] + v0[1] * v0[1]) + (v0[2] * v0[2] + v0[3] * v0[3]) + (v1[0] * v1[0] + v1[1] * v1[1]) + (v1[2] * v1[2] + v1[3] * v1[3]);
            *(LAS f32x4*)(vb + c) = v0; *(LAS f32x4*)(vb + c + 4) = v1; }
        const float rstd = 1.f / sqrtf(wave_sum(ss) * (1.f / 2048.f) + EPS);
#pragma nounroll
        for (int j = 0; j < 4; ++j) { const int c = 8 * lane + 512 * j;
            const f32x4 v0 = *(const LAS f32x4*)(vb + c), v1 = *(const LAS f32x4*)(vb + c + 4);
            const f32x4 f0 = *(const f32x4*)(fg + c), f1 = *(const f32x4*)(fg + c + 4);
            *(f32x4*)(F.out + (size_t)m * 2048 + c) = v0 * rstd * f0; *(f32x4*)(F.out + (size_t)m * 2048 + c + 4) = v1 * rstd * f1; }
    }
}

#define DIAG_PH 4
#define DIAG_S0 0
#define DIAG_S1 1
#if 1
#define DIAG_BH 0
#define DIAG_VSC 1.0f
#define DIAG_EMIT 0
#define DIAG_S 0
#define DIAG_VR 0
#define DIAG_CMP 2
#define DIAG_SEL (s_ == 0)
#endif
constexpr int CW_DIAG = 9000;
__device__ __forceinline__ void diag_compute(Frame& F) {
#if DIAG == 1
    const unsigned* MASK = WSP(unsigned, WS_MASK);
    for (int row = F.bx * NWAVES + F.wave; row < T; row += F.G * NWAVES) { const int q = row & 2047;
        const unsigned mw = MASK[(size_t)row * 64 + F.lane]; int c = __popc(mw);
        for (int o = 1; o < 64; o <<= 1) c += __shfl_xor(c, o);
        unsigned bad = 0; { const int k0 = F.lane * 32; for (int bb = 0; bb < 32; ++bb) if (((mw >> bb) & 1u) && (k0 + bb > q)) bad = 1; }
        bad = __any(bad) ? 1u : 0u;
        if (F.lane == 0) { atomicMax(F.ctl + CW_DIAG, (unsigned)c); if (c != (q + 1 < 256 ? q + 1 : 256)) atomicAdd(F.ctl + CW_DIAG + 1, 1u); if (bad) atomicAdd(F.ctl + CW_DIAG + 2, 1u); } }
#endif
#if DIAG == 3
    const bf16_t* A = WSP(bf16_t, WS_AO); const bf16_t* Bq = WSP(bf16_t, WS_H1);
    for (size_t i = (size_t)F.bx * NTHR + F.tid; i < (size_t)T * 1024; i += (size_t)F.G * NTHR) {
        const int d = (int)(i & 127), s_ = (int)((i >> 7) & 2047), bh = (int)(i >> 18); (void)d; (void)s_; (void)bh;
        if (!(DIAG_SEL)) continue;
        const bf16_t* Vv = WSP(bf16_t, WS_V); const float vref = DIAG_VSC * bf1(Vv[((size_t)bh * 2048 + DIAG_VR) * 128 + d]);
        const float df = (DIAG_CMP == 0) ? fabsf(bf1(A[i]) - bf1(Bq[i])) : (DIAG_CMP == 1) ? fabsf(bf1(A[i]) - vref) : fabsf(bf1(Bq[i]) - vref);
        const float bv = bf1(Bq[i]);
        atomicMax(F.ctl + CW_DIAG, (unsigned)(df * 4096.f)); if (DIAG_CMP == 3 ? (bv != bv) : DIAG_CMP == 4 ? (bv == 0.f) : (df > 0.05f)) atomicAdd(F.ctl + CW_DIAG + 1, 1u); }
#endif
#if DIAG == 4
    if (F.bx == 0 && F.wave == 0) { const bf16_t* Bq = WSP(bf16_t, WS_H1); const bf16_t* Vv = WSP(bf16_t, WS_V);
        float bv = 0.f, vv = 0.f, bb = 0.f;
        for (int d = F.lane; d < 128; d += 64) { const float x = bf1(Bq[((size_t)DIAG_BH * 2048 + DIAG_S) * 128 + d]), y = bf1(Vv[((size_t)DIAG_BH * 2048 + DIAG_VR) * 128 + d]); bv += x * y; vv += y * y; bb += x * x; }
        bv = wave_sum(bv); vv = wave_sum(vv); bb = wave_sum(bb);
        if (F.lane == 0) { F.ctl[CW_DIAG] = (unsigned)(int)(1000.f * bv / vv + 100000.f); F.ctl[CW_DIAG + 1] = (unsigned)(int)(1000.f * bb / vv); } }
#endif
#if DIAG == 2
    const unsigned* p = (const unsigned*)(F.ws + (size_t)DIAG_OFF); const size_t n = (size_t)DIAG_LEN / 4; unsigned acc = 0;
    for (size_t i = (size_t)F.bx * NTHR + F.tid; i < n; i += (size_t)F.G * NTHR) acc += p[i] * 2654435761u + (unsigned)i;
    for (int o = 1; o < 64; o <<= 1) acc += __shfl_xor(acc, o);
    if (F.lane == 0) atomicAdd(F.ctl + CW_DIAG, acc);
#endif
}
__device__ __forceinline__ void diag_emit(Frame& F) {
    if (F.bx == 0 && F.tid == 0) { const unsigned a = F.ctl[CW_DIAG], b = F.ctl[CW_DIAG + 1], c = F.ctl[CW_DIAG + 2];
        F.out[0] = (DIAG == 4) ? (float)((int)a - 100000) * (DIAG_EMIT == 0 ? 1.f : 0.f) + (float)b * (DIAG_EMIT == 1 ? 1.f : 0.f) : (DIAG_EMIT == 0 ? (float)b : (float)a * (100.f / 4096.f)) + 0.f * (float)(a + c); (void)a; (void)b; (void)c; }
}
constexpr int N_PHASES = (DIAG && DIAG != 5 && DIAG != 6) ? 14 : 12;
__global__ void __launch_bounds__(NTHR, 2) mk_fwd(Args args) {
    extern __shared__ __attribute__((aligned(16))) unsigned char lds[];
    Frame F;
    F.lds = (LAS unsigned char*)lds; F.MISC = (volatile LAS unsigned*)(F.lds + MISC_OFF);
    F.tid = threadIdx.x; F.lane = F.tid & 63; F.wave = __builtin_amdgcn_readfirstlane(F.tid >> 6);
    F.G = gridDim.x; F.bx = blockIdx.x; F.ws = args.ws; F.ctl = (unsigned*)(args.ws + WS_CTL); F.in = args.in; F.out = args.out;
    for (int u = F.tid; u < (LDS_BYTES - CTLZ_OFF) / 4; u += NTHR) ((LAS unsigned*)(F.lds + CTLZ_OFF))[u] = 0u;
    __syncthreads();
    const int lo = args.ph_lo, hi = args.ph_hi;
    XcdBarrier bar; bar.bar = F.ctl + CW_BAR; bar.x = 0; bar.st = nullptr;
    if (hi - lo > 1) bar = xcd_barrier_post(F.ctl + CW_BAR, F.MISC + 8);
#ifndef PH_MASK
#define PH_MASK 0xFFFFF
#endif
#define IN(k) (((PH_MASK >> (k)) & 1) && lo <= (k) && (k) < hi)
#define SEAM(k) do { if (IN(k) && IN((k) + 1)) xcd_barrier(bar); if (DIAG == 5 && F.bx == 0 && F.tid == 0) F.ctl[CW_DIAG + 16 + (k) + 1] = (unsigned)__builtin_amdgcn_s_memrealtime(); } while (0)
#ifndef REP_PHASE
#define REP_PHASE -1
#endif
#define REPEAT(k) (REP_PHASE == (k) && hi - lo > 1)
    if (DIAG == 5 && F.bx == 0 && F.tid == 0) F.ctl[CW_DIAG + 16] = (unsigned)__builtin_amdgcn_s_memrealtime();
    if (IN(0)) { if (F.bx == 0 && F.tid < 64) WSP(float, WS_IKGC)[F.tid] = F.in[I_IKG][F.tid];
        p0_experts(F, F.bx, F.G, 0, F.G > 128 ? EXP_ITEMS - EXP_LATE : EXP_ITEMS); p0_prologue(F); } SEAM(0);
    if (IN(1)) { p0b_mod(F); } SEAM(1);
    if (IN(2)) { p1_h1(F); if (REPEAT(2)) { xcd_barrier(bar); p1_h1(F); } } SEAM(2);
    if (IN(3)) {
        { pg8::ProjSched S{(const char*)WSP(bf16_t, WS_H1), (const char*)WSP(bf16_t, WS_WIN), 4096, 0, F.G, F.bx};
            EpiProj E{F.ws, F.in[I_LBL], 1.f}; pg8::gemm_phase<EpiProj, pg8::ProjSched, true, true, false>(F.lds, 4096, S, E); }
        __syncthreads();
        { pg8::ProjSched S{(const char*)WSP(unsigned char, WS_H1F8), (const char*)WSP(unsigned char, WS_WIN8), 2048, 1, F.G, F.bx};
            EpiProj E{F.ws, F.in[I_LBL], 1.f / (WIN_SCALE * H1_SCALE)}; pg8::gemm_phase<EpiProj, pg8::ProjSched, true, true, true>(F.lds, 2048, S, E); } } SEAM(3);
    if (IN(4)) { if (((PH_MASK >> 12) & 1) && (F.G <= 128 || F.bx >= 64)) { pg8::DenseSched S; if (F.G > 128) S.init(WSP(bf16_t, WS_CKV), WSP(bf16_t, WS_WKV), T, 2048, 512, F.G - 64, F.bx - 64); else S.init(WSP(bf16_t, WS_CKV), WSP(bf16_t, WS_WKV), T, 2048, 512, F.G, F.bx);
          EpiKV E{F.ws}; pg8::gemm_phase<EpiKV, pg8::DenseSched, true, true>(F.lds, 512, S, E); }
        __syncthreads();
        if (((PH_MASK >> 13) & 1) && F.bx < 64) { p3_hgrn(F, F.bx); }
        if ((PH_MASK >> 14) & 1) { p3_indexer(F, 0);
            if (F.G > 128) { __syncthreads(); if (F.bx >= 64) p0_experts(F, F.bx - 64, F.G - 64, EXP_ITEMS - EXP_LATE, EXP_ITEMS - EXP_LATE_H); else p0_experts(F, F.bx, 64, EXP_ITEMS - EXP_LATE_H, EXP_ITEMS); } if (REP_PHASE == 42) { xcd_barrier(bar); p3_indexer(F, 64); } } } SEAM(4);
    if (IN(5)) { if (DIAG >= 3) { p4_attn_naive(F); __syncthreads(); p4_attn_dense(F, WSP(bf16_t, WS_H1)); } else { p4_attn_dense(F, WSP(bf16_t, WS_AO)); if (REPEAT(5)) { xcd_barrier(bar); p4_attn_dense(F, WSP(bf16_t, WS_AO)); } } } SEAM(5);
    if (IN(6)) { p5_finalize(F); if (REPEAT(6)) { xcd_barrier(bar); p5_finalize(F); } } SEAM(6);
    if (IN(7)) { pg8::DenseSched S; S.init(WSP(bf16_t, WS_A2), WSP(bf16_t, WS_WOUT), T, 2048, 2048, F.G, F.bx); S.rep = (REP_PHASE == 7) ? 2 : 1;
        EpiOut E{F.in[I_X], WSP(bf16_t, WS_X1), WSP(float, WS_MOD)}; pg8::gemm_phase<EpiOut, pg8::DenseSched, true, true, true>(F.lds, 2048, S, E); } SEAM(7);
    if (IN(8)) { p7_router(F, 0); if (REPEAT(8)) { xcd_barrier(bar); p7_router(F, 128); } } SEAM(8);
    if (IN(9)) { moe_tables(F);
        MoeSched S; S.A = (const char*)WSP(bf16_t, WS_H2); S.Bt = (const char*)WSP(bf16_t, WS_W1); S.ltok = WSP(int, WS_LTOK); S.tab = (LAS const int*)(F.lds + SCHED_OFF); S.K = 2048; S.ncol = 4; S.nexp = 1024; S.G = F.G; S.c = F.bx; S.gather = 1; S.rep = (REP_PHASE == 9) ? 2 : 1; moe_units(F, S);
        EpiMoe1 E{WSP(unsigned char, WS_ACT)}; pg8::gemm_phase<EpiMoe1, MoeSched, true, true, true>(F.lds, 2048, S, E); } SEAM(9);
    if (IN(10)) { moe_tables(F);
        MoeSched S; S.A = (const char*)WSP(bf16_t, WS_ACT); S.Bt = (const char*)WSP(bf16_t, WS_W2); S.ltok = nullptr; S.tab = (LAS const int*)(F.lds + SCHED_OFF); S.K = 512; S.ncol = 8; S.nexp = 2048; S.G = F.G; S.c = F.bx; S.gather = 0; S.rep = (REP_PHASE == 10) ? 2 : 1; moe_units(F, S);
        EpiMoe2 E{WSP(unsigned char, WS_Y), WSP(int, WS_LDST), WSP(float, WS_LW), F.lds}; pg8::gemm_phase<EpiMoe2, MoeSched, true, true, true>(F.lds, 512, S, E); } SEAM(10);
    if (IN(11)) { p11_final(F); if (REPEAT(11)) { xcd_barrier(bar); p11_final(F); } }
    if (DIAG == 5) { __syncthreads(); if (F.bx == 0 && F.tid == 0) { F.ctl[CW_DIAG + 16 + 12] = (unsigned)__builtin_amdgcn_s_memrealtime();
            F.out[0] = 1000.f + (float)(F.ctl[CW_DIAG + 16 + DIAG_PH + 1] - F.ctl[CW_DIAG + 16 + DIAG_PH]) * 0.01f; } }
    if (DIAG == 6) { __syncthreads(); if (F.bx == 0 && F.tid == 0) { const float us_ = (float)(F.ctl[9100 + DIAG_S1] - F.ctl[9100 + DIAG_S0]) * 0.01f; const float q_ = us_ > 200.f ? 50.f : us_ > 60.f ? 20.f : 5.f;
            F.out[0] = 10.f * q_ * floorf(us_ / q_ + 0.5f); } }
    if (DIAG && DIAG != 5 && DIAG != 6 && lo <= 12 && 12 < hi) diag_compute(F);
    if (DIAG && DIAG != 5 && DIAG != 6 && lo <= 13 && 13 < hi) diag_emit(F);
#undef IN
#undef SEAM
}

extern "C" void kernel_launch(void* const* d_in, const int* in_sizes, int n_in, void* d_out, int out_size, void* d_ws, size_t ws_size, hipStream_t stream) {
    static int grid = 0;
    if (grid == 0) {
        if (n_in != 25 || in_sizes[0] != T * D || out_size != T * D || ws_size < WS_END) { fprintf(stderr, "kernel_launch: unexpected shapes (n_in %d, in0 %d, out %d, ws %zu < %zu)\n", n_in, n_in > 0 ? in_sizes[0] : -1, out_size, ws_size, (size_t)WS_END); grid = -1; return; }
        int dev = 0, cus = 0, per_cu = 0;
        if (hipGetDevice(&dev) != hipSuccess || hipDeviceGetAttribute(&cus, hipDeviceAttributeMultiprocessorCount, dev) != hipSuccess) { grid = -1; return; }
        if (hipFuncSetAttribute((const void*)mk_fwd, hipFuncAttributeMaxDynamicSharedMemorySize, LDS_BYTES) != hipSuccess) { fprintf(stderr, "kernel_launch: hipFuncSetAttribute failed\n"); grid = -1; return; }
        if (hipOccupancyMaxActiveBlocksPerMultiprocessor(&per_cu, (const void*)mk_fwd, NTHR, LDS_BYTES) != hipSuccess || per_cu < 1) { fprintf(stderr, "kernel_launch: occupancy query says %d\n", per_cu); }
        (void)hipGetLastError();
        grid = cus;
    }
    if (grid < 0) return;
    (void)hipMemsetAsync((char*)d_ws + WS_CTL, 0, CTL_ZERO_BYTES, stream);
    Args a{};
    for (int i = 0; i < 25; ++i) a.in[i] = (const float*)d_in[i];
    a.out = (float*)d_out; a.ws = (unsigned char*)d_ws;
    constexpr int NL = (DIAG && DIAG != 5 && DIAG != 6) ? 14 : MK_N_LAUNCHES;
    for (int li = 0; li < NL; ++li) {
        a.ph_lo = li * N_PHASES / NL; a.ph_hi = (li + 1) * N_PHASES / NL;
        hipLaunchKernelGGL(mk_fwd, dim3(grid), dim3(NTHR), LDS_BYTES, stream, a);
    }
}
```
